# Optimizing an MI355X kernel written in HIP

```python
import math
import jax, jax.numpy as jnp
from jax import lax

D_MODEL = 1024
BATCH = 16
SEQ = 256
DEPTH = 2
DEC_BATCH = 2
DEC_SEQ = 2048
PAST_LEN = 512

GRID_W = 64
HEAD_DIM = 64
N_HEADS_GROUP = 4
W_GROUP = N_HEADS_GROUP * HEAD_DIM
N_MIXERS = 4
D_MIX = N_MIXERS * W_GROUP
D_FF = 4 * D_MODEL
Q_BLOCK = 128
SSD_HEADS = N_HEADS_GROUP
SSD_P = HEAD_DIM
SSD_GROUPS = 2
SSD_N = 64
SSD_CONV = 5
SSD_CHUNK = 128
SSD_XBC = W_GROUP + 2 * SSD_GROUPS * SSD_N
WIN_R = 8
WIN_C = 16
RWKV_SHIFT = 3
RWKV_DECAY_RANK = 64
RWKV_ICLR_RANK = 64
RWKV_GATE_RANK = 128
RWKV_SIZES = (W_GROUP, W_GROUP, W_GROUP, 2 * RWKV_DECAY_RANK, 2 * RWKV_ICLR_RANK, RWKV_GATE_RANK)
RWKV_COLS = 3 * W_GROUP + 2 * RWKV_DECAY_RANK + 2 * RWKV_ICLR_RANK + RWKV_GATE_RANK
RWKV_LN_EPS = 64e-5
DIFF_SUB = HEAD_DIM // 2
ROPE_THETA = 10000.0
IN_SIZES = (W_GROUP, SSD_XBC, 2 * SSD_HEADS, 3 * W_GROUP, RWKV_COLS, 3 * W_GROUP)
N_IN = W_GROUP + SSD_XBC + 2 * SSD_HEADS + 3 * W_GROUP + RWKV_COLS + 3 * W_GROUP

kernel_name = 'hybrid_diffusion_parallel_heads_step'


def split_points(sizes):
    pts, acc = [], 0
    for s in sizes[:-1]:
        acc += s
        pts.append(acc)
    return pts


def rms_norm(x, g, eps=1e-6):
    xf = x.astype(jnp.float32)
    y = xf * lax.rsqrt(jnp.mean(xf * xf, axis=-1, keepdims=True) + eps)
    return (y * g.astype(jnp.float32)).astype(x.dtype)


def dwconv_centred(x, w):
    k = w.shape[0]
    return lax.conv_general_dilated(x, w[:, None, :].astype(x.dtype), window_strides=(1,),
                                    padding=[(k // 2, k // 2)],
                                    dimension_numbers=('NWC', 'WIO', 'NWC'),
                                    feature_group_count=x.shape[-1])


def sweep_query_blocks(fn, q):
    b, L = q.shape[:2]
    nb = L // Q_BLOCK
    qb = jnp.moveaxis(q.reshape((b, nb, Q_BLOCK) + q.shape[2:]), 1, 0)
    out = jnp.moveaxis(lax.map(fn, qb), 0, 1)
    return out.reshape((b, L) + out.shape[3:])


def axial_rope(t):
    L = t.shape[1]
    pos = jnp.arange(L)
    half = DIFF_SUB // 2
    inv = 1.0 / (ROPE_THETA ** (jnp.arange(0, half, 2, dtype=jnp.float32) / half))

    def rot(u, p):
        ang = p.astype(jnp.float32)[:, None] * inv[None, :]
        cos = jnp.cos(ang)[None, :, None, None, :].astype(u.dtype)
        sin = jnp.sin(ang)[None, :, None, None, :].astype(u.dtype)
        u1, u2 = u[..., :half // 2], u[..., half // 2:]
        return jnp.concatenate([u1 * cos - u2 * sin, u2 * cos + u1 * sin], axis=-1)

    return jnp.concatenate([rot(t[..., :half], pos // GRID_W), rot(t[..., half:], pos % GRID_W)], axis=-1)


def ssd_chunked(x, dt, A, B, C, h0):
    b, L, h, p = x.shape
    n = B.shape[-1]
    Q = SSD_CHUNK
    nc = L // Q
    dtype = x.dtype
    la = (dt * A).reshape(b, nc, Q, h).transpose(0, 3, 1, 2)
    cs = jnp.cumsum(la, axis=-1)
    xdt = (x.astype(jnp.float32) * dt[..., None]).astype(dtype).reshape(b, nc, Q, h, p)
    Bc = B.reshape(b, nc, Q, h, n)
    Cc = C.reshape(b, nc, Q, h, n)
    tri = jnp.tril(jnp.ones((Q, Q), dtype=bool))
    seg = jnp.where(tri, cs[..., :, None] - cs[..., None, :], -jnp.inf)
    lmat = jnp.exp(seg).astype(dtype)
    gmat = jnp.einsum('bclhn,bcshn->bhcls', Cc, Bc) * lmat
    y_diag = jnp.einsum('bhcls,bcshp->bclhp', gmat, xdt)
    decay_to_end = jnp.exp(cs[..., -1:] - cs).astype(dtype)
    chunk_states = jnp.einsum('bclhn,bhcl,bclhp->bchpn', Bc, decay_to_end, xdt)
    chunk_decay = jnp.exp(cs[..., -1]).astype(dtype)

    def carry_step(s, inp):
        dec, st = inp
        return s * dec[..., None, None] + st, s

    final, s_in = lax.scan(carry_step, h0.astype(dtype),
                           (jnp.moveaxis(chunk_decay, 2, 0), jnp.moveaxis(chunk_states, 1, 0)))
    s_in = jnp.moveaxis(s_in, 0, 1)
    y_off = jnp.einsum('bclhn,bchpn,bhcl->bclhp', Cc, s_in, jnp.exp(cs).astype(dtype))
    return (y_diag + y_off).reshape(b, L, h, p), final


def ssd_mixer(z, xbc, dt_raw, p, h0_fwd, h0_bwd):
    b, L, _ = xbc.shape
    xbc = jax.nn.silu(dwconv_centred(xbc, p['ssd_conv_w']) + p['ssd_conv_b'])
    xs, bm, cm = jnp.split(xbc, [W_GROUP, W_GROUP + SSD_GROUPS * SSD_N], axis=-1)
    xs = xs.reshape(b, L, SSD_HEADS, SSD_P)
    rep = SSD_HEADS // SSD_GROUPS
    bm = jnp.repeat(bm.reshape(b, L, SSD_GROUPS, SSD_N), rep, axis=2)
    cm = jnp.repeat(cm.reshape(b, L, SSD_GROUPS, SSD_N), rep, axis=2)
    dt = jax.nn.softplus(dt_raw.reshape(b, L, 2, SSD_HEADS).astype(jnp.float32)
                         + p['ssd_dt_bias'].astype(jnp.float32))
    A = -jnp.exp(p['ssd_a_log'].astype(jnp.float32))
    flip = lambda t: t[:, ::-1]
    y_f, s_f = ssd_chunked(xs, dt[:, :, 0], A[0], bm, cm, h0_fwd)
    y_b, s_b = ssd_chunked(flip(xs), flip(dt[:, :, 1]), A[1], flip(bm), flip(cm), h0_bwd)
    y = y_f + flip(y_b) + p['ssd_d'][:, None] * xs
    y = y.reshape(b, L, W_GROUP) * jax.nn.silu(z)
    return rms_norm(y, p['ssd_norm_g']), jnp.stack([s_f, s_b], axis=1)


def dense_attend(q, k, v):
    scale = q.shape[-1] ** -0.5

    def block(qb):
        s = jnp.einsum('bqhd,bkhd->bhqk', qb, k).astype(jnp.float32) * scale
        return jnp.einsum('bhqk,bkhd->bqhd', jax.nn.softmax(s, axis=-1).astype(v.dtype), v)

    return sweep_query_blocks(block, q)


def nat_latent_attend(q, k, v, ck, cv, rel_bias):
    b, L, h, d = q.shape
    W = GRID_W
    R = L // W
    KR = min(WIN_R, R)
    scale = d ** -0.5
    rows = jnp.arange(R)
    cols = jnp.arange(W)
    row_idx = jnp.clip(rows - KR // 2, 0, R - KR)[:, None] + jnp.arange(KR)[None, :]
    col_start = jnp.clip(cols - WIN_C // 2, 0, W - WIN_C)
    col_ok = (cols[None, :] >= col_start[:, None]) & (cols[None, :] < col_start[:, None] + WIN_C)
    dr = row_idx - rows[:, None] + (WIN_R - 1)
    dc = jnp.clip(cols[None, :] - cols[:, None], -(WIN_C - 1), WIN_C - 1) + (WIN_C - 1)
    bias = rel_bias[:, dr[:, :, None, None], dc[None, None, :, :]]
    bias = bias.transpose(1, 3, 0, 2, 4).astype(jnp.float32)
    qg = q.reshape(b, R, W, h, d)
    kg = k.reshape(b, R, W, h, d)[:, row_idx]
    vg = v.reshape(b, R, W, h, d)[:, row_idx]
    s_lat = jnp.einsum('brqhd,brikhd->brqhik', qg, kg).astype(jnp.float32) * scale + bias
    s_lat = jnp.where(col_ok[None, None, :, None, None, :], s_lat, -jnp.inf)
    s_ctx = jnp.einsum('brqhd,bchd->brqhc', qg, ck).astype(jnp.float32) * scale
    n_lat = KR * W
    probs = jax.nn.softmax(jnp.concatenate([s_lat.reshape(b, R, W, h, n_lat), s_ctx], axis=-1), axis=-1)
    probs = probs.astype(v.dtype)
    out = (jnp.einsum('brqhik,brikhd->brqhd', probs[..., :n_lat].reshape(b, R, W, h, KR, W), vg)
           + jnp.einsum('brqhc,bchd->brqhd', probs[..., n_lat:], cv))
    return out.reshape(b, L, h, d)


def rwkv7_scan(r, w, kk, a, kt, v, s0):
    def step(S, inp):
        r_t, w_t, kk_t, a_t, kt_t, v_t = inp
        s_kk = jnp.einsum('bhvk,bhk->bhv', S, kk_t)
        S = (S * w_t[:, :, None, :] - s_kk[..., None] * (kk_t * a_t)[:, :, None, :]
             + v_t[..., None] * kt_t[:, :, None, :])
        return S, jnp.einsum('bhvk,bhk->bhv', S, r_t)

    xs = tuple(jnp.moveaxis(t, 1, 0) for t in (r, w, kk, a, kt, v))
    s_fin, ys = lax.scan(step, s0, xs)
    return jnp.moveaxis(ys, 0, 1), s_fin


def rwkv_mixer(u, p, s0_fwd, s0_bwd):
    b, L, _ = u.shape
    f32 = jnp.float32
    u = dwconv_centred(u, p['rwkv_conv_w'])
    r, k, v, w_dn, a_dn, g_dn = jnp.split(u, split_points(RWKV_SIZES), axis=-1)
    hd = lambda t: t.reshape(b, L, N_HEADS_GROUP, HEAD_DIM).astype(f32)
    kk = hd(k * p['rwkv_k_k'])
    kk = kk / jnp.maximum(jnp.sqrt(jnp.sum(kk * kk, axis=-1, keepdims=True)), 1e-12)
    w_dn = w_dn.reshape(b, L, 2, RWKV_DECAY_RANK)
    a_dn = a_dn.reshape(b, L, 2, RWKV_ICLR_RANK)
    ys, finals = [], []
    for d, s0 in enumerate((s0_fwd, s0_bwd)):
        w_log = -jax.nn.softplus(-(p['rwkv_w0'][d] + jnp.tanh(w_dn[:, :, d]) @ p['rwkv_w_up'][d])) - 0.5
        decay = jnp.exp(-jnp.exp(w_log.astype(f32)))
        a = jax.nn.sigmoid(p['rwkv_a0'][d] + a_dn[:, :, d] @ p['rwkv_a_up'][d])
        kt = k * (1 + (a - 1) * p['rwkv_k_a'])
        seqs = (hd(r), hd(decay), kk, hd(a), hd(kt), hd(v))
        if d == 1:
            seqs = tuple(t[:, ::-1] for t in seqs)
        y, s_fin = rwkv7_scan(*seqs, s0.astype(f32))
        ys.append(y if d == 0 else y[:, ::-1])
        finals.append(s_fin)
    y = ys[0] + ys[1]
    mu = jnp.mean(y, axis=-1, keepdims=True)
    var = jnp.mean(jnp.square(y - mu), axis=-1, keepdims=True)
    y = ((y - mu) * lax.rsqrt(var + RWKV_LN_EPS)
         * p['rwkv_ln_g'].reshape(N_HEADS_GROUP, HEAD_DIM).astype(f32)
         + p['rwkv_ln_b'].reshape(N_HEADS_GROUP, HEAD_DIM).astype(f32))
    bonus = jnp.sum(hd(r) * hd(k) * p['rwkv_r_k'].astype(f32), axis=-1, keepdims=True) * hd(v)
    gate = jax.nn.sigmoid(g_dn) @ p['rwkv_g_up']
    out = (y + bonus).reshape(b, L, W_GROUP).astype(u.dtype) * gate
    return out, jnp.stack(finals, axis=1).astype(u.dtype)


def diff_attend(q, k, v, lam):
    scale = DIFF_SUB ** -0.5

    def block(qb):
        s = jnp.einsum('bqhcd,bkhcd->bhcqk', qb, k).astype(jnp.float32) * scale
        pr = jax.nn.softmax(s, axis=-1)
        amap = pr[:, :, 0] - lam * pr[:, :, 1]
        return jnp.einsum('bhqk,bkhd->bqhd', amap.astype(v.dtype), v)

    return sweep_query_blocks(block, q)


def trunk_layer(x, cond, p, layer_idx, cache):
    b, L, _ = x.shape
    is_ctx = cache is None
    heads = lambda t: t.reshape(b, L, N_HEADS_GROUP, HEAD_DIM)
    mod = (jax.nn.silu(cond) @ p['w_mod'] + p['b_mod']).reshape(-1, 1, 6 * D_MODEL)
    sh1, sc1, g1, sh2, sc2, g2 = jnp.split(mod, 6, axis=-1)
    hn = rms_norm(x, p['norm1_g']) * (1 + sc1) + sh1
    z, xbc, dt_raw, nat_qkv, rwkv_in, diff_qkv = jnp.split(hn @ p['w_in'], split_points(IN_SIZES), axis=-1)
    if is_ctx:
        ssd0 = jnp.zeros((b, 2, SSD_HEADS, SSD_P, SSD_N), x.dtype)
        rwkv0 = jnp.zeros((b, 2, N_HEADS_GROUP, HEAD_DIM, HEAD_DIM), x.dtype)
    else:
        ssd0, nat_kc, nat_vc, rwkv0, diff_kc, diff_vc = cache
    y_ssd, ssd_fin = ssd_mixer(z, xbc, dt_raw, p, ssd0[:, 0], ssd0[:, 1])
    nq, nk, nv = jnp.split(nat_qkv, 3, axis=-1)
    nq = rms_norm(heads(nq), p['nat_q_g'])
    nk = rms_norm(heads(nk), p['nat_k_g'])
    nv = heads(nv)
    if is_ctx:
        y_nat = dense_attend(nq, nk, nv)
    else:
        y_nat = nat_latent_attend(nq, nk, nv, nat_kc, nat_vc, p['nat_rel_bias'])
    y_rwkv, rwkv_fin = rwkv_mixer(rwkv_in, p, rwkv0[:, 0], rwkv0[:, 1])
    dq, dk, dv = jnp.split(diff_qkv, 3, axis=-1)
    dq = rms_norm(dq.reshape(b, L, N_HEADS_GROUP, 2, DIFF_SUB), p['diff_q_g'])
    dk = rms_norm(dk.reshape(b, L, N_HEADS_GROUP, 2, DIFF_SUB), p['diff_k_g'])
    dv = heads(dv)
    lam_init = 0.8 - 0.6 * math.exp(-0.3 * layer_idx)
    lv = p['diff_lam'].astype(jnp.float32)
    lam = jnp.exp(jnp.sum(lv[0] * lv[1])) - jnp.exp(jnp.sum(lv[2] * lv[3])) + lam_init
    if is_ctx:
        k_all, v_all = dk, dv
    else:
        dq = axial_rope(dq)
        k_all = jnp.concatenate([diff_kc, axial_rope(dk)], axis=1)
        v_all = jnp.concatenate([diff_vc, dv], axis=1)
    y_diff = rms_norm(diff_attend(dq, k_all, v_all, lam), p['diff_subln_g']) * (1 - lam_init)
    mixed = jnp.concatenate([y_ssd, y_nat.reshape(b, L, W_GROUP), y_rwkv,
                             y_diff.reshape(b, L, W_GROUP)], axis=-1)
    x = x + g1 * (mixed @ p['w_out'])
    hn2 = rms_norm(x, p['norm2_g']) * (1 + sc2) + sh2
    x = x + g2 * (jnp.square(jax.nn.relu(hn2 @ p['w_ff1'])) @ p['w_ff2'])
    if is_ctx:
        return x, (ssd_fin, nk, nv, rwkv_fin, dk, dv)
    return x, None


def setup_inputs(seed: int = 0) -> dict:
    key = jax.random.key(seed)
    ks = iter(jax.random.split(key, 64))
    f32 = jnp.float32
    H = N_HEADS_GROUP

    def nrm(shape, scale):
        return scale * jax.random.normal(next(ks), shape, f32)

    def unif(shape, lo, hi):
        return jax.random.uniform(next(ks), shape, f32, lo, hi)

    dt0 = jnp.exp(unif((DEPTH, 2, SSD_HEADS), math.log(1e-3), math.log(1e-1)))
    return {
        'x_prompt': nrm((BATCH, SEQ, D_MODEL), 1.0),
        'x_sample': nrm((DEC_BATCH, DEC_SEQ, D_MODEL), 1.0),
        'state_ssd': nrm((DEC_BATCH, DEPTH, 2, SSD_HEADS, SSD_P, SSD_N), 0.5),
        'cache_nat_k': nrm((DEC_BATCH, DEPTH, PAST_LEN, H, HEAD_DIM), 1.0),
        'cache_nat_v': nrm((DEC_BATCH, DEPTH, PAST_LEN, H, HEAD_DIM), 1.0),
        'state_rwkv': nrm((DEC_BATCH, DEPTH, 2, H, HEAD_DIM, HEAD_DIM), 0.5),
        'cache_diff_k': nrm((DEC_BATCH, DEPTH, PAST_LEN, H, 2, DIFF_SUB), 1.0),
        'cache_diff_v': nrm((DEC_BATCH, DEPTH, PAST_LEN, H, HEAD_DIM), 1.0),
        'c': nrm((DEC_BATCH, D_MODEL), 1.0),
        'c_ctx': nrm((D_MODEL,), 1.0),
        'w_mod': nrm((DEPTH, D_MODEL, 6 * D_MODEL), D_MODEL ** -0.5),
        'b_mod': nrm((DEPTH, 6 * D_MODEL), 0.01),
        'norm1_g': 1.0 + nrm((DEPTH, D_MODEL), 0.01),
        'norm2_g': 1.0 + nrm((DEPTH, D_MODEL), 0.01),
        'w_in': nrm((DEPTH, D_MODEL, N_IN), D_MODEL ** -0.5),
        'w_out': nrm((DEPTH, D_MIX, D_MODEL), D_MIX ** -0.5),
        'ssd_conv_w': nrm((DEPTH, SSD_CONV, SSD_XBC), SSD_CONV ** -0.5),
        'ssd_conv_b': nrm((DEPTH, SSD_XBC), 0.01),
        'ssd_a_log': jnp.log(unif((DEPTH, 2, SSD_HEADS), 1.0, 16.0)),
        'ssd_dt_bias': dt0 + jnp.log(-jnp.expm1(-dt0)),
        'ssd_d': 1.0 + nrm((DEPTH, SSD_HEADS), 0.01),
        'ssd_norm_g': 1.0 + nrm((DEPTH, W_GROUP), 0.01),
        'nat_q_g': 1.0 + nrm((DEPTH, HEAD_DIM), 0.01),
        'nat_k_g': 1.0 + nrm((DEPTH, HEAD_DIM), 0.01),
        'nat_rel_bias': nrm((DEPTH, H, 2 * WIN_R - 1, 2 * WIN_C - 1), 0.1),
        'rwkv_conv_w': nrm((DEPTH, RWKV_SHIFT, RWKV_COLS), RWKV_SHIFT ** -0.5),
        'rwkv_w0': unif((DEPTH, 2, W_GROUP), -5.0, -0.5),
        'rwkv_w_up': nrm((DEPTH, 2, RWKV_DECAY_RANK, W_GROUP), 0.5 * RWKV_DECAY_RANK ** -0.5),
        'rwkv_a0': nrm((DEPTH, 2, W_GROUP), 0.1),
        'rwkv_a_up': nrm((DEPTH, 2, RWKV_ICLR_RANK, W_GROUP), 0.5 * RWKV_ICLR_RANK ** -0.5),
        'rwkv_g_up': nrm((DEPTH, RWKV_GATE_RANK, W_GROUP), RWKV_GATE_RANK ** -0.5),
        'rwkv_k_k': 0.85 + nrm((DEPTH, W_GROUP), 0.02),
        'rwkv_k_a': 1.0 + nrm((DEPTH, W_GROUP), 0.02),
        'rwkv_r_k': nrm((DEPTH, H, HEAD_DIM), 0.1),
        'rwkv_ln_g': 1.0 + nrm((DEPTH, W_GROUP), 0.01),
        'rwkv_ln_b': nrm((DEPTH, W_GROUP), 0.01),
        'diff_q_g': 1.0 + nrm((DEPTH, DIFF_SUB), 0.01),
        'diff_k_g': 1.0 + nrm((DEPTH, DIFF_SUB), 0.01),
        'diff_lam': nrm((DEPTH, 4, DIFF_SUB), 0.1),
        'diff_subln_g': 1.0 + nrm((DEPTH, HEAD_DIM), 0.01),
        'w_ff1': nrm((DEPTH, D_MODEL, D_FF), D_MODEL ** -0.5),
        'w_ff2': nrm((DEPTH, D_FF, D_MODEL), D_FF ** -0.5),
    }


def reference(x_prompt, x_sample, state_ssd, cache_nat_k, cache_nat_v, state_rwkv, cache_diff_k,
              cache_diff_v, c, c_ctx, w_mod, b_mod, norm1_g, norm2_g, w_in, w_out, ssd_conv_w,
              ssd_conv_b, ssd_a_log, ssd_dt_bias, ssd_d, ssd_norm_g, nat_q_g, nat_k_g, nat_rel_bias,
              rwkv_conv_w, rwkv_w0, rwkv_w_up, rwkv_a0, rwkv_a_up, rwkv_g_up, rwkv_k_k, rwkv_k_a,
              rwkv_r_k, rwkv_ln_g, rwkv_ln_b, diff_q_g, diff_k_g, diff_lam, diff_subln_g, w_ff1, w_ff2):
    def layer_params(l):
        return {
            'w_mod': w_mod[l], 'b_mod': b_mod[l], 'norm1_g': norm1_g[l], 'norm2_g': norm2_g[l],
            'w_in': w_in[l], 'w_out': w_out[l], 'ssd_conv_w': ssd_conv_w[l], 'ssd_conv_b': ssd_conv_b[l],
            'ssd_a_log': ssd_a_log[l], 'ssd_dt_bias': ssd_dt_bias[l], 'ssd_d': ssd_d[l],
            'ssd_norm_g': ssd_norm_g[l], 'nat_q_g': nat_q_g[l], 'nat_k_g': nat_k_g[l],
            'nat_rel_bias': nat_rel_bias[l], 'rwkv_conv_w': rwkv_conv_w[l], 'rwkv_w0': rwkv_w0[l],
            'rwkv_w_up': rwkv_w_up[l], 'rwkv_a0': rwkv_a0[l], 'rwkv_a_up': rwkv_a_up[l],
            'rwkv_g_up': rwkv_g_up[l], 'rwkv_k_k': rwkv_k_k[l], 'rwkv_k_a': rwkv_k_a[l],
            'rwkv_r_k': rwkv_r_k[l], 'rwkv_ln_g': rwkv_ln_g[l], 'rwkv_ln_b': rwkv_ln_b[l],
            'diff_q_g': diff_q_g[l], 'diff_k_g': diff_k_g[l], 'diff_lam': diff_lam[l],
            'diff_subln_g': diff_subln_g[l], 'w_ff1': w_ff1[l], 'w_ff2': w_ff2[l],
        }

    y_prompt = x_prompt
    ctx = []
    for l in range(DEPTH):
        y_prompt, st = trunk_layer(y_prompt, c_ctx, layer_params(l), l, None)
        ctx.append(st)
    new_state_ssd = jnp.stack([s[0] for s in ctx], axis=1)
    new_cache_nat_k = jnp.stack([s[1] for s in ctx], axis=1)
    new_cache_nat_v = jnp.stack([s[2] for s in ctx], axis=1)
    new_state_rwkv = jnp.stack([s[3] for s in ctx], axis=1)
    new_cache_diff_k = jnp.stack([s[4] for s in ctx], axis=1)
    new_cache_diff_v = jnp.stack([s[5] for s in ctx], axis=1)

    y_sample = x_sample
    for l in range(DEPTH):
        cache = (state_ssd[:, l], cache_nat_k[:, l], cache_nat_v[:, l], state_rwkv[:, l],
                 cache_diff_k[:, l], cache_diff_v[:, l])
        y_sample, _ = trunk_layer(y_sample, c, layer_params(l), l, cache)

    return (y_prompt, y_sample, new_state_ssd, new_cache_nat_k, new_cache_nat_v, new_state_rwkv,
            new_cache_diff_k, new_cache_diff_v)
```

```cpp
#include <hip/hip_runtime.h>
#include <hip/hip_cooperative_groups.h>
#include <cstdint>
#include <cstdio>
namespace cg = cooperative_groups;

#ifndef MK_MULTI
#define MK_MULTI 1
#endif

typedef unsigned short bf16_t;
typedef short bf16x8 __attribute__((ext_vector_type(8)));
typedef float f32x4 __attribute__((ext_vector_type(4)));
typedef float f32x2 __attribute__((ext_vector_type(2)));
typedef unsigned u32x4 __attribute__((ext_vector_type(4)));
typedef unsigned u32x2 __attribute__((ext_vector_type(2)));

constexpr int NT = 512;
constexpr int MTOK = 8192, CTXTOK = 4096;
constexpr int D = 1024, NPROJ = 3584, DFF = 4096;
constexpr int LDS_BYTES = 114688;
constexpr float LOG2E = 1.4426950408889634f;

constexpr int PC_Z = 0, PC_XBC = 256, PC_NAT = 768, PC_RW = 1536, PC_DIFF = 2688, PC_DT = 3456;

constexpr size_t O_Y = 0, O_SSD = 8388608, O_NATK = 9437184, O_NATV = 11534336, O_RWKV = 13631488, O_DIFFK = 14680064, O_DIFFV = 16777216;

constexpr size_t WS_CTL = 0;
constexpr size_t WS_MOD = 65536;
constexpr size_t WS_ROPE = WS_MOD + 2 * 3 * 6144 * 4;
constexpr size_t WS_WIN = WS_ROPE + 4096;
constexpr size_t WS_WOUT = WS_WIN + (size_t)2 * 3584 * 1024 * 2;
constexpr size_t WS_WFF1 = WS_WOUT + (size_t)2 * 1024 * 1024 * 2;
constexpr size_t WS_WFF2 = WS_WFF1 + (size_t)2 * 4096 * 1024 * 2;
constexpr size_t WS_CKN = WS_WFF2 + (size_t)2 * 4096 * 1024 * 2;
constexpr size_t WS_CVTN = WS_CKN + 1048576;
constexpr size_t WS_CKD = WS_CVTN + 1048576;
constexpr size_t WS_CVTD = WS_CKD + 1048576;
constexpr size_t WS_HN = WS_CVTD + 1048576;
constexpr size_t WS_PROJ = WS_HN + (size_t)MTOK * 1024 * 2;
constexpr size_t WS_YSF = WS_PROJ;
constexpr size_t WS_YSB = WS_YSF + (size_t)MTOK * 256 * 4;
constexpr size_t WS_YRF = WS_YSB + (size_t)MTOK * 256 * 4;
constexpr size_t WS_YRB = WS_YRF + (size_t)MTOK * 256 * 4;
constexpr size_t WS_XBC = WS_PROJ + (size_t)MTOK * NPROJ * 2;
constexpr size_t WS_DTA = WS_XBC + (size_t)MTOK * 512 * 4;
constexpr size_t WS_ZS = WS_DTA + (size_t)MTOK * 16 * 4;
constexpr size_t WS_QN = WS_ZS + (size_t)MTOK * 256 * 2;
constexpr size_t WS_KN = WS_QN + (size_t)MTOK * 256 * 2;
constexpr size_t WS_VTN = WS_KN + (size_t)MTOK * 256 * 2;
constexpr size_t WS_QD = WS_VTN + (size_t)MTOK * 256 * 2;
constexpr size_t WS_KD = WS_QD + (size_t)MTOK * 256 * 2;
constexpr size_t WS_VTD = WS_KD + (size_t)MTOK * 256 * 2;
constexpr size_t WS_RW = WS_VTD + (size_t)MTOK * 256 * 2;
constexpr size_t RWA = (size_t)MTOK * 256 * 4;
constexpr size_t WS_BON = WS_RW + 10 * RWA;
constexpr size_t WS_END = WS_BON + (size_t)MTOK * 4 * 4;
constexpr size_t WS_H = WS_RW;
static_assert((size_t)MTOK * DFF * 2 <= 10 * RWA, "h overlay");
static_assert(WS_END <= (size_t)268435456, "workspace");

struct Params {
    const float* in[42];
    float* out;
    unsigned char* ws;
    int ph_lo, ph_hi;
};

__device__ __forceinline__ float bf2f(unsigned short h) { return __uint_as_float((unsigned)h << 16); }
typedef __bf16 bf16x2_t __attribute__((ext_vector_type(2)));
__device__ __forceinline__ unsigned pack_bf16(float lo, float hi) { f32x2 v = {lo, hi}; bf16x2_t r = __builtin_convertvector(v, bf16x2_t); return __builtin_bit_cast(unsigned, r); }
__device__ __forceinline__ unsigned short f2bf(float f) { return (unsigned short)(pack_bf16(f, 0.f) & 0xffffu); }
__device__ __forceinline__ float siluf(float x) { return x / (1.f + __expf(-x)); }
__device__ __forceinline__ float sigmoidf_(float x) { return 1.f / (1.f + __expf(-x)); }
__device__ __forceinline__ float softplusf_(float x) { return x > 20.f ? x : log1pf(__expf(x)); }
template <int CTRL> __device__ __forceinline__ float dpp_mov(float x) {
    return __builtin_bit_cast(float, __builtin_amdgcn_update_dpp(0, __builtin_bit_cast(int, x), CTRL, 0xf, 0xf, true));
}
__device__ __forceinline__ float allsum4(float x) { x += dpp_mov<0xB1>(x); x += dpp_mov<0x4E>(x); return x; }
__device__ __forceinline__ float allsum8(float x) { x = allsum4(x); x += dpp_mov<0x141>(x); return x; }
__device__ __forceinline__ float allsum16(float x) { x = allsum8(x); x += dpp_mov<0x140>(x); return x; }
__device__ __forceinline__ float allsum64(float x) { x = allsum16(x); x += __shfl_xor(x, 16); x += __shfl_xor(x, 32); return x; }
__device__ __forceinline__ float allmax_q(float x) { x = fmaxf(x, __shfl_xor(x, 16)); x = fmaxf(x, __shfl_xor(x, 32)); return x; }
__device__ __forceinline__ float allsum_q(float x) { x += __shfl_xor(x, 16); x += __shfl_xor(x, 32); return x; }

__device__ __forceinline__ const float* inp(const Params& P, int k) { asm volatile("" : "+s"(k)); return P.in[k]; }
__device__ __forceinline__ float* outp(const Params& P) { float* o = P.out; asm volatile("" : "+s"(o)); return o; }
__device__ __forceinline__ unsigned char* opaque_ws(const Params& P) { unsigned char* w = P.ws; asm volatile("" : "+s"(w)); return w; }
struct TokInfo { int seqbase, t, L, cond, isctx, sidx; };
__device__ __forceinline__ TokInfo tokinfo(int g) {
    TokInfo r;
    if (g < CTXTOK) { r.isctx = 1; r.sidx = g >> 8; r.t = g & 255; r.L = 256; r.seqbase = r.sidx << 8; r.cond = 0; }
    else { int q = g - CTXTOK; r.isctx = 0; r.sidx = q >> 11; r.t = q & 2047; r.L = 2048; r.seqbase = CTXTOK + (r.sidx << 11); r.cond = 1 + r.sidx; }
    return r;
}

__device__ void pro_transpose_tile(const float* __restrict__ W, bf16_t* __restrict__ Wt, int K, int N, int k0, int n0, bool perm_in, float* lds) {
    const int tid = threadIdx.x;
    const int nn = tid & 63;
    int nd = n0 + nn, ns = nd; bool valid = true;
    if (perm_in) {
        if (nd < 768) ns = nd; else if (nd < 3456) ns = nd + 8; else if (nd < 3464) ns = nd - 3456 + 768; else valid = false;
    }
#pragma unroll
    for (int i = 0; i < 8; ++i) {
        const int kk = (tid >> 6) + 8 * i;
        float v = valid ? W[(size_t)(k0 + kk) * N + ns] : 0.f;
        lds[nn * 65 + kk] = v;
    }
    __syncthreads();
    {
        const int n2 = tid >> 3, c = tid & 7;
        const float* s = lds + n2 * 65 + c * 8;
        u32x4 o; o.x = pack_bf16(s[0], s[1]); o.y = pack_bf16(s[2], s[3]); o.z = pack_bf16(s[4], s[5]); o.w = pack_bf16(s[6], s[7]);
        *(u32x4*)(Wt + (size_t)(n0 + n2) * K + k0 + c * 8) = o;
    }
    __syncthreads();
}

__device__ void phase_prologue(const Params& P, float* lds) {
    const int tid = threadIdx.x, bid = blockIdx.x, nb = gridDim.x;
    unsigned char* ws = P.ws;
    const int T_IN = 2 * 56 * 16, T_OUT = 2 * 16 * 16, T_F1 = 2 * 64 * 16, T_F2 = 2 * 16 * 64;
    const int T_ALL = T_IN + T_OUT + T_F1 + T_F2;
    for (int u = bid; u < T_ALL; u += nb) {
        int v = u;
        if (v < T_IN) { int l = v / (56 * 16); v %= 56 * 16; int tn = v / 16, tk = v % 16;
            pro_transpose_tile(inp(P, 14) + (size_t)l * 1024 * 3464, (bf16_t*)(ws + WS_WIN) + (size_t)l * 3584 * 1024, 1024, 3464, tk * 64, tn * 64, true, lds); continue; }
        v -= T_IN;
        if (v < T_OUT) { int l = v / 256; v %= 256; int tn = v / 16, tk = v % 16;
            pro_transpose_tile(inp(P, 15) + (size_t)l * 1024 * 1024, (bf16_t*)(ws + WS_WOUT) + (size_t)l * 1024 * 1024, 1024, 1024, tk * 64, tn * 64, false, lds); continue; }
        v -= T_OUT;
        if (v < T_F1) { int l = v / 1024; v %= 1024; int tn = v / 16, tk = v % 16;
            pro_transpose_tile(inp(P, 40) + (size_t)l * 1024 * 4096, (bf16_t*)(ws + WS_WFF1) + (size_t)l * 4096 * 1024, 1024, 4096, tk * 64, tn * 64, false, lds); continue; }
        v -= T_F1;
        { int l = v / 1024; v %= 1024; int tn = v / 64, tk = v % 64;
            pro_transpose_tile(inp(P, 41) + (size_t)l * 4096 * 1024, (bf16_t*)(ws + WS_WFF2) + (size_t)l * 1024 * 4096, 4096, 1024, tk * 64, tn * 64, false, lds); }
    }
    for (int u = bid; u < 192; u += nb) {
        const int l = u / 96, n0 = (u % 96) * 64;
        float* sc = lds;
        float* red = lds + 3072;
        for (int i = tid; i < 3072; i += NT) { int c = i >> 10, k = i & 1023; float x = (c == 0) ? inp(P, 9)[k] : inp(P, 8)[(c - 1) * 1024 + k]; sc[i] = siluf(x); }
        __syncthreads();
        const int kg = tid >> 4, nc = tid & 15;
        const float* W = inp(P, 10) + (size_t)l * 1024 * 6144 + n0 + nc * 4;
        f32x4 a0 = {0, 0, 0, 0}, a1 = a0, a2 = a0;
#pragma unroll 4
        for (int k = kg * 32; k < kg * 32 + 32; ++k) {
            const f32x4 w = *(const f32x4*)(W + (size_t)k * 6144);
            a0 += w * sc[k]; a1 += w * sc[1024 + k]; a2 += w * sc[2048 + k];
        }
        *(f32x4*)(red + (kg * 3 + 0) * 64 + nc * 4) = a0;
        *(f32x4*)(red + (kg * 3 + 1) * 64 + nc * 4) = a1;
        *(f32x4*)(red + (kg * 3 + 2) * 64 + nc * 4) = a2;
        __syncthreads();
        if (tid < 192) {
            const int c = tid >> 6, n = tid & 63; float s = 0.f;
            for (int g = 0; g < 32; ++g) s += red[(g * 3 + c) * 64 + n];
            s += inp(P, 11)[l * 6144 + n0 + n];
            ((float*)(ws + WS_MOD))[(l * 3 + c) * 6144 + n0 + n] = s;
        }
        __syncthreads();
    }
    for (int u = bid; u < 2 * 128; u += nb) {
        const int which = u / 128, chunk = u % 128;
        const float* src = inp(P, which ? 6 : 3);
        bf16_t* dst = (bf16_t*)(ws + (which ? WS_CKD : WS_CKN));
        const int e = chunk * 4096 + tid * 8;
        const int c = e & 255, key = (e >> 8) & 511, b = (e >> 17) & 1, layer = e >> 18;
        const float* s = src + ((size_t)((b * 2 + layer) * 512 + key)) * 256 + c;
        const f32x4 x0 = *(const f32x4*)s, x1 = *(const f32x4*)(s + 4);
        u32x4 o; o.x = pack_bf16(x0[0], x0[1]); o.y = pack_bf16(x0[2], x0[3]); o.z = pack_bf16(x1[0], x1[1]); o.w = pack_bf16(x1[2], x1[3]);
        *(u32x4*)(dst + e) = o;
    }
    for (int u = bid; u < 2 * 128; u += nb) {
        const int which = u / 128; int v = u % 128; const int kb = v & 7; v >>= 3; const int h = v & 3; v >>= 2; const int b = v & 1, layer = v >> 1;
        const float* src = inp(P, which ? 7 : 4) + ((size_t)((b * 2 + layer) * 512 + kb * 64)) * 256 + h * 64;
        bf16_t* dst = (bf16_t*)(ws + (which ? WS_CVTD : WS_CVTN)) + ((size_t)((layer * 2 + b) * 4 + h) * 64) * 512 + kb * 64;
        const int dd = tid & 63;
#pragma unroll
        for (int i = 0; i < 8; ++i) { const int key = (tid >> 6) + 8 * i; lds[dd * 65 + key] = src[(size_t)key * 256 + dd]; }
        __syncthreads();
        { const int d2 = tid >> 3, c = tid & 7; const float* s = lds + d2 * 65 + c * 8;
          u32x4 o; o.x = pack_bf16(s[0], s[1]); o.y = pack_bf16(s[2], s[3]); o.z = pack_bf16(s[4], s[5]); o.w = pack_bf16(s[6], s[7]);
          *(u32x4*)(dst + (size_t)d2 * 512 + c * 8) = o; }
        __syncthreads();
    }
    if (bid == 0 && tid < 512) {
        const int p = tid >> 3, f = tid & 7;
        float t = 1.f;
        t = (f == 1) ? 0.31622776601683794f : t; t = (f == 2) ? 0.1f : t; t = (f == 3) ? 0.031622776601683794f : t; t = (f == 4) ? 0.01f : t;
        t = (f == 5) ? 0.0031622776601683794f : t; t = (f == 6) ? 0.001f : t; t = (f == 7) ? 0.00031622776601683794f : t;
        double x = (double)t, x2 = x * x;
        double c = 1.0, s = x, tc = 1.0, tsn = x;
        for (int i = 1; i < 12; ++i) { tc *= -x2 / ((2.0 * i - 1.0) * (2.0 * i)); tsn *= -x2 / ((2.0 * i) * (2.0 * i + 1.0)); c += tc; s += tsn; }
        double cr = 1.0, sr = 0.0;
        for (int i = 0; i < p; ++i) { const double nc2 = cr * c - sr * s, ns2 = sr * c + cr * s; cr = nc2; sr = ns2; }
        float* R = (float*)(ws + WS_ROPE);
        R[(p * 8 + f) * 2 + 0] = (float)cr; R[(p * 8 + f) * 2 + 1] = (float)sr;
    }
}

__device__ void phase_norm(const Params& P, int layer, int which  ) {
    const int tid = threadIdx.x, lane = tid & 63, w = tid >> 6;
    const float* X = (layer == 0 && which == 0) ? nullptr : outp(P);
    const float* gvec = inp(P, which ? 13 : 12) + layer * 1024;
    const float* mod = (const float*)(P.ws + WS_MOD) + (size_t)layer * 3 * 6144;
    bf16_t* HN = (bf16_t*)(P.ws + WS_HN);
    for (int row = blockIdx.x * 8 + w; row < MTOK; row += gridDim.x * 8) {
        const float* xr;
        if (X) xr = X + (size_t)row * 1024; else xr = (row < CTXTOK) ? inp(P, 0) + (size_t)row * 1024 : inp(P, 1) + (size_t)(row - CTXTOK) * 1024;
        const int cond = (row < CTXTOK) ? 0 : 1 + ((row - CTXTOK) >> 11);
        const float* sh = mod + cond * 6144 + (which ? 3072 : 0);
        const float* sc = sh + 1024;
        f32x4 x[4]; float ss = 0.f;
#pragma unroll
        for (int i = 0; i < 4; ++i) { x[i] = *(const f32x4*)(xr + lane * 4 + 256 * i); ss += x[i][0] * x[i][0] + x[i][1] * x[i][1] + x[i][2] * x[i][2] + x[i][3] * x[i][3]; }
        ss = allsum64(ss);
        const float rs = rsqrtf(ss * (1.f / 1024.f) + 1e-6f);
#pragma unroll
        for (int i = 0; i < 4; ++i) {
            const int c = lane * 4 + 256 * i;
            const f32x4 g = *(const f32x4*)(gvec + c), s1 = *(const f32x4*)(sc + c), s0 = *(const f32x4*)(sh + c);
            f32x4 o = x[i] * rs * g * (s1 + 1.f) + s0;
            u32x2 pk; pk.x = pack_bf16(o[0], o[1]); pk.y = pack_bf16(o[2], o[3]);
            *(u32x2*)(HN + (size_t)row * 1024 + c) = pk;
        }
    }
}

constexpr int GS = 72;
template <class Epi>
__device__ void gemm_phase(unsigned char* ldsraw, const bf16_t* __restrict__ A, const bf16_t* __restrict__ Bt, int M, int N, int K, const Epi& epi) {
    bf16_t* lds = (bf16_t*)ldsraw;
    const int tid = threadIdx.x, lane = tid & 63, w = tid >> 6, wm = w >> 1, wn = w & 1, l15 = lane & 15, quad = lane >> 4;
    const int nTM = M / 256, nTN = N / 128, ntiles = nTM * nTN, nk = K / 64;
    constexpr int STAGE = (256 + 128) * GS;
    for (int tile = blockIdx.x; tile < ntiles; tile += gridDim.x) {
        const int tm = tile % nTM, tn = tile / nTM;
        const bf16_t* Ag = A + (size_t)(tm * 256) * K;
        const bf16_t* Bg = Bt + (size_t)(tn * 128) * K;
        u32x4 ra[4], rb[2];
        auto gload = [&](int kt) {
#pragma unroll
            for (int i = 0; i < 4; ++i) { const int p = tid + NT * i, row = p >> 3, kc = p & 7; ra[i] = *(const u32x4*)(Ag + (size_t)row * K + kt * 64 + kc * 8); }
#pragma unroll
            for (int i = 0; i < 2; ++i) { const int p = tid + NT * i, row = p >> 3, kc = p & 7; rb[i] = *(const u32x4*)(Bg + (size_t)row * K + kt * 64 + kc * 8); }
        };
        auto sstore = [&](int st) {
            bf16_t* As = lds + st * STAGE; bf16_t* Bs = As + 256 * GS;
#pragma unroll
            for (int i = 0; i < 4; ++i) { const int p = tid + NT * i, row = p >> 3, kc = p & 7; *(u32x4*)(As + row * GS + kc * 8) = ra[i]; }
#pragma unroll
            for (int i = 0; i < 2; ++i) { const int p = tid + NT * i, row = p >> 3, kc = p & 7; *(u32x4*)(Bs + row * GS + kc * 8) = rb[i]; }
        };
        f32x4 acc[4][4];
#pragma unroll
        for (int i = 0; i < 4; ++i)
#pragma unroll
            for (int j = 0; j < 4; ++j) acc[i][j] = (f32x4){0.f, 0.f, 0.f, 0.f};
        gload(0); sstore(0); __syncthreads();
        for (int kt = 0; kt < nk; ++kt) {
            const bool more = (kt + 1 < nk);
            if (more) gload(kt + 1);
            const bf16_t* As = lds + (kt & 1) * STAGE; const bf16_t* Bs = As + 256 * GS;
#pragma unroll
            for (int ks = 0; ks < 2; ++ks) {
                bf16x8 af[4], bfr[4];
#pragma unroll
                for (int i = 0; i < 4; ++i) af[i] = *(const bf16x8*)(As + (wm * 64 + i * 16 + l15) * GS + ks * 32 + quad * 8);
#pragma unroll
                for (int j = 0; j < 4; ++j) bfr[j] = *(const bf16x8*)(Bs + (wn * 64 + j * 16 + l15) * GS + ks * 32 + quad * 8);
#pragma unroll
                for (int i = 0; i < 4; ++i)
#pragma unroll
                    for (int j = 0; j < 4; ++j) acc[i][j] = __builtin_amdgcn_mfma_f32_16x16x32_bf16(bfr[j], af[i], acc[i][j], 0, 0, 0);
            }
            if (more) sstore((kt + 1) & 1);
            __syncthreads();
        }
#pragma unroll
        for (int i = 0; i < 4; ++i)
#pragma unroll
            for (int j = 0; j < 4; ++j) epi(tm * 256 + wm * 64 + i * 16 + l15, tn * 128 + wn * 64 + j * 16 + quad * 4, acc[i][j]);
    }
}

struct EpiProj { bf16_t* out; __device__ __forceinline__ void operator()(int row, int col, f32x4 v) const {
    u32x2 pk; pk.x = pack_bf16(v[0], v[1]); pk.y = pack_bf16(v[2], v[3]); *(u32x2*)(out + (size_t)row * NPROJ + col) = pk; } };
struct EpiRelu2 { bf16_t* out; __device__ __forceinline__ void operator()(int row, int col, f32x4 v) const {
    f32x4 r; for (int i = 0; i < 4; ++i) { float t = fmaxf(v[i], 0.f); r[i] = t * t; }
    u32x2 pk; pk.x = pack_bf16(r[0], r[1]); pk.y = pack_bf16(r[2], r[3]); *(u32x2*)(out + (size_t)row * DFF + col) = pk; } };
struct EpiResid { const float* x0; const float* x1; float* out; const float* gate;
    __device__ __forceinline__ void operator()(int row, int col, f32x4 v) const {
        const float* xr = x0 ? ((row < CTXTOK) ? x0 + (size_t)row * 1024 : x1 + (size_t)(row - CTXTOK) * 1024) : out + (size_t)row * 1024;
        const int cond = (row < CTXTOK) ? 0 : 1 + ((row - CTXTOK) >> 11);
        const f32x4 g = *(const f32x4*)(gate + cond * 6144 + col);
        const f32x4 xv = *(const f32x4*)(xr + col);
        *(f32x4*)(out + (size_t)row * 1024 + col) = xv + g * v; } };

__device__ void premix_item(const Params& P, int layer, int it, unsigned char* ldsraw) {
    const int tid = threadIdx.x, lane = tid & 63, w = tid >> 6;
    unsigned char* ws = opaque_ws(P);
    const int g0 = it * 32;
    const TokInfo ti = tokinfo(g0);
    const int t0 = ti.t, L = ti.L, sb = ti.seqbase;
    const bf16_t* PROJ = (const bf16_t*)(ws + WS_PROJ);
    float* lds = (float*)ldsraw;
    {
        const int c = tid;
        const float* cw = inp(P, 16) + (size_t)layer * 5 * 512; const float cb = inp(P, 17)[layer * 512 + c];
        float wj[5];
#pragma unroll
        for (int j = 0; j < 5; ++j) wj[j] = cw[j * 512 + c];
        float* XBC = (float*)(ws + WS_XBC);
        auto ld = [&](int t) -> float { return (t >= 0 && t < L) ? bf2f(PROJ[(size_t)(sb + t) * NPROJ + PC_XBC + c]) : 0.f; };
        float x0 = ld(t0 - 2), x1 = ld(t0 - 1), x2 = ld(t0), x3 = ld(t0 + 1);
        for (int tt = 0; tt < 32; ++tt) {
            const float x4 = ld(t0 + tt + 2);
            float v = cb + x0 * wj[0] + x1 * wj[1] + x2 * wj[2] + x3 * wj[3] + x4 * wj[4];
            XBC[(size_t)(g0 + tt) * 512 + c] = siluf(v);
            x0 = x1; x1 = x2; x2 = x3; x3 = x4;
        }
    }
    if (tid < 256) {
        const int tt = tid >> 3, j = tid & 7;
        const float raw = bf2f(PROJ[(size_t)(g0 + tt) * NPROJ + PC_DT + j]);
        const float dtv = softplusf_(raw + inp(P, 19)[layer * 8 + j]);
        const float Aj = -__expf(inp(P, 18)[layer * 8 + j]);
        f32x2 o; o.x = dtv; o.y = __expf(dtv * Aj);
        *(f32x2*)((float*)(ws + WS_DTA) + ((size_t)(g0 + tt) * 8 + j) * 2) = o;
    }
    {
        bf16_t* ZS = (bf16_t*)(ws + WS_ZS);
#pragma unroll
        for (int i = 0; i < 8; ++i) {
            const int e = tid + NT * i, tt = e >> 7, cp = (e & 127) * 2;
            const unsigned u = *(const unsigned*)(PROJ + (size_t)(g0 + tt) * NPROJ + PC_Z + cp);
            const float a = siluf(bf2f((unsigned short)(u & 0xffff))), b = siluf(bf2f((unsigned short)(u >> 16)));
            *(unsigned*)(ZS + (size_t)(g0 + tt) * 256 + cp) = pack_bf16(a, b);
        }
    }
    bf16_t* VS = (bf16_t*)ldsraw;
    {
        const int c4 = lane * 4;
        const f32x4 gq = *(const f32x4*)(inp(P, 22) + layer * 64 + (c4 & 63)), gk = *(const f32x4*)(inp(P, 23) + layer * 64 + (c4 & 63));
        const f32x4 dgq = *(const f32x4*)(inp(P, 36) + layer * 32 + (c4 & 31)), dgk = *(const f32x4*)(inp(P, 37) + layer * 32 + (c4 & 31));
        const float* ROPE = (const float*)(ws + WS_ROPE);
        auto ld4 = [&](const bf16_t* p) -> f32x4 { const u32x2 u = *(const u32x2*)p; f32x4 r; r[0] = bf2f((unsigned short)(u.x & 0xffff)); r[1] = bf2f((unsigned short)(u.x >> 16)); r[2] = bf2f((unsigned short)(u.y & 0xffff)); r[3] = bf2f((unsigned short)(u.y >> 16)); return r; };
        auto st4 = [&](bf16_t* p, f32x4 v) { u32x2 pk; pk.x = pack_bf16(v[0], v[1]); pk.y = pack_bf16(v[2], v[3]); *(u32x2*)p = pk; };
        for (int i = 0; i < 4; ++i) {
            const int tt = w * 4 + i, g = g0 + tt, t = t0 + tt;
            const bf16_t* pr = PROJ + (size_t)g * NPROJ;
            {
                f32x4 q = ld4(pr + PC_NAT + c4), k = ld4(pr + PC_NAT + 256 + c4), v = ld4(pr + PC_NAT + 512 + c4);
                float sq = allsum16(q[0] * q[0] + q[1] * q[1] + q[2] * q[2] + q[3] * q[3]);
                float sk = allsum16(k[0] * k[0] + k[1] * k[1] + k[2] * k[2] + k[3] * k[3]);
                const float rq = rsqrtf(sq * (1.f / 64.f) + 1e-6f) * (0.125f * LOG2E), rk = rsqrtf(sk * (1.f / 64.f) + 1e-6f);
                q = q * rq * gq; k = k * rk * gk;
                st4((bf16_t*)(ws + WS_QN) + (size_t)g * 256 + c4, q);
                st4((bf16_t*)(ws + WS_KN) + (size_t)g * 256 + c4, k);
                if (ti.isctx) {
                    const size_t o = ((size_t)((ti.sidx * 2 + layer) * 256 + t)) * 256 + c4;
                    *(f32x4*)(outp(P) + O_NATK + o) = k; *(f32x4*)(outp(P) + O_NATV + o) = v;
                }
#pragma unroll
                for (int e = 0; e < 4; ++e) VS[(c4 + e) * 40 + tt] = f2bf(v[e]);
            }
            {
                f32x4 q = ld4(pr + PC_DIFF + c4), k = ld4(pr + PC_DIFF + 256 + c4), v = ld4(pr + PC_DIFF + 512 + c4);
                float sq = allsum8(q[0] * q[0] + q[1] * q[1] + q[2] * q[2] + q[3] * q[3]);
                float sk = allsum8(k[0] * k[0] + k[1] * k[1] + k[2] * k[2] + k[3] * k[3]);
                const float rq = rsqrtf(sq * (1.f / 32.f) + 1e-6f), rk = rsqrtf(sk * (1.f / 32.f) + 1e-6f);
                q = q * rq * dgq; k = k * rk * dgk;
                if (ti.isctx) {
                    const size_t o = ((size_t)((ti.sidx * 2 + layer) * 256 + t)) * 256 + c4;
                    *(f32x4*)(outp(P) + O_DIFFK + o) = k; *(f32x4*)(outp(P) + O_DIFFV + o) = v;
                } else {
                    const int blk = (c4 >> 4) & 1, pos = blk ? (t & 63) : (t >> 6), f0 = c4 & 7;
                    const bool isu2 = (lane & 2) != 0;
                    f32x4 qp, kp;
#pragma unroll
                    for (int e = 0; e < 4; ++e) { qp[e] = __shfl_xor(q[e], 2); kp[e] = __shfl_xor(k[e], 2); }
#pragma unroll
                    for (int e = 0; e < 4; ++e) {
                        const f32x2 cs = *(const f32x2*)(ROPE + (pos * 8 + f0 + e) * 2);
                        const float sgn = isu2 ? cs.y : -cs.y;
                        q[e] = q[e] * cs.x + qp[e] * sgn; k[e] = k[e] * cs.x + kp[e] * sgn;
                    }
                }
                q = q * (0.17677669529663687f * LOG2E);
                st4((bf16_t*)(ws + WS_QD) + (size_t)g * 256 + c4, q);
                st4((bf16_t*)(ws + WS_KD) + (size_t)g * 256 + c4, k);
#pragma unroll
                for (int e = 0; e < 4; ++e) VS[256 * 40 + (c4 + e) * 40 + tt] = f2bf(v[e]);
            }
        }
        __syncthreads();
        {
            const int ch = tid >> 1, hf = tid & 1, h = ch >> 6, d = ch & 63;
            size_t o;
            if (ti.isctx) o = ((size_t)((ti.sidx * 4 + h) * 64 + d)) * 256 + t0 + hf * 16;
            else o = (size_t)1048576 + ((size_t)((ti.sidx * 4 + h) * 64 + d)) * 2048 + t0 + hf * 16;
#pragma unroll
            for (int a = 0; a < 2; ++a) {
                const bf16_t* s = VS + a * 256 * 40 + ch * 40 + hf * 16;
                bf16_t* dst = (bf16_t*)(ws + (a ? WS_VTD : WS_VTN)) + o;
                *(u32x4*)dst = *(const u32x4*)s; *(u32x4*)(dst + 8) = *(const u32x4*)(s + 8);
            }
        }
        __syncthreads();
    }
    {
        float* LR = lds;
        const float* cwr = inp(P, 25) + (size_t)layer * 3 * 1152;
        if (tid < 384) {
            const int lc = tid, ch = 768 + lc;
            const float w0 = cwr[ch], w1 = cwr[1152 + ch], w2 = cwr[2304 + ch];
            auto ld = [&](int t) -> float { return (t >= 0 && t < L) ? bf2f(PROJ[(size_t)(sb + t) * NPROJ + PC_RW + ch]) : 0.f; };
            float x0 = ld(t0 - 1), x1 = ld(t0);
            for (int tt = 0; tt < 32; ++tt) {
                const float x2 = ld(t0 + tt + 1);
                float v = x0 * w0 + x1 * w1 + x2 * w2;
                v = (lc < 128) ? tanhf(v) : ((lc < 256) ? v : sigmoidf_(v));
                LR[tt * 384 + lc] = v;
                x0 = x1; x1 = x2;
            }
        }
        __syncthreads();
        const int hf = tid >> 8, c = tid & 255, head = c >> 6;
        float* RW = (float*)(ws + WS_RW);
        const size_t A_ = (size_t)MTOK * 256;
        float* pR = RW, *pKK = RW + A_, *pV = RW + 2 * A_, *pDEC = RW + (3 + hf) * A_, *pKKA = RW + (5 + hf) * A_, *pKT = RW + (7 + hf) * A_, *pG = RW + 9 * A_;
        const float* wup = inp(P, 27) + ((size_t)(layer * 2 + hf) * 64) * 256 + c;
        const float* aup = inp(P, 29) + ((size_t)(layer * 2 + hf) * 64) * 256 + c;
        const float w0c = inp(P, 26)[(layer * 2 + hf) * 256 + c], a0c = inp(P, 28)[(layer * 2 + hf) * 256 + c];
        const float kkc = inp(P, 31)[layer * 256 + c], kac = inp(P, 32)[layer * 256 + c], rkc = inp(P, 33)[layer * 256 + c];
        const int chk = 256 + c, cho = hf ? 512 + c : c;
        const float k0w = cwr[chk], k1w = cwr[1152 + chk], k2w = cwr[2304 + chk];
        const float o0w = cwr[cho], o1w = cwr[1152 + cho], o2w = cwr[2304 + cho];
        auto ldk = [&](int t) -> float { return (t >= 0 && t < L) ? bf2f(PROJ[(size_t)(sb + t) * NPROJ + PC_RW + chk]) : 0.f; };
        auto ldo = [&](int t) -> float { return (t >= 0 && t < L) ? bf2f(PROJ[(size_t)(sb + t) * NPROJ + PC_RW + cho]) : 0.f; };
        for (int th = 0; th < 2; ++th) {
            float wsum[16], asum[16];
#pragma unroll
            for (int i = 0; i < 16; ++i) { wsum[i] = 0.f; asum[i] = 0.f; }
            for (int i = 0; i < 64; i += 4) {
                const float wa = wup[(size_t)i * 256], wb = wup[(size_t)(i + 1) * 256], wc = wup[(size_t)(i + 2) * 256], wd = wup[(size_t)(i + 3) * 256];
                const float aa = aup[(size_t)i * 256], ab = aup[(size_t)(i + 1) * 256], ac = aup[(size_t)(i + 2) * 256], ad = aup[(size_t)(i + 3) * 256];
#pragma unroll
                for (int tt = 0; tt < 16; ++tt) {
                    const f32x4 lw = *(const f32x4*)(LR + (th * 16 + tt) * 384 + hf * 64 + i);
                    const f32x4 la = *(const f32x4*)(LR + (th * 16 + tt) * 384 + 128 + hf * 64 + i);
                    wsum[tt] += lw[0] * wa + lw[1] * wb + lw[2] * wc + lw[3] * wd;
                    asum[tt] += la[0] * aa + la[1] * ab + la[2] * ac + la[3] * ad;
                }
            }
            const int tb = t0 + th * 16;
            float xk0 = ldk(tb - 1), xk1 = ldk(tb), xo0 = ldo(tb - 1), xo1 = ldo(tb);
#pragma unroll
            for (int tt = 0; tt < 16; ++tt) {
                const float xk2 = ldk(tb + tt + 1), xo2 = ldo(tb + tt + 1);
                const float kv = xk0 * k0w + xk1 * k1w + xk2 * k2w;
                const float ov = xo0 * o0w + xo1 * o1w + xo2 * o2w;
                xk0 = xk1; xk1 = xk2; xo0 = xo1; xo1 = xo2;
                const float s = kv * kkc;
                const float ssum = allsum64(s * s);
                const float kk = s / fmaxf(sqrtf(ssum), 1e-12f);
                const float wl = -softplusf_(-(w0c + wsum[tt])) - 0.5f;
                const float dec = __expf(-__expf(wl));
                const float a = sigmoidf_(a0c + asum[tt]);
                const size_t o = (size_t)(g0 + th * 16 + tt) * 256 + c;
                pDEC[o] = dec; pKKA[o] = kk * a; pKT[o] = kv * (1.f + (a - 1.f) * kac);
                if (hf == 0) {
                    pKK[o] = kk; pR[o] = ov;
                    const float bsum = allsum64(ov * kv * rkc);
                    if (lane == 0) ((float*)(ws + WS_BON))[(size_t)(g0 + th * 16 + tt) * 4 + head] = bsum;
                } else pV[o] = ov;
            }
        }
        {
            float gs[16];
#pragma unroll
            for (int i = 0; i < 16; ++i) gs[i] = 0.f;
            const float* gup = inp(P, 30) + (size_t)layer * 128 * 256 + c;
            for (int i = 0; i < 128; i += 4) {
                const float ga = gup[(size_t)i * 256], gb = gup[(size_t)(i + 1) * 256], gc = gup[(size_t)(i + 2) * 256], gd = gup[(size_t)(i + 3) * 256];
#pragma unroll
                for (int tt = 0; tt < 16; ++tt) {
                    const f32x4 lg = *(const f32x4*)(LR + (hf * 16 + tt) * 384 + 256 + i);
                    gs[tt] += lg[0] * ga + lg[1] * gb + lg[2] * gc + lg[3] * gd;
                }
            }
#pragma unroll
            for (int tt = 0; tt < 16; ++tt) pG[(size_t)(g0 + hf * 16 + tt) * 256 + c] = gs[tt];
        }
        __syncthreads();
    }
}

__device__ void rwkv_scan_item(const Params& P, int layer, int sidx_all  , int dir, int h, int rh, unsigned char* ldsraw) {
    const int tid = threadIdx.x, lane = tid & 63, w = tid >> 6, ks = lane & 15, rl = w * 4 + (lane >> 4);
    const bool isctx = sidx_all < 16;
    const int L = isctx ? 256 : 2048, sb = isctx ? sidx_all * 256 : CTXTOK + (sidx_all - 16) * 2048, nch = L / 16;
    const size_t A_ = (size_t)MTOK * 256;
    unsigned char* ws = opaque_ws(P);
    const float* RW = (const float*)(ws + WS_RW);
    float* Y = (float*)(ws + (dir ? WS_YRB : WS_YRF));
    float* lds = (float*)ldsraw;
    constexpr int REC = 352, CH = 16 * REC;
    const float* src[3]; int sj[3]; bool pv[3];
#pragma unroll
    for (int j = 0; j < 3; ++j) {
        const int q = tid + NT * j; pv[j] = q < 1408;
        const int s = q / 88, ww = q % 88, vec = ww >> 4, off = (ww & 15) * 4;
        sj[j] = s;
        const float* base;
        if (vec == 0) base = RW + (3 + dir) * A_; else if (vec == 1) base = RW + A_; else if (vec == 2) base = RW + (5 + dir) * A_; else if (vec == 3) base = RW + (7 + dir) * A_; else if (vec == 4) base = RW; else base = RW + 2 * A_;
        src[j] = base + h * 64 + ((vec == 5) ? (32 * rh + (ww - 80) * 4) : off);
    }
    auto tok = [&](int n) -> int { return sb + (dir ? (L - 1 - n) : n); };
    auto gl = [&](int c, f32x4 (&r)[3]) {
#pragma unroll
        for (int j = 0; j < 3; ++j) if (pv[j]) r[j] = *(const f32x4*)(src[j] + (size_t)tok(c * 16 + sj[j]) * 256);
    };
    auto st = [&](int buf, const f32x4 (&r)[3]) {
#pragma unroll
        for (int j = 0; j < 3; ++j) if (pv[j]) *(f32x4*)(lds + buf * CH + (tid + NT * j) * 4) = r[j];
    };
    f32x4 S;
    const int b = isctx ? sidx_all : sidx_all - 16;
    const int row = 32 * rh + rl;
    if (isctx) S = (f32x4){0.f, 0.f, 0.f, 0.f};
    else S = *(const f32x4*)(inp(P, 5) + ((size_t)(((b * 2 + layer) * 2 + dir) * 4 + h) * 64 + row) * 64 + ks * 4);
    f32x4 ra[3], rb[3];
    gl(0, ra); st(0, ra); __syncthreads();
    gl(1, ra); if (nch > 2) gl(2, rb);
    auto compute = [&](int buf, int c) {
        const float* base = lds + buf * CH;
        float yk = 0.f;
#pragma unroll
        for (int s = 0; s < 16; ++s) {
            const float* rec = base + s * REC;
            const f32x4 dec = *(const f32x4*)(rec + ks * 4), kk = *(const f32x4*)(rec + 64 + ks * 4), kka = *(const f32x4*)(rec + 128 + ks * 4),
                        kt = *(const f32x4*)(rec + 192 + ks * 4), r = *(const f32x4*)(rec + 256 + ks * 4);
            const float v = rec[320 + rl];
            float d = S[0] * kk[0] + S[1] * kk[1] + S[2] * kk[2] + S[3] * kk[3];
            const f32x4 U = S * dec + kt * v;
            d = allsum16(d);
            S = U - kka * d;
            float y = S[0] * r[0] + S[1] * r[1] + S[2] * r[2] + S[3] * r[3];
            y = allsum16(y);
            yk = (ks == s) ? y : yk;
        }
        Y[(size_t)tok(c * 16 + ks) * 256 + h * 64 + row] = yk;
    };
    for (int c = 0; c < nch; c += 2) {
        st(1, ra); if (c + 3 < nch) gl(c + 3, ra);
        compute(0, c);
        __syncthreads();
        if (c + 2 < nch) st(0, rb); if (c + 4 < nch) gl(c + 4, rb);
        compute(1, c + 1);
        __syncthreads();
    }
    if (isctx) *(f32x4*)(outp(P) + O_RWKV + ((size_t)(((b * 2 + layer) * 2 + dir) * 4 + h) * 64 + row) * 64 + ks * 4) = S;
}

__device__ void ssd_scan_item(const Params& P, int layer, int sidx_all, int dir, int h, int rh, unsigned char* ldsraw) {
    const int tid = threadIdx.x, lane = tid & 63, w = tid >> 6, ks = lane & 15, rl = w * 4 + (lane >> 4);
    const bool isctx = sidx_all < 16;
    const int L = isctx ? 256 : 2048, sb = isctx ? sidx_all * 256 : CTXTOK + (sidx_all - 16) * 2048, nch = L / 16;
    unsigned char* ws = opaque_ws(P);
    const float* XBC = (const float*)(ws + WS_XBC);
    const float* DTA = (const float*)(ws + WS_DTA);
    float* Y = (float*)(ws + (dir ? WS_YSB : WS_YSF));
    float* lds = (float*)ldsraw;
    constexpr int REC = 164, CH = 16 * REC;
    const int grp = h >> 1;
    int sj[2], kind[2]; const float* src[2]; bool pv[2];
#pragma unroll
    for (int j = 0; j < 2; ++j) {
        const int q = tid + NT * j; pv[j] = q < 656;
        const int s = q / 41, ww = q % 41; sj[j] = s;
        if (ww < 16) { kind[j] = 0; src[j] = XBC + 256 + grp * 64 + ww * 4; }
        else if (ww < 32) { kind[j] = 0; src[j] = XBC + 384 + grp * 64 + (ww - 16) * 4; }
        else if (ww < 40) { kind[j] = 0; src[j] = XBC + h * 64 + 32 * rh + (ww - 32) * 4; }
        else { kind[j] = 1; src[j] = DTA + (dir * 4 + h) * 2; }
    }
    auto tok = [&](int n) -> int { return sb + (dir ? (L - 1 - n) : n); };
    auto gl = [&](int c, f32x4 (&r)[2]) {
#pragma unroll
        for (int j = 0; j < 2; ++j) if (pv[j]) {
            const int tk = tok(c * 16 + sj[j]);
            if (kind[j] == 0) r[j] = *(const f32x4*)(src[j] + (size_t)tk * 512);
            else { const f32x2 t2 = *(const f32x2*)(src[j] + (size_t)tk * 16); r[j] = (f32x4){t2.x, t2.y, 0.f, 0.f}; }
        }
    };
    auto st = [&](int buf, const f32x4 (&r)[2]) {
#pragma unroll
        for (int j = 0; j < 2; ++j) if (pv[j]) *(f32x4*)(lds + buf * CH + (tid + NT * j) * 4) = r[j];
    };
    f32x4 Hs;
    const int b = isctx ? sidx_all : sidx_all - 16;
    const int row = 32 * rh + rl;
    if (isctx) Hs = (f32x4){0.f, 0.f, 0.f, 0.f};
    else Hs = *(const f32x4*)(inp(P, 2) + ((size_t)(((b * 2 + layer) * 2 + dir) * 4 + h) * 64 + row) * 64 + ks * 4);
    f32x4 ra[2], rb[2];
    gl(0, ra); st(0, ra); __syncthreads();
    gl(1, ra); if (nch > 2) gl(2, rb);
    auto compute = [&](int buf, int c) {
        const float* base = lds + buf * CH;
        float yk = 0.f;
#pragma unroll
        for (int s = 0; s < 16; ++s) {
            const float* rec = base + s * REC;
            const f32x4 Bv = *(const f32x4*)(rec + ks * 4), Cv = *(const f32x4*)(rec + 64 + ks * 4);
            const float x = rec[128 + rl], dt = rec[160], a = rec[161];
            Hs = Hs * a + Bv * (x * dt);
            float y = Hs[0] * Cv[0] + Hs[1] * Cv[1] + Hs[2] * Cv[2] + Hs[3] * Cv[3];
            y = allsum16(y);
            yk = (ks == s) ? y : yk;
        }
        Y[(size_t)tok(c * 16 + ks) * 256 + h * 64 + row] = yk;
    };
    for (int c = 0; c < nch; c += 2) {
        st(1, ra); if (c + 3 < nch) gl(c + 3, ra);
        compute(0, c);
        __syncthreads();
        if (c + 2 < nch) st(0, rb); if (c + 4 < nch) gl(c + 4, rb);
        compute(1, c + 1);
        __syncthreads();
    }
    if (isctx) *(f32x4*)(outp(P) + O_SSD + ((size_t)(((b * 2 + layer) * 2 + dir) * 4 + h) * 64 + row) * 64 + ks * 4) = Hs;
}

template <int MODE>
__device__ void attn_item(const Params& P, int layer, int idx, unsigned char* ldsraw) {
    constexpr bool DIFF = MODE >= 2, LAT = (MODE & 1) != 0;
    const int tid = threadIdx.x, lane = tid & 63, w = tid >> 6, l15 = lane & 15, quad = lane >> 4;
    unsigned char* ws = opaque_ws(P);
    int sidx, h, qb;
    if (LAT) { qb = idx & 15; h = (idx >> 4) & 3; sidx = idx >> 6; }
    else { qb = idx & 1; h = (idx >> 1) & 3; sidx = idx >> 3; }
    const int sb = LAT ? CTXTOK + sidx * 2048 : sidx * 256;
    const int Lseq = LAT ? 2048 : 256;
    const bf16_t* Q = (const bf16_t*)(ws + (DIFF ? WS_QD : WS_QN));
    const bf16_t* KX = (const bf16_t*)(ws + (DIFF ? WS_KD : WS_KN));
    const bf16_t* VT = (const bf16_t*)(ws + (DIFF ? WS_VTD : WS_VTN));
    const bf16_t* CK = (const bf16_t*)(ws + (DIFF ? WS_CKD : WS_CKN));
    const bf16_t* CVT = (const bf16_t*)(ws + (DIFF ? WS_CVTD : WS_CVTN));
    bf16_t* MIX = (bf16_t*)(ws + WS_HN);
    bf16_t* lds = (bf16_t*)ldsraw;
    constexpr int TS = 64 * GS;
    float* RB = (float*)(ldsraw + 4 * TS * 2);
    int base0 = 0, nlat = 0;
    if (MODE == 1) { const int r0 = 2 * qb; const int b0 = min(max(r0 - 4, 0), 24), b1 = min(max(r0 - 3, 0), 24); base0 = b0; nlat = b1 + 8 - b0;
        for (int i = tid; i < 465; i += NT) RB[i] = inp(P, 24)[((size_t)(layer * 4 + h)) * 465 + i] * LOG2E; }
    const int ntiles = (MODE == 0 || MODE == 2) ? 4 : (MODE == 1 ? 8 + nlat : 40);
    const int qt = qb * 128 + w * 16;
    const bf16_t* qp = Q + (size_t)(sb + qt + l15) * 256 + h * 64 + quad * 8;
    const bf16x8 qf0 = *(const bf16x8*)qp, qf1 = *(const bf16x8*)(qp + 32);
    const int lrow = tid >> 3, lpc = tid & 7;
    u32x4 rk, rv;
    auto gload = [&](int i) {
        const bf16_t* kp; const bf16_t* vp;
        if (!LAT) { kp = KX + (size_t)(sb + 64 * i + lrow) * 256 + h * 64; vp = VT + ((size_t)((sidx * 4 + h) * 64 + lrow)) * 256 + 64 * i; }
        else if (i < 8) { kp = CK + ((size_t)((layer * 2 + sidx) * 512 + 64 * i + lrow)) * 256 + h * 64; vp = CVT + ((size_t)(((layer * 2 + sidx) * 4 + h) * 64 + lrow)) * 512 + 64 * i; }
        else { const int kr = (MODE == 1) ? base0 + (i - 8) : (i - 8);
            kp = KX + (size_t)(sb + 64 * kr + lrow) * 256 + h * 64; vp = VT + (size_t)1048576 + ((size_t)((sidx * 4 + h) * 64 + lrow)) * 2048 + 64 * kr; }
        rk = *(const u32x4*)(kp + lpc * 8); rv = *(const u32x4*)(vp + lpc * 8);
    };
    auto sstore = [&](int st) { *(u32x4*)(lds + st * 2 * TS + lrow * GS + lpc * 8) = rk; *(u32x4*)(lds + st * 2 * TS + TS + lrow * GS + lpc * 8) = rv; };
    float mA = -INFINITY, lA = 0.f, mB = -INFINITY, lB = 0.f;
    f32x4 oA[4], oB[4];
#pragma unroll
    for (int i = 0; i < 4; ++i) { oA[i] = (f32x4){0.f, 0.f, 0.f, 0.f}; oB[i] = oA[i]; }
    const int qr = qt >> 6, qc = (qt & 63) + l15;
    const int qbase = min(max(qr - 4, 0), 24), cs = min(max(qc - 8, 0), 48);
    gload(0); sstore(0); __syncthreads();
    for (int i = 0; i < ntiles; ++i) {
        const bool more = i + 1 < ntiles;
        if (more) gload(i + 1);
        const bf16_t* Ks = lds + (i & 1) * 2 * TS; const bf16_t* Vs = Ks + TS;
        bool active = true; int kr = 0;
        if (MODE == 1 && i >= 8) { kr = base0 + (i - 8); active = (kr >= qbase) && (kr < qbase + 8); }
        if (active) {
            f32x4 sA[4], sB[4];
#pragma unroll
            for (int g = 0; g < 4; ++g) {
                const bf16x8 kf0 = *(const bf16x8*)(Ks + (16 * g + l15) * GS + quad * 8), kf1 = *(const bf16x8*)(Ks + (16 * g + l15) * GS + 32 + quad * 8);
                sA[g] = __builtin_amdgcn_mfma_f32_16x16x32_bf16(kf0, qf0, (f32x4){0.f, 0.f, 0.f, 0.f}, 0, 0, 0);
                if (DIFF) sB[g] = __builtin_amdgcn_mfma_f32_16x16x32_bf16(kf1, qf1, (f32x4){0.f, 0.f, 0.f, 0.f}, 0, 0, 0);
                else sA[g] = __builtin_amdgcn_mfma_f32_16x16x32_bf16(kf1, qf1, sA[g], 0, 0, 0);
            }
            if (MODE == 1 && i >= 8) {
                const float* rb = RB + (kr - qr + 7) * 31 + 15 - qc;
#pragma unroll
                for (int g = 0; g < 4; ++g)
#pragma unroll
                    for (int r = 0; r < 4; ++r) { const int kc = 16 * g + 4 * quad + r; const bool ok = (kc >= cs) && (kc < cs + 16);
                        sA[g][r] = ok ? sA[g][r] + rb[ok ? kc : qc] : -INFINITY; }
            }
            u32x2 pA[4], pB[4];
            {
                float mx = -INFINITY;
#pragma unroll
                for (int g = 0; g < 4; ++g) mx = fmaxf(mx, fmaxf(fmaxf(sA[g][0], sA[g][1]), fmaxf(sA[g][2], sA[g][3])));
                mx = allmax_q(mx);
                const float mn = fmaxf(mA, mx), al = __builtin_amdgcn_exp2f(mA - mn); mA = mn;
                float rs = 0.f;
#pragma unroll
                for (int g = 0; g < 4; ++g) { f32x4 p; for (int r = 0; r < 4; ++r) { p[r] = __builtin_amdgcn_exp2f(sA[g][r] - mn); rs += p[r]; } pA[g].x = pack_bf16(p[0], p[1]); pA[g].y = pack_bf16(p[2], p[3]); }
                lA = lA * al + rs;
#pragma unroll
                for (int db = 0; db < 4; ++db) oA[db] = oA[db] * al;
            }
            if (DIFF) {
                float mx = -INFINITY;
#pragma unroll
                for (int g = 0; g < 4; ++g) mx = fmaxf(mx, fmaxf(fmaxf(sB[g][0], sB[g][1]), fmaxf(sB[g][2], sB[g][3])));
                mx = allmax_q(mx);
                const float mn = fmaxf(mB, mx), al = __builtin_amdgcn_exp2f(mB - mn); mB = mn;
                float rs = 0.f;
#pragma unroll
                for (int g = 0; g < 4; ++g) { f32x4 p; for (int r = 0; r < 4; ++r) { p[r] = __builtin_amdgcn_exp2f(sB[g][r] - mn); rs += p[r]; } pB[g].x = pack_bf16(p[0], p[1]); pB[g].y = pack_bf16(p[2], p[3]); }
                lB = lB * al + rs;
#pragma unroll
                for (int db = 0; db < 4; ++db) oB[db] = oB[db] * al;
            }
#pragma unroll
            for (int kk = 0; kk < 2; ++kk) {
                u32x4 pfa; pfa.x = pA[2 * kk].x; pfa.y = pA[2 * kk].y; pfa.z = pA[2 * kk + 1].x; pfa.w = pA[2 * kk + 1].y;
                u32x4 pfb; if (DIFF) { pfb.x = pB[2 * kk].x; pfb.y = pB[2 * kk].y; pfb.z = pB[2 * kk + 1].x; pfb.w = pB[2 * kk + 1].y; }
#pragma unroll
                for (int db = 0; db < 4; ++db) {
                    const bf16_t* vp = Vs + (16 * db + l15) * GS + 32 * kk + 4 * quad;
                    const u32x2 v0 = *(const u32x2*)vp, v1 = *(const u32x2*)(vp + 16);
                    u32x4 vf; vf.x = v0.x; vf.y = v0.y; vf.z = v1.x; vf.w = v1.y;
                    oA[db] = __builtin_amdgcn_mfma_f32_16x16x32_bf16(__builtin_bit_cast(bf16x8, vf), __builtin_bit_cast(bf16x8, pfa), oA[db], 0, 0, 0);
                    if (DIFF) oB[db] = __builtin_amdgcn_mfma_f32_16x16x32_bf16(__builtin_bit_cast(bf16x8, vf), __builtin_bit_cast(bf16x8, pfb), oB[db], 0, 0, 0);
                }
            }
        }
        if (more) sstore((i + 1) & 1);
        __syncthreads();
    }
    const float iA = 1.f / allsum_q(lA);
    bf16_t* op = MIX + (size_t)(sb + qt + l15) * 1024 + (DIFF ? 768 : 256) + h * 64 + quad * 4;
    if (!DIFF) {
#pragma unroll
        for (int db = 0; db < 4; ++db) { const f32x4 o = oA[db] * iA; u32x2 pk; pk.x = pack_bf16(o[0], o[1]); pk.y = pack_bf16(o[2], o[3]); *(u32x2*)(op + 16 * db) = pk; }
    } else {
        const float iB = 1.f / allsum_q(lB);
        float la_ = 0.f, lb_ = 0.f;
        if (lane < 32) { const float* lv = inp(P, 38) + layer * 128; la_ = lv[lane] * lv[32 + lane]; lb_ = lv[64 + lane] * lv[96 + lane]; }
        la_ = allsum64(la_); lb_ = allsum64(lb_);
        const float lam_init = layer == 0 ? 0.2f : (0.8f - 0.6f * 0.7408182206817179f);
        const float lam = __expf(la_) - __expf(lb_) + lam_init;
        f32x4 o[4]; float ssq = 0.f;
#pragma unroll
        for (int db = 0; db < 4; ++db) { o[db] = oA[db] * iA - oB[db] * (iB * lam); ssq += o[db][0] * o[db][0] + o[db][1] * o[db][1] + o[db][2] * o[db][2] + o[db][3] * o[db][3]; }
        ssq = allsum_q(ssq);
        const float rs = rsqrtf(ssq * (1.f / 64.f) + 1e-6f) * (1.f - lam_init);
#pragma unroll
        for (int db = 0; db < 4; ++db) { const f32x4 g = *(const f32x4*)(inp(P, 39) + layer * 64 + 16 * db + quad * 4); const f32x4 r = o[db] * rs * g;
            u32x2 pk; pk.x = pack_bf16(r[0], r[1]); pk.y = pack_bf16(r[2], r[3]); *(u32x2*)(op + 16 * db) = pk; }
    }
    __syncthreads();
}

__device__ void phase_mix(const Params& P, int layer, unsigned char* ldsraw) {
    unsigned* ctr = (unsigned*)(P.ws + WS_CTL) + 64 * (1 + layer);
    volatile unsigned* s_item = (volatile unsigned*)(ldsraw + LDS_BYTES - 16);
    for (;;) {
        if (threadIdx.x == 0) *s_item = atomicAdd(ctr, 1u);
        __syncthreads();
        const int it = (int)*s_item;
        __syncthreads();
        if (it >= 1088) break;
        if (it < 32) { const int rh = it & 1, h = (it >> 1) & 3, d = (it >> 3) & 1, b = it >> 4; rwkv_scan_item(P, layer, 16 + b, d, h, rh, ldsraw); }
        else if (it < 64) { const int v = it - 32; const int rh = v & 1, h = (v >> 1) & 3, d = (v >> 3) & 1, b = v >> 4; ssd_scan_item(P, layer, 16 + b, d, h, rh, ldsraw); }
        else if (it < 192) attn_item<3>(P, layer, it - 64, ldsraw);
        else if (it < 320) attn_item<1>(P, layer, it - 192, ldsraw);
        else if (it < 576) { const int v = it - 320; const int rh = v & 1, h = (v >> 1) & 3, d = (v >> 3) & 1, s = v >> 4; rwkv_scan_item(P, layer, s, d, h, rh, ldsraw); }
        else if (it < 832) { const int v = it - 576; const int rh = v & 1, h = (v >> 1) & 3, d = (v >> 3) & 1, s = v >> 4; ssd_scan_item(P, layer, s, d, h, rh, ldsraw); }
        else if (it < 960) attn_item<2>(P, layer, it - 832, ldsraw);
        else attn_item<0>(P, layer, it - 960, ldsraw);
    }
}

__device__ void phase_post(const Params& P, int layer) {
    const int tid = threadIdx.x, lane = tid & 63, w = tid >> 6, c4 = lane * 4, head = lane >> 4;
    unsigned char* ws = opaque_ws(P);
    const float* YSF = (const float*)(ws + WS_YSF), *YSB = (const float*)(ws + WS_YSB), *YRF = (const float*)(ws + WS_YRF), *YRB = (const float*)(ws + WS_YRB);
    const float* XBC = (const float*)(ws + WS_XBC);
    const bf16_t* ZS = (const bf16_t*)(ws + WS_ZS);
    const float* RW = (const float*)(ws + WS_RW);
    const size_t A_ = (size_t)MTOK * 256;
    const float* BON = (const float*)(ws + WS_BON);
    bf16_t* MIX = (bf16_t*)(ws + WS_HN);
    const float Dh = inp(P, 20)[layer * 4 + head];
    const f32x4 ng = *(const f32x4*)(inp(P, 21) + layer * 256 + c4);
    const f32x4 lg = *(const f32x4*)(inp(P, 34) + layer * 256 + c4), lb = *(const f32x4*)(inp(P, 35) + layer * 256 + c4);
    for (int g = blockIdx.x * 8 + w; g < MTOK; g += gridDim.x * 8) {
        const size_t o = (size_t)g * 256 + c4;
        {
            f32x4 y = *(const f32x4*)(YSF + o) + *(const f32x4*)(YSB + o) + *(const f32x4*)(XBC + (size_t)g * 512 + c4) * Dh;
            const u32x2 z = *(const u32x2*)(ZS + o);
            y[0] *= bf2f((unsigned short)(z.x & 0xffff)); y[1] *= bf2f((unsigned short)(z.x >> 16)); y[2] *= bf2f((unsigned short)(z.y & 0xffff)); y[3] *= bf2f((unsigned short)(z.y >> 16));
            const float ss = allsum64(y[0] * y[0] + y[1] * y[1] + y[2] * y[2] + y[3] * y[3]);
            y = y * rsqrtf(ss * (1.f / 256.f) + 1e-6f) * ng;
            u32x2 pk; pk.x = pack_bf16(y[0], y[1]); pk.y = pack_bf16(y[2], y[3]);
            *(u32x2*)(MIX + (size_t)g * 1024 + c4) = pk;
        }
        {
            f32x4 y = *(const f32x4*)(YRF + o) + *(const f32x4*)(YRB + o);
            const float mu = allsum16(y[0] + y[1] + y[2] + y[3]) * (1.f / 64.f);
            const f32x4 dlt = y - mu;
            const float var = allsum16(dlt[0] * dlt[0] + dlt[1] * dlt[1] + dlt[2] * dlt[2] + dlt[3] * dlt[3]) * (1.f / 64.f);
            f32x4 r = dlt * rsqrtf(var + 64e-5f) * lg + lb;
            r = r + *(const f32x4*)(RW + 2 * A_ + o) * BON[(size_t)g * 4 + head];
            r = r * *(const f32x4*)(RW + 9 * A_ + o);
            u32x2 pk; pk.x = pack_bf16(r[0], r[1]); pk.y = pack_bf16(r[2], r[3]);
            *(u32x2*)(MIX + (size_t)g * 1024 + 512 + c4) = pk;
        }
    }
}

constexpr int NPHASE = 19;
__device__ void run_phase(const Params& P, int ph, unsigned char* lds) {
    unsigned char* ws = opaque_ws(P);
    if (ph == 0) { phase_prologue(P, (float*)lds); return; }
    const int layer = (ph - 1) / 9, sub = (ph - 1) % 9;
#ifdef ONLY_SUB
    if (sub != ONLY_SUB) return;
#endif
    const float* mod = (const float*)(ws + WS_MOD) + (size_t)layer * 3 * 6144;
    switch (sub) {
    case 0: phase_norm(P, layer, 0); break;
    case 1: { EpiProj e{(bf16_t*)(ws + WS_PROJ)}; gemm_phase(lds, (const bf16_t*)(ws + WS_HN), (const bf16_t*)(ws + WS_WIN) + (size_t)layer * 3584 * 1024, MTOK, NPROJ, 1024, e); } break;
    case 2: for (int it = blockIdx.x; it < 256; it += gridDim.x) premix_item(P, layer, it, lds); break;
    case 3: phase_mix(P, layer, lds); break;
    case 4: phase_post(P, layer); break;
    case 5: { EpiResid e{layer == 0 ? inp(P, 0) : nullptr, inp(P, 1), outp(P), mod + 2048}; gemm_phase(lds, (const bf16_t*)(ws + WS_HN), (const bf16_t*)(ws + WS_WOUT) + (size_t)layer * 1024 * 1024, MTOK, 1024, 1024, e); } break;
    case 6: phase_norm(P, layer, 1); break;
    case 7: { EpiRelu2 e{(bf16_t*)(ws + WS_H)}; gemm_phase(lds, (const bf16_t*)(ws + WS_HN), (const bf16_t*)(ws + WS_WFF1) + (size_t)layer * 4096 * 1024, MTOK, DFF, 1024, e); } break;
    case 8: { EpiResid e{nullptr, nullptr, outp(P), mod + 5120}; gemm_phase(lds, (const bf16_t*)(ws + WS_H), (const bf16_t*)(ws + WS_WFF2) + (size_t)layer * 1024 * 4096, MTOK, 1024, 4096, e); } break;
    }
}

__global__ void __launch_bounds__(NT, 2) mk_kernel(Params P) {
    extern __shared__ __attribute__((aligned(16))) unsigned char lds[];
#if MK_MULTI
    run_phase(P, P.ph_lo, lds);
#else
    cg::grid_group grid = cg::this_grid();
    for (int ph = P.ph_lo; ph < P.ph_hi; ++ph) {
        run_phase(P, ph, lds);
        if (ph + 1 < P.ph_hi) grid.sync();
    }
#endif
}

extern "C" void kernel_launch(void* const* d_in, const int* in_sizes, int n_in, void* d_out, int out_size, void* d_ws, size_t ws_size, hipStream_t stream) {
    static int grid = 0;
    if (grid == 0) {
        if (n_in != 42 || ws_size < WS_END) { fprintf(stderr, "kernel_launch: unexpected n_in %d / ws_size %zu (need %zu)\n", n_in, ws_size, (size_t)WS_END); grid = -1; return; }
        int dev = 0, cus = 0, per_cu = 0;
        hipGetDevice(&dev); hipDeviceGetAttribute(&cus, hipDeviceAttributeMultiprocessorCount, dev);
        if (hipFuncSetAttribute((const void*)mk_kernel, hipFuncAttributeMaxDynamicSharedMemorySize, LDS_BYTES) != hipSuccess) { fprintf(stderr, "hipFuncSetAttribute failed\n"); grid = -1; return; }
        hipOccupancyMaxActiveBlocksPerMultiprocessor(&per_cu, (const void*)mk_kernel, NT, LDS_BYTES);
        if (per_cu < 1) { fprintf(stderr, "occupancy query says %d blocks/CU\n", per_cu); grid = -1; return; }
        grid = cus;
    }
    if (grid < 0) return;
    hipMemsetAsync((char*)d_ws + WS_CTL, 0, 65536, stream);
    Params p{};
    for (int i = 0; i < 42; ++i) p.in[i] = (const float*)d_in[i];
    p.out = (float*)d_out; p.ws = (unsigned char*)d_ws;
#if MK_MULTI
    for (int ph = 0; ph < NPHASE; ++ph) {
        p.ph_lo = ph; p.ph_hi = ph + 1;
        hipLaunchKernelGGL(mk_kernel, dim3(grid), dim3(NT), LDS_BYTES, stream, p);
    }
#else
    p.ph_lo = 0; p.ph_hi = NPHASE;
    void* args[] = {&p};
    hipError_t e = hipLaunchCooperativeKernel((const void*)mk_kernel, dim3(grid), dim3(NT), args, LDS_BYTES, stream);
    if (e != hipSuccess) fprintf(stderr, "cooperative launch failed: %s (grid %d)\n", hipGetErrorString(e), grid);
#endif
}
```

```cpp
#include <hip/hip_runtime.h>
#include <hip/hip_cooperative_groups.h>
#include <cstdint>
#include <cstdio>
namespace cg = cooperative_groups;

#ifndef PROBE_DUP
#define PROBE_DUP 0
#endif
#ifndef MK_MULTI
#define MK_MULTI 0
#endif

typedef unsigned short bf16_t;
typedef short bf16x8 __attribute__((ext_vector_type(8)));
typedef float f32x4 __attribute__((ext_vector_type(4)));
typedef float f32x2 __attribute__((ext_vector_type(2)));
typedef unsigned u32x4 __attribute__((ext_vector_type(4)));
typedef unsigned u32x2 __attribute__((ext_vector_type(2)));

constexpr int NT = 512;
constexpr int MTOK = 8192, CTXTOK = 4096;
constexpr int D = 1024, NPROJ = 3584, DFF = 4096;
constexpr int LDS_BYTES = 131072 + 256;
constexpr float LOG2E = 1.4426950408889634f;

constexpr int PC_Z = 0, PC_XBC = 256, PC_NAT = 768, PC_RW = 1536, PC_DIFF = 2688, PC_DT = 3456;

constexpr size_t O_Y = 0, O_SSD = 8388608, O_NATK = 9437184, O_NATV = 11534336, O_RWKV = 13631488, O_DIFFK = 14680064, O_DIFFV = 16777216;

constexpr size_t WS_CTL = 0;
constexpr size_t WS_MOD = 65536;
constexpr size_t WS_ROPE = WS_MOD + 2 * 3 * 6144 * 4;
constexpr size_t WS_LORA = WS_ROPE + 4096;
constexpr size_t WS_WIN = WS_LORA + 393216;
constexpr size_t WS_WOUT = WS_WIN + (size_t)2 * 3584 * 1024 * 2;
constexpr size_t WS_WFF1 = WS_WOUT + (size_t)2 * 1024 * 1024 * 2;
constexpr size_t WS_WFF2 = WS_WFF1 + (size_t)2 * 4096 * 1024 * 2;
constexpr size_t WS_CKN = WS_WFF2 + (size_t)2 * 4096 * 1024 * 2;
constexpr size_t WS_CVTN = WS_CKN + 1048576;
constexpr size_t WS_CKD = WS_CVTN + 1048576;
constexpr size_t WS_CVTD = WS_CKD + 1048576;
constexpr size_t WS_HN = WS_CVTD + 1048576;
constexpr size_t WS_PROJ = WS_HN + (size_t)MTOK * 1024 * 2;
constexpr size_t WS_PART = WS_PROJ;
constexpr size_t WS_XBC = WS_PROJ + (size_t)MTOK * NPROJ * 2;
constexpr size_t WS_DTA = WS_XBC + (size_t)MTOK * 512 * 2;
constexpr size_t WS_ZS = WS_DTA + (size_t)MTOK * 16 * 4;
constexpr size_t WS_QN = WS_ZS + (size_t)MTOK * 256 * 2;
constexpr size_t WS_KN = WS_QN + (size_t)MTOK * 256 * 2;
constexpr size_t WS_VTN = WS_KN + (size_t)MTOK * 256 * 2;
constexpr size_t WS_QD = WS_VTN + (size_t)MTOK * 256 * 2;
constexpr size_t WS_KD = WS_QD + (size_t)MTOK * 256 * 2;
constexpr size_t WS_VTD = WS_KD + (size_t)MTOK * 256 * 2;
constexpr size_t WS_H = WS_VTD + (size_t)MTOK * 256 * 2;
constexpr size_t RWB = (size_t)MTOK * 256;
constexpr size_t WS_RWB = WS_H;
constexpr size_t WS_DEC = WS_RWB + 8 * RWB * 2;
constexpr size_t WS_YSF = WS_DEC + 2 * RWB * 4;
constexpr size_t WS_YSB = WS_YSF + (size_t)MTOK * 256 * 2;
constexpr size_t WS_YRF = WS_YSB + (size_t)MTOK * 256 * 2;
constexpr size_t WS_YRB = WS_YRF + (size_t)MTOK * 256 * 2;
constexpr size_t WS_BON = WS_H + (size_t)MTOK * DFF * 2;
static_assert(WS_YRB + (size_t)MTOK * 256 * 2 <= WS_BON, "h overlay");
constexpr int CHR_U = 10496;
constexpr int CHS_U = 4688;
constexpr size_t WS_CHR = WS_PROJ;
constexpr size_t CHR_TILE = (size_t)32 * NPROJ * 2, CHR_OFF = (size_t)2 * NPROJ * 2;
static_assert(CHR_OFF + 16 * (size_t)CHR_U <= (size_t)30 * NPROJ * 2, "chr inside tile");
__host__ __device__ inline size_t chr_unit_off(int cn_g, int h, int dir) { return (size_t)(cn_g >> 1) * CHR_TILE + CHR_OFF + (size_t)((((cn_g & 1) * 4 + h) * 2) + dir) * CHR_U; }
static_assert((size_t)4096 * CHR_U <= (size_t)MTOK * NPROJ * 2, "chr overlay");
constexpr size_t WS_CHS = WS_BON + (size_t)MTOK * 4 * 4;
constexpr size_t WS_END = WS_CHS + (size_t)4096 * CHS_U;
static_assert(WS_END <= (size_t)268435456, "workspace");

struct Params {
    const float* in[42];
    float* out;
    unsigned char* ws;
    int ph_lo, ph_hi;
};

__device__ __forceinline__ float bf2f(unsigned short h) { return __uint_as_float((unsigned)h << 16); }
typedef __bf16 bf16x2_t __attribute__((ext_vector_type(2)));
__device__ __forceinline__ unsigned pack_bf16(float lo, float hi) { f32x2 v = {lo, hi}; bf16x2_t r = __builtin_convertvector(v, bf16x2_t); return __builtin_bit_cast(unsigned, r); }
__device__ __forceinline__ unsigned short f2bf(float f) { return (unsigned short)(pack_bf16(f, 0.f) & 0xffffu); }
__device__ __forceinline__ f32x4 ld4bf(const bf16_t* p) { const u32x2 u = *(const u32x2*)p; f32x4 r; r[0] = __uint_as_float(u.x << 16); r[1] = __uint_as_float(u.x & 0xffff0000u); r[2] = __uint_as_float(u.y << 16); r[3] = __uint_as_float(u.y & 0xffff0000u); return r; }
__device__ __forceinline__ void st4bf(bf16_t* p, f32x4 v) { u32x2 pk; pk.x = pack_bf16(v[0], v[1]); pk.y = pack_bf16(v[2], v[3]); *(u32x2*)p = pk; }
__device__ __forceinline__ float frcp(float x) { return __builtin_amdgcn_rcpf(x); }
__device__ __forceinline__ float siluf(float x) { return x * frcp(1.f + __expf(-x)); }
__device__ __forceinline__ float sigmoidf_(float x) { return frcp(1.f + __expf(-x)); }
__device__ __forceinline__ float softplusf_(float x) { return fmaxf(x, 0.f) + __logf(1.f + __expf(-fabsf(x))); }
__device__ __forceinline__ float tanhf_(float x) { const float e = __expf(-2.f * fabsf(x)); const float t = (1.f - e) * frcp(1.f + e); return x < 0.f ? -t : t; }
__device__ __forceinline__ int phase_tid() { int t = threadIdx.x; asm volatile("" : "+v"(t)); return t & 511; }
template <int CTRL> __device__ __forceinline__ float dpp_mov(float x) {
    return __builtin_bit_cast(float, __builtin_amdgcn_update_dpp(0, __builtin_bit_cast(int, x), CTRL, 0xf, 0xf, true));
}
__device__ __forceinline__ float allsum4(float x) { x += dpp_mov<0xB1>(x); x += dpp_mov<0x4E>(x); return x; }
__device__ __forceinline__ float allsum8(float x) { x = allsum4(x); x += dpp_mov<0x141>(x); return x; }
__device__ __forceinline__ float allsum16(float x) { x = allsum8(x); x += dpp_mov<0x140>(x); return x; }
__device__ __forceinline__ float allsum_q(float x);
__device__ __forceinline__ float allsum64(float x) { return allsum_q(allsum16(x)); }
__device__ __forceinline__ float wavesum64(float x) {
    x = allsum16(x);
    x += __builtin_bit_cast(float, __builtin_amdgcn_update_dpp(0, __builtin_bit_cast(int, x), 0x142, 0xa, 0xf, false));
    x += __builtin_bit_cast(float, __builtin_amdgcn_update_dpp(0, __builtin_bit_cast(int, x), 0x143, 0xc, 0xf, false));
    return __builtin_bit_cast(float, __builtin_amdgcn_readlane(__builtin_bit_cast(int, x), 63));
}
__device__ __forceinline__ float allmax_q(float x) { x = fmaxf(x, __shfl_xor(x, 16)); x = fmaxf(x, __shfl_xor(x, 32)); return x; }
__device__ __forceinline__ float allsum_q(float x) { x += __shfl_xor(x, 16); x += __shfl_xor(x, 32); return x; }
__device__ __forceinline__ int opaque_uniform(int k) { asm volatile("" : "+v"(k)); return __builtin_amdgcn_readfirstlane(k); }
#define GAS __attribute__((address_space(1)))
template <class T> __device__ __forceinline__ T* opaque_ptr(T* p) {
    unsigned long long u = (unsigned long long)p; unsigned lo = (unsigned)u, hi = (unsigned)(u >> 32);
    asm volatile("" : "+v"(lo), "+v"(hi));
    lo = __builtin_amdgcn_readfirstlane(lo); hi = __builtin_amdgcn_readfirstlane(hi);
    return (T*)(T GAS*)(((unsigned long long)hi << 32) | lo);
}
__device__ __forceinline__ const float* inp(const Params& P, int k) { return (const float*)(const float GAS*)(unsigned long long)P.in[opaque_uniform(k)]; }
__device__ __forceinline__ float* outp(const Params& P) { return opaque_ptr(P.out); }
__device__ __forceinline__ unsigned char* opaque_ws(const Params& P) { return opaque_ptr(P.ws); }
namespace pg8 {
#define PG8_LAS __attribute__((address_space(3)))
typedef unsigned short bf16_t;
typedef short bf16x8 __attribute__((ext_vector_type(8)));
typedef float f32x4 __attribute__((ext_vector_type(4)));
typedef unsigned u32x4 __attribute__((ext_vector_type(4)));
constexpr int BM = 256, BK = 64, HALF = 128, HTB = HALF * BK * 2  , STAGE_BYTES = 8 * HTB, NXCD = 8, WGM = 8;

__host__ __device__ __forceinline__ int lds_byte(int r, int c) { const int st = (r >> 4) * 2 + (c >> 5), rr = r & 15, cc = c & 31, ob = rr * 64 + cc * 2; return st * 1024 + (ob ^ (((ob >> 9) & 1) << 5)); }
__host__ __device__ __forceinline__ void stage_rc(int b, int& R, int& C) { const int st = b / 1024, sb = b % 1024, swz = sb ^ (((sb >> 9) & 1) << 5); R = (st >> 1) * 16 + swz / 64; C = (st & 1) * 32 + (swz % 64) / 2; }
__host__ __device__ __forceinline__ int perm32(int rho) { const int n = rho >> 4, i = rho & 15; return 8 * (i >> 2) + 4 * n + (i & 3); }

struct Unit { int pm, pn, ks; };
struct Gemm { const bf16_t* A; const bf16_t* Bt; int M, N, K, KL; };
struct StaticOrder {
    int nM, nN, nNs, nwg, G, c;
    __host__ __device__ void init(int M, int N, int SK, int G_, int c_) { nM = M / BM; nN = N / BM; nNs = nN * SK; nwg = nM * nNs; G = G_; c = c_; }
    __host__ __device__ bool next(int i, Unit& u) const {
        const long L = (long)i * G + c; if (L >= nwg) return false;
        int wgid = (int)L; { const int q = nwg / NXCD, r = nwg % NXCD, xcd = wgid % NXCD, off = wgid / NXCD; wgid = (xcd < r ? xcd * (q + 1) : r * (q + 1) + (xcd - r) * q) + off; }
        const int nig = WGM * nNs, gid = wgid / nig, fm = gid * WGM, gsz = (nM - fm) < WGM ? (nM - fm) : WGM;
        u.pm = fm + ((wgid % nig) % gsz); const int pnn = (wgid % nig) / gsz; u.pn = pnn % nN; u.ks = pnn / nN; return true;
    }
    __device__ __forceinline__ void a_ready(const Unit&) const {}
    __device__ __forceinline__ void done(const Unit&) const {}
};
template <class Epi, class Sched, bool ALIGN_EPI = false, bool SP2 = false>
__device__ __forceinline__ void gemm_phase(PG8_LAS unsigned char* lds, const Gemm g, const Sched& S, const Epi& E) {
    const int tid = phase_tid(), wid = __builtin_amdgcn_readfirstlane(tid >> 6), lane = tid & 63, wr = wid >> 2, wc = wid & 3, fr = lane & 15, fq = lane >> 4;
    const int K = g.K, nt = g.KL / BK;
    unsigned voffA[2], voffB[2];
#pragma unroll
    for (int i = 0; i < 2; ++i) { int R, C; stage_rc(tid * 16 + i * 8192, R, C); const int Rb = Epi::PERM ? ((R & ~31) + perm32(R & 31)) : R;
        voffA[i] = (unsigned)(R * K + C) * 2u; voffB[i] = (unsigned)(Rb * K + C) * 2u; }
    const size_t kstep = (size_t)(BK * 2);
    const size_t hstep = (size_t)HALF * K * 2;
    const size_t tstep = 2 * hstep;
    const unsigned ldsw = (unsigned)wid * 1024u;
    const int aoff = lds_byte(wr * 64 + fr, fq * 8), boff = lds_byte(wc * 32 + fr, fq * 8);
#define PG8_SA(b, h) (((b) * 2 + (h)) * HTB)
#define PG8_SB(b, h) ((4 + (b) * 2 + (h)) * HTB)
#define PG8_STAGE(bufoff, gbase, voff) do { _Pragma("unroll") for (int _i = 0; _i < 2; ++_i) \
        __builtin_amdgcn_global_load_lds((const unsigned*)((const char*)(gbase) + (voff)[_i]), (PG8_LAS unsigned*)(lds + (bufoff) + ldsw + _i * 8192), 16, 0, 0); } while (0)
#define PG8_LDA(dst, b, h) do { _Pragma("unroll") for (int m = 0; m < 4; ++m) _Pragma("unroll") for (int k = 0; k < 2; ++k) dst[m][k] = *(const PG8_LAS bf16x8*)(lds + PG8_SA(b, h) + aoff + m * 2048 + k * 1024); } while (0)
#define PG8_LDB(dst, b, h) do { _Pragma("unroll") for (int n = 0; n < 2; ++n) _Pragma("unroll") for (int k = 0; k < 2; ++k) dst[n][k] = *(const PG8_LAS bf16x8*)(lds + PG8_SB(b, h) + boff + n * 2048 + k * 1024); } while (0)
#define PG8_MMA(ai, bj, At, Bt) do { __builtin_amdgcn_s_setprio(1); _Pragma("unroll") for (int m = 0; m < 4; ++m) _Pragma("unroll") for (int n = 0; n < 2; ++n) _Pragma("unroll") for (int k = 0; k < 2; ++k) \
        acc[ai][bj][m][n] = __builtin_amdgcn_mfma_f32_16x16x32_bf16(Bt[n][k], At[m][k], acc[ai][bj][m][n], 0, 0, 0); __builtin_amdgcn_s_setprio(0); } while (0)
#define PG8_WAIT_V(n) asm volatile("s_waitcnt vmcnt(" #n ")" ::: "memory")
#define PG8_WAIT_L(n) asm volatile("s_waitcnt lgkmcnt(" #n ")" ::: "memory")
#define PG8_BAR __builtin_amdgcn_s_barrier()
#define PG8_SCHED __builtin_amdgcn_sched_barrier(0)
    Unit cur, nxt; int ui = 0;
    if (!S.next(0, cur)) return;
    f32x4 acc[2][2][4][2];
#pragma unroll
    for (int a = 0; a < 2; ++a)
#pragma unroll
        for (int b = 0; b < 2; ++b)
#pragma unroll
            for (int m = 0; m < 4; ++m)
#pragma unroll
                for (int n = 0; n < 2; ++n) acc[a][b][m][n] = (f32x4){0.f, 0.f, 0.f, 0.f};
    bf16x8 At[4][2], B0[2][2], B1[2][2];
    const char* cA = (const char*)g.A + (size_t)cur.pm * tstep + (size_t)cur.ks * g.KL * 2; const char* cB = (const char*)g.Bt + (size_t)cur.pn * tstep + (size_t)cur.ks * g.KL * 2;
    S.a_ready(cur);
    if constexpr (SP2) {
        PG8_STAGE(PG8_SB(0, 0), cB, voffB); PG8_STAGE(PG8_SB(0, 1), cB + hstep, voffB); PG8_STAGE(PG8_SA(0, 0), cA, voffA); PG8_STAGE(PG8_SA(0, 1), cA + hstep, voffA);
        if (wr == 1) PG8_BAR;
        PG8_WAIT_V(2); PG8_BAR;
        PG8_STAGE(PG8_SB(1, 0), cB + kstep, voffB); PG8_STAGE(PG8_SA(1, 0), cA + kstep, voffA); PG8_STAGE(PG8_SB(1, 1), cB + hstep + kstep, voffB);
        PG8_WAIT_V(6); PG8_BAR;
    } else {
        PG8_STAGE(PG8_SB(0, 0), cB, voffB); PG8_STAGE(PG8_SA(0, 0), cA, voffA); PG8_STAGE(PG8_SB(0, 1), cB + hstep, voffB); PG8_STAGE(PG8_SA(0, 1), cA + hstep, voffA);
        if (wr == 1) PG8_BAR;
        PG8_WAIT_V(4); PG8_BAR;
        PG8_STAGE(PG8_SB(1, 0), cB + kstep, voffB); PG8_STAGE(PG8_SA(1, 0), cA + kstep, voffA); PG8_STAGE(PG8_SB(1, 1), cB + hstep + kstep, voffB);
        PG8_WAIT_V(6); PG8_BAR;
    }
    for (;;) {
        const bool has_next = S.next(ui + 1, nxt);
        const char* nA = has_next ? (const char*)g.A + (size_t)nxt.pm * tstep + (size_t)nxt.ks * g.KL * 2 : cA; const char* nB = has_next ? (const char*)g.Bt + (size_t)nxt.pn * tstep + (size_t)nxt.ks * g.KL * 2 : cB;
        for (int t = 0; t < nt; t += 2) {
            const bool last = (t == nt - 2);
            const char* a1 = cA + (size_t)(t + 1) * kstep;
            const char* a2 = last ? nA : cA + (size_t)(t + 2) * kstep; const char* b2 = last ? nB : cB + (size_t)(t + 2) * kstep;
            const char* a3 = a2 + kstep; const char* b3 = b2 + kstep;
            if (last && has_next) S.a_ready(nxt);
            if constexpr (SP2) {
            PG8_LDB(B0, 0, 0); PG8_LDB(B1, 0, 1); PG8_SCHED; PG8_LDA(At, 0, 0); PG8_STAGE(PG8_SA(1, 1), a1 + hstep, voffA);
            PG8_WAIT_V(8); PG8_WAIT_L(0); PG8_BAR; PG8_MMA(0, 0, At, B0); PG8_MMA(0, 1, At, B1); PG8_BAR; PG8_SCHED;
            PG8_LDA(At, 0, 1); PG8_STAGE(PG8_SB(0, 0), b2, voffB); PG8_STAGE(PG8_SB(0, 1), b2 + hstep, voffB); PG8_STAGE(PG8_SA(0, 0), a2, voffA);
            PG8_WAIT_V(8); PG8_WAIT_L(0); PG8_BAR; PG8_MMA(1, 0, At, B0); PG8_MMA(1, 1, At, B1); PG8_BAR; PG8_SCHED;
            PG8_LDB(B0, 1, 0); PG8_LDB(B1, 1, 1); PG8_SCHED; PG8_LDA(At, 1, 0); PG8_STAGE(PG8_SA(0, 1), a2 + hstep, voffA);
            PG8_WAIT_V(8); PG8_WAIT_L(0); PG8_BAR; PG8_MMA(0, 0, At, B0); PG8_MMA(0, 1, At, B1); PG8_BAR; PG8_SCHED;
            PG8_LDA(At, 1, 1); PG8_STAGE(PG8_SB(1, 0), b3, voffB); PG8_STAGE(PG8_SB(1, 1), b3 + hstep, voffB); PG8_STAGE(PG8_SA(1, 0), a3, voffA);
            PG8_WAIT_V(8); PG8_WAIT_L(0); PG8_BAR; PG8_MMA(1, 0, At, B0); PG8_MMA(1, 1, At, B1); PG8_BAR; PG8_SCHED;
            } else {
            PG8_LDB(B0, 0, 0); PG8_SCHED; PG8_LDA(At, 0, 0); PG8_STAGE(PG8_SA(1, 1), a1 + hstep, voffA);
            PG8_WAIT_L(8); PG8_BAR; PG8_WAIT_L(0); PG8_MMA(0, 0, At, B0); PG8_BAR; PG8_SCHED;
            PG8_LDB(B1, 0, 1); PG8_STAGE(PG8_SB(0, 0), b2, voffB);
            PG8_BAR; PG8_WAIT_L(0); PG8_MMA(0, 1, At, B1); PG8_BAR;
            PG8_LDA(At, 0, 1); PG8_STAGE(PG8_SA(0, 0), a2, voffA);
            PG8_BAR; PG8_WAIT_L(0); PG8_MMA(1, 0, At, B0); PG8_BAR; PG8_SCHED;
            PG8_STAGE(PG8_SB(0, 1), b2 + hstep, voffB);
            PG8_WAIT_V(6); PG8_BAR; PG8_MMA(1, 1, At, B1); PG8_BAR;
            PG8_LDB(B0, 1, 0); PG8_SCHED; PG8_LDA(At, 1, 0); PG8_STAGE(PG8_SA(0, 1), a2 + hstep, voffA);
            PG8_WAIT_L(8); PG8_BAR; PG8_WAIT_L(0); PG8_MMA(0, 0, At, B0); PG8_BAR; PG8_SCHED;
            PG8_LDB(B1, 1, 1); PG8_STAGE(PG8_SB(1, 0), b3, voffB);
            PG8_BAR; PG8_WAIT_L(0); PG8_MMA(0, 1, At, B1); PG8_BAR;
            PG8_LDA(At, 1, 1); PG8_STAGE(PG8_SA(1, 0), a3, voffA);
            PG8_BAR; PG8_WAIT_L(0); PG8_MMA(1, 0, At, B0); PG8_BAR; PG8_SCHED;
            PG8_STAGE(PG8_SB(1, 1), b3 + hstep, voffB);
            PG8_WAIT_V(6); PG8_BAR; PG8_MMA(1, 1, At, B1); PG8_BAR;
            }
        }
        if constexpr (ALIGN_EPI) { if (wr == 0) PG8_BAR; }
        if constexpr (!Epi::AFTER_DRAIN) { E(acc, cur, wr, wc, fr, fq); S.done(cur); }
        if (!has_next) break;
#pragma unroll
        for (int a = 0; a < 2; ++a)
#pragma unroll
            for (int b = 0; b < 2; ++b)
#pragma unroll
                for (int m = 0; m < 4; ++m)
#pragma unroll
                    for (int n = 0; n < 2; ++n) acc[a][b][m][n] = (f32x4){0.f, 0.f, 0.f, 0.f};
        cur = nxt; cA = nA; cB = nB; ++ui;
        if constexpr (ALIGN_EPI) { if (wr == 1) PG8_BAR; }
    }
    PG8_WAIT_V(0);
    if constexpr (!ALIGN_EPI) { if (wr == 0) PG8_BAR; }
    PG8_BAR;
    if constexpr (Epi::AFTER_DRAIN) { E.fused(acc, cur, wr, wc, fr, fq, lds, wid, lane); S.done(cur); }
#undef PG8_SA
#undef PG8_SB
#undef PG8_STAGE
#undef PG8_LDA
#undef PG8_LDB
#undef PG8_MMA
#undef PG8_WAIT_V
#undef PG8_WAIT_L
#undef PG8_BAR
#undef PG8_SCHED
}
}

namespace pg8 {
template <int ACT> struct EpiBf16 {
    static constexpr bool PERM = true, AFTER_DRAIN = false;
    bf16_t* O; int ldc; size_t slab;
    __device__ __forceinline__ void operator()(const f32x4 (&acc)[2][2][4][2], const Unit& u, int wr, int wc, int fr, int fq) const {
        const int row0 = u.pm * BM + wr * 64 + fr, col0 = u.pn * BM + wc * 32 + 8 * fq;
        bf16_t* Ob = O + (size_t)u.ks * slab;
#pragma unroll
        for (int ai = 0; ai < 2; ++ai)
#pragma unroll
            for (int m = 0; m < 4; ++m) { bf16_t* rowp = Ob + (size_t)(row0 + ai * HALF + m * 16) * ldc + col0;
#pragma unroll
                for (int bj = 0; bj < 2; ++bj) { f32x4 v0 = acc[ai][bj][m][0], v1 = acc[ai][bj][m][1];
                    if (ACT == 1) {
#pragma unroll
                        for (int e = 0; e < 4; ++e) { const float a = fmaxf(v0[e], 0.f), b = fmaxf(v1[e], 0.f); v0[e] = a * a; v1[e] = b * b; } }
                    u32x4 w; w.x = ::pack_bf16(v0[0], v0[1]); w.y = ::pack_bf16(v0[2], v0[3]); w.z = ::pack_bf16(v1[0], v1[1]); w.w = ::pack_bf16(v1[2], v1[3]);
                    *(u32x4*)(rowp + bj * HALF) = w; } }
    }
};
struct EpiF32 {
    static constexpr bool PERM = false, AFTER_DRAIN = false;
    float* O; int ldc; size_t slab;
    __device__ __forceinline__ void operator()(const f32x4 (&acc)[2][2][4][2], const Unit& u, int wr, int wc, int fr, int fq) const {
        const int row0 = u.pm * BM + wr * 64 + fr, col0 = u.pn * BM + wc * 32 + 4 * fq;
        float* base = O + (size_t)u.ks * slab;
#pragma unroll
        for (int ai = 0; ai < 2; ++ai)
#pragma unroll
            for (int m = 0; m < 4; ++m) { float* rowp = base + (size_t)(row0 + ai * HALF + m * 16) * ldc + col0;
#pragma unroll
                for (int bj = 0; bj < 2; ++bj)
#pragma unroll
                    for (int n = 0; n < 2; ++n) *(f32x4*)(rowp + bj * HALF + n * 16) = acc[ai][bj][m][n]; }
    }
};
}

struct TokInfo { int seqbase, t, L, cond, isctx, sidx; };
__device__ __forceinline__ TokInfo tokinfo(int g) {
    TokInfo r;
    if (g < CTXTOK) { r.isctx = 1; r.sidx = g >> 8; r.t = g & 255; r.L = 256; r.seqbase = r.sidx << 8; r.cond = 0; }
    else { int q = g - CTXTOK; r.isctx = 0; r.sidx = q >> 11; r.t = q & 2047; r.L = 2048; r.seqbase = CTXTOK + (r.sidx << 11); r.cond = 1 + r.sidx; }
    return r;
}

__device__ __forceinline__ void pro_transpose_tile(const float* __restrict__ W, bf16_t* __restrict__ Wt, int K, int N, int k0, int n0, bool perm_in, float* lds) {
    const int tid = phase_tid();
    const int nn = tid & 63;
    int nd = n0 + nn, ns = nd; bool valid = true;
    if (perm_in) {
        if (nd < 768) ns = nd; else if (nd < 3456) ns = nd + 8; else if (nd < 3464) ns = nd - 3456 + 768; else valid = false;
    }
#pragma unroll
    for (int i = 0; i < 8; ++i) {
        const int kk = (tid >> 6) + 8 * i;
        float v = valid ? W[(size_t)(k0 + kk) * N + ns] : 0.f;
        lds[nn * 65 + kk] = v;
    }
    __syncthreads();
    {
        const int n2 = tid >> 3, c = tid & 7;
        const float* s = lds + n2 * 65 + c * 8;
        u32x4 o; o.x = pack_bf16(s[0], s[1]); o.y = pack_bf16(s[2], s[3]); o.z = pack_bf16(s[4], s[5]); o.w = pack_bf16(s[6], s[7]);
        *(u32x4*)(Wt + (size_t)(n0 + n2) * K + k0 + c * 8) = o;
    }
    __syncthreads();
}

__device__ __forceinline__ void phase_prologue(const Params& P, float* lds) {
    const int tid = phase_tid(), bid = blockIdx.x, nb = gridDim.x;
    unsigned char* ws = P.ws;
    const int T_IN = 2 * 56 * 16, T_OUT = 2 * 16 * 16, T_F1 = 2 * 64 * 16, T_F2 = 2 * 16 * 64;
    const int T_ALL = T_IN + T_OUT + T_F1 + T_F2;
    for (int u = bid; u < T_ALL; u += nb) {
        int v = u;
        if (v < T_IN) { int l = v / (56 * 16); v %= 56 * 16; int tn = v / 16, tk = v % 16;
            pro_transpose_tile(inp(P, 14) + (size_t)l * 1024 * 3464, (bf16_t*)(ws + WS_WIN) + (size_t)l * 3584 * 1024, 1024, 3464, tk * 64, tn * 64, true, lds); continue; }
        v -= T_IN;
        if (v < T_OUT) { int l = v / 256; v %= 256; int tn = v / 16, tk = v % 16;
            pro_transpose_tile(inp(P, 15) + (size_t)l * 1024 * 1024, (bf16_t*)(ws + WS_WOUT) + (size_t)l * 1024 * 1024, 1024, 1024, tk * 64, tn * 64, false, lds); continue; }
        v -= T_OUT;
        if (v < T_F1) { int l = v / 1024; v %= 1024; int tn = v / 16, tk = v % 16;
            pro_transpose_tile(inp(P, 40) + (size_t)l * 1024 * 4096, (bf16_t*)(ws + WS_WFF1) + (size_t)l * 4096 * 1024, 1024, 4096, tk * 64, tn * 64, false, lds); continue; }
        v -= T_F1;
        { int l = v / 1024; v %= 1024; int tn = v / 64, tk = v % 64;
            pro_transpose_tile(inp(P, 41) + (size_t)l * 4096 * 1024, (bf16_t*)(ws + WS_WFF2) + (size_t)l * 1024 * 4096, 4096, 1024, tk * 64, tn * 64, false, lds); }
    }
    for (int u = bid; u < 192; u += nb) {
        const int l = u / 96, n0 = (u % 96) * 64;
        float* sc = lds;
        float* red = lds + 3072;
        for (int i = tid; i < 3072; i += NT) { int c = i >> 10, k = i & 1023; float x = (c == 0) ? inp(P, 9)[k] : inp(P, 8)[(c - 1) * 1024 + k]; sc[i] = siluf(x); }
        __syncthreads();
        const int kg = tid >> 4, nc = tid & 15;
        const float* W = inp(P, 10) + (size_t)l * 1024 * 6144 + n0 + nc * 4;
        f32x4 a0 = {0, 0, 0, 0}, a1 = a0, a2 = a0;
#pragma unroll 4
        for (int k = kg * 32; k < kg * 32 + 32; ++k) {
            const f32x4 w = *(const f32x4*)(W + (size_t)k * 6144);
            a0 += w * sc[k]; a1 += w * sc[1024 + k]; a2 += w * sc[2048 + k];
        }
        *(f32x4*)(red + (kg * 3 + 0) * 64 + nc * 4) = a0;
        *(f32x4*)(red + (kg * 3 + 1) * 64 + nc * 4) = a1;
        *(f32x4*)(red + (kg * 3 + 2) * 64 + nc * 4) = a2;
        __syncthreads();
        if (tid < 192) {
            const int c = tid >> 6, n = tid & 63; float s = 0.f;
            for (int g = 0; g < 32; ++g) s += red[(g * 3 + c) * 64 + n];
            s += inp(P, 11)[l * 6144 + n0 + n];
            ((float*)(ws + WS_MOD))[(l * 3 + c) * 6144 + n0 + n] = s;
        }
        __syncthreads();
    }
    for (int u = bid; u < 2 * 128; u += nb) {
        const int which = u / 128, chunk = u % 128;
        const float* src = inp(P, which ? 6 : 3);
        bf16_t* dst = (bf16_t*)(ws + (which ? WS_CKD : WS_CKN));
        const int e = chunk * 4096 + tid * 8;
        const int c = e & 255, key = (e >> 8) & 511, b = (e >> 17) & 1, layer = e >> 18;
        const float* s = src + ((size_t)((b * 2 + layer) * 512 + key)) * 256 + c;
        const f32x4 x0 = *(const f32x4*)s, x1 = *(const f32x4*)(s + 4);
        u32x4 o; o.x = pack_bf16(x0[0], x0[1]); o.y = pack_bf16(x0[2], x0[3]); o.z = pack_bf16(x1[0], x1[1]); o.w = pack_bf16(x1[2], x1[3]);
        *(u32x4*)(dst + e) = o;
    }
    for (int u = bid; u < 2 * 128; u += nb) {
        const int which = u / 128; int v = u % 128; const int kb = v & 7; v >>= 3; const int h = v & 3; v >>= 2; const int b = v & 1, layer = v >> 1;
        const float* src = inp(P, which ? 7 : 4) + ((size_t)((b * 2 + layer) * 512 + kb * 64)) * 256 + h * 64;
        bf16_t* dst = (bf16_t*)(ws + (which ? WS_CVTD : WS_CVTN)) + ((size_t)((layer * 2 + b) * 4 + h) * 64) * 512 + kb * 64;
        const int dd = tid & 63;
#pragma unroll
        for (int i = 0; i < 8; ++i) { const int key = (tid >> 6) + 8 * i; lds[dd * 65 + key] = src[(size_t)key * 256 + dd]; }
        __syncthreads();
        { const int d2 = tid >> 3, c = tid & 7; const float* s = lds + d2 * 65 + c * 8;
          u32x4 o; o.x = pack_bf16(s[0], s[1]); o.y = pack_bf16(s[2], s[3]); o.z = pack_bf16(s[4], s[5]); o.w = pack_bf16(s[6], s[7]);
          *(u32x4*)(dst + (size_t)d2 * 512 + c * 8) = o; }
        __syncthreads();
    }
    for (int e = bid * NT + tid; e < 196608; e += nb * NT) {
        bf16_t* dst = (bf16_t*)(ws + WS_LORA);
        float v;
        if (e < 131072) { const int which = e >> 16, r = e & 65535, i = r & 63, c = (r >> 6) & 255, ld = r >> 14;
            v = inp(P, which ? 29 : 27)[((size_t)ld * 64 + i) * 256 + c]; }
        else { const int r = e - 131072, i = r & 127, c = (r >> 7) & 255, l = r >> 15;
            v = inp(P, 30)[((size_t)l * 128 + i) * 256 + c]; }
        dst[e] = f2bf(v);
    }
    if (bid == 0 && tid < 512) {
        const int p = tid >> 3, f = tid & 7;
        float t = 1.f;
        t = (f == 1) ? 0.31622776601683794f : t; t = (f == 2) ? 0.1f : t; t = (f == 3) ? 0.031622776601683794f : t; t = (f == 4) ? 0.01f : t;
        t = (f == 5) ? 0.0031622776601683794f : t; t = (f == 6) ? 0.001f : t; t = (f == 7) ? 0.00031622776601683794f : t;
        double x = (double)t, x2 = x * x;
        double c = 1.0, s = x, tc = 1.0, tsn = x;
        for (int i = 1; i < 12; ++i) { tc *= -x2 / ((2.0 * i - 1.0) * (2.0 * i)); tsn *= -x2 / ((2.0 * i) * (2.0 * i + 1.0)); c += tc; s += tsn; }
        double cr = 1.0, sr = 0.0;
        for (int i = 0; i < p; ++i) { const double nc2 = cr * c - sr * s, ns2 = sr * c + cr * s; cr = nc2; sr = ns2; }
        float* R = (float*)(ws + WS_ROPE);
        R[(p * 8 + f) * 2 + 0] = (float)cr; R[(p * 8 + f) * 2 + 1] = (float)sr;
    }
}

__device__ __forceinline__ void phase_norm(const Params& P, int layer, int which, bool from_inputs, bool add_part, int glayer, int goff, bool do_norm) {
    const int tid = phase_tid(), lane = tid & 63, w = __builtin_amdgcn_readfirstlane(tid >> 6);
    unsigned char* ws = opaque_ws(P);
    float* OUT = outp(P);
    const float* X0 = inp(P, 0); const float* X1 = inp(P, 1);
    const float* gvec = inp(P, which ? 13 : 12) + layer * 1024;
    const float* modl = (const float*)(ws + WS_MOD) + (size_t)layer * 3 * 6144;
    const float* modg = (const float*)(ws + WS_MOD) + (size_t)glayer * 3 * 6144 + goff;
    const bf16_t* P0 = (const bf16_t*)(ws + WS_PART); const bf16_t* P1 = P0 + (size_t)MTOK * 1024;
    bf16_t* HN = (bf16_t*)(ws + WS_HN);
    constexpr int RPW = MTOK / (256 * 8);
    static_assert(RPW == 4, "rows per wave");
    f32x4 x[RPW][4]; u32x2 p0[RPW][4], p1[RPW][4];
    const int rbase = (blockIdx.x * 8 + w) * RPW;
#pragma unroll
    for (int r = 0; r < RPW; ++r) {
        const int row = rbase + r;
        const float* xr;
        if (!from_inputs) xr = OUT + (size_t)row * 1024; else xr = (row < CTXTOK) ? X0 + (size_t)row * 1024 : X1 + (size_t)(row - CTXTOK) * 1024;
#pragma unroll
        for (int i = 0; i < 4; ++i) { const int c = lane * 4 + 256 * i; x[r][i] = *(const f32x4*)(xr + c);
            if (add_part) { p0[r][i] = *(const u32x2*)(P0 + (size_t)row * 1024 + c); p1[r][i] = *(const u32x2*)(P1 + (size_t)row * 1024 + c); } }
    }
    auto cvp = [&](const u32x2 u) -> f32x4 { f32x4 r; r[0] = __uint_as_float(u.x << 16); r[1] = __uint_as_float(u.x & 0xffff0000u); r[2] = __uint_as_float(u.y << 16); r[3] = __uint_as_float(u.y & 0xffff0000u); return r; };
#pragma unroll
    for (int r = 0; r < RPW; ++r) {
        const int row = rbase + r;
        const int cond = (row < CTXTOK) ? 0 : 1 + ((row - CTXTOK) >> 11);
        float ss = 0.f;
#pragma unroll
        for (int i = 0; i < 4; ++i) {
            const int c = lane * 4 + 256 * i;
            if (add_part) {
                const f32x4 g = *(const f32x4*)(modg + cond * 6144 + c);
                x[r][i] += g * (cvp(p0[r][i]) + cvp(p1[r][i]));
                *(f32x4*)(OUT + (size_t)row * 1024 + c) = x[r][i];
            }
            ss += x[r][i][0] * x[r][i][0] + x[r][i][1] * x[r][i][1] + x[r][i][2] * x[r][i][2] + x[r][i][3] * x[r][i][3];
        }
        if (do_norm) {
            const float* sh = modl + cond * 6144 + (which ? 3072 : 0);
            const float* sc = sh + 1024;
            ss = allsum64(ss);
            const float rs = __builtin_amdgcn_rsqf(ss * (1.f / 1024.f) + 1e-6f);
#pragma unroll
            for (int i = 0; i < 4; ++i) {
                const int c = lane * 4 + 256 * i;
                const f32x4 g = *(const f32x4*)(gvec + c), s1 = *(const f32x4*)(sc + c), s0 = *(const f32x4*)(sh + c);
                f32x4 o = x[r][i] * rs * g * (s1 + 1.f) + s0;
                u32x2 pk; pk.x = pack_bf16(o[0], o[1]); pk.y = pack_bf16(o[2], o[3]);
                *(u32x2*)(HN + (size_t)row * 1024 + c) = pk;
            }
        }
    }
}

constexpr int GS = 72;
__device__ __forceinline__ void premix_item(const Params& P, int layer, int it, unsigned char* ldsraw, int secmask = 7) {
    const int tid = phase_tid(), lane = tid & 63, w = __builtin_amdgcn_readfirstlane(tid >> 6);
    unsigned char* ws = opaque_ws(P);
    const int g0 = it * 32;
    const TokInfo ti = tokinfo(g0);
    const int t0 = ti.t, L = ti.L, sb = ti.seqbase;
    const bf16_t* PROJ = (const bf16_t*)(ws + WS_PROJ);
    float* lds = (float*)ldsraw;
    if (secmask & 1) {
        const int c = tid;
        const float* cw = inp(P, 16) + (size_t)layer * 5 * 512; const float cb = inp(P, 17)[layer * 512 + c];
        float wj[5];
#pragma unroll
        for (int j = 0; j < 5; ++j) wj[j] = cw[j * 512 + c];
        bf16_t* XBC = (bf16_t*)(ws + WS_XBC);
        auto ld = [&](int t) -> float { const int tc = min(max(t, 0), L - 1); const float vv = bf2f(PROJ[(size_t)(sb + tc) * NPROJ + PC_XBC + c]); return (t == tc) ? vv : 0.f; };
        float xx[36];
#pragma unroll
        for (int i = 0; i < 36; ++i) xx[i] = ld(t0 - 2 + i);
#pragma unroll
        for (int tt = 0; tt < 32; ++tt) {
            float v = cb + xx[tt] * wj[0] + xx[tt + 1] * wj[1] + xx[tt + 2] * wj[2] + xx[tt + 3] * wj[3] + xx[tt + 4] * wj[4];
            XBC[(size_t)(g0 + tt) * 512 + c] = f2bf(siluf(v));
        }
    }
    if ((secmask & 1) && tid < 256) {
        const int tt = tid >> 3, j = tid & 7;
        const float raw = bf2f(PROJ[(size_t)(g0 + tt) * NPROJ + PC_DT + j]);
        const float dtv = softplusf_(raw + inp(P, 19)[layer * 8 + j]);
        const float Aj = -__expf(inp(P, 18)[layer * 8 + j]);
        f32x2 o; o.x = dtv; o.y = __expf(dtv * Aj);
        *(f32x2*)((float*)(ws + WS_DTA) + ((size_t)(g0 + tt) * 8 + j) * 2) = o;
    }
    if (secmask & 1) {
        bf16_t* ZS = (bf16_t*)(ws + WS_ZS);
        unsigned zu[8];
#pragma unroll
        for (int i = 0; i < 8; ++i) { const int e = tid + NT * i, tt = e >> 7, cp = (e & 127) * 2; zu[i] = *(const unsigned*)(PROJ + (size_t)(g0 + tt) * NPROJ + PC_Z + cp); }
#pragma unroll
        for (int i = 0; i < 8; ++i) {
            const int e = tid + NT * i, tt = e >> 7, cp = (e & 127) * 2;
            const float a = siluf(bf2f((unsigned short)(zu[i] & 0xffff))), b = siluf(bf2f((unsigned short)(zu[i] >> 16)));
            *(unsigned*)(ZS + (size_t)(g0 + tt) * 256 + cp) = pack_bf16(a, b);
        }
    }
    bf16_t* VS = (bf16_t*)ldsraw;
    if (secmask & 2) {
        const int c4 = lane * 4;
        const f32x4 gq = *(const f32x4*)(inp(P, 22) + layer * 64 + (c4 & 63)), gk = *(const f32x4*)(inp(P, 23) + layer * 64 + (c4 & 63));
        const f32x4 dgq = *(const f32x4*)(inp(P, 36) + layer * 32 + (c4 & 31)), dgk = *(const f32x4*)(inp(P, 37) + layer * 32 + (c4 & 31));
        const float* ROPE = (const float*)(ws + WS_ROPE);
        auto ld4 = [&](const bf16_t* p) -> f32x4 { const u32x2 u = *(const u32x2*)p; f32x4 r; r[0] = bf2f((unsigned short)(u.x & 0xffff)); r[1] = bf2f((unsigned short)(u.x >> 16)); r[2] = bf2f((unsigned short)(u.y & 0xffff)); r[3] = bf2f((unsigned short)(u.y >> 16)); return r; };
        auto st4 = [&](bf16_t* p, f32x4 v) { u32x2 pk; pk.x = pack_bf16(v[0], v[1]); pk.y = pack_bf16(v[2], v[3]); *(u32x2*)p = pk; };
        u32x2 raw[4][6];
#pragma unroll
        for (int i = 0; i < 4; ++i) { const bf16_t* pr = PROJ + (size_t)(g0 + w * 4 + i) * NPROJ;
#pragma unroll
            for (int a = 0; a < 3; ++a) { raw[i][a] = *(const u32x2*)(pr + PC_NAT + 256 * a + c4); raw[i][3 + a] = *(const u32x2*)(pr + PC_DIFF + 256 * a + c4); } }
        auto cv4 = [&](const u32x2 u) -> f32x4 { f32x4 r; r[0] = __uint_as_float(u.x << 16); r[1] = __uint_as_float(u.x & 0xffff0000u); r[2] = __uint_as_float(u.y << 16); r[3] = __uint_as_float(u.y & 0xffff0000u); return r; };
#pragma unroll
        for (int i = 0; i < 4; ++i) {
            const int tt = w * 4 + i, g = g0 + tt, t = t0 + tt;
            {
                f32x4 q = cv4(raw[i][0]), k = cv4(raw[i][1]), v = cv4(raw[i][2]);
                float sq = allsum16(q[0] * q[0] + q[1] * q[1] + q[2] * q[2] + q[3] * q[3]);
                float sk = allsum16(k[0] * k[0] + k[1] * k[1] + k[2] * k[2] + k[3] * k[3]);
                const float rq = __builtin_amdgcn_rsqf(sq * (1.f / 64.f) + 1e-6f) * (0.125f * LOG2E), rk = __builtin_amdgcn_rsqf(sk * (1.f / 64.f) + 1e-6f);
                q = q * rq * gq; k = k * rk * gk;
                st4((bf16_t*)(ws + WS_QN) + (size_t)g * 256 + c4, q);
                st4((bf16_t*)(ws + WS_KN) + (size_t)g * 256 + c4, k);
                if (ti.isctx) {
                    const size_t o = ((size_t)((ti.sidx * 2 + layer) * 256 + t)) * 256 + c4;
                    *(f32x4*)(outp(P) + O_NATK + o) = k; *(f32x4*)(outp(P) + O_NATV + o) = v;
                }
#pragma unroll
                for (int e = 0; e < 4; ++e) VS[(c4 + e) * 40 + tt] = f2bf(v[e]);
            }
            {
                f32x4 q = cv4(raw[i][3]), k = cv4(raw[i][4]), v = cv4(raw[i][5]);
                float sq = allsum8(q[0] * q[0] + q[1] * q[1] + q[2] * q[2] + q[3] * q[3]);
                float sk = allsum8(k[0] * k[0] + k[1] * k[1] + k[2] * k[2] + k[3] * k[3]);
                const float rq = __builtin_amdgcn_rsqf(sq * (1.f / 32.f) + 1e-6f), rk = __builtin_amdgcn_rsqf(sk * (1.f / 32.f) + 1e-6f);
                q = q * rq * dgq; k = k * rk * dgk;
                if (ti.isctx) {
                    const size_t o = ((size_t)((ti.sidx * 2 + layer) * 256 + t)) * 256 + c4;
                    *(f32x4*)(outp(P) + O_DIFFK + o) = k; *(f32x4*)(outp(P) + O_DIFFV + o) = v;
                } else {
                    const int blk = (c4 >> 4) & 1, pos = blk ? (t & 63) : (t >> 6), f0 = c4 & 7;
                    const bool isu2 = (lane & 2) != 0;
                    f32x4 qp, kp;
#pragma unroll
                    for (int e = 0; e < 4; ++e) { qp[e] = dpp_mov<0x4E>(q[e]); kp[e] = dpp_mov<0x4E>(k[e]); }
#pragma unroll
                    for (int e = 0; e < 4; ++e) {
                        const f32x2 cs = *(const f32x2*)(ROPE + (pos * 8 + f0 + e) * 2);
                        const float sgn = isu2 ? cs.y : -cs.y;
                        q[e] = q[e] * cs.x + qp[e] * sgn; k[e] = k[e] * cs.x + kp[e] * sgn;
                    }
                }
                q = q * (0.17677669529663687f * LOG2E);
                st4((bf16_t*)(ws + WS_QD) + (size_t)g * 256 + c4, q);
                st4((bf16_t*)(ws + WS_KD) + (size_t)g * 256 + c4, k);
#pragma unroll
                for (int e = 0; e < 4; ++e) VS[256 * 40 + (c4 + e) * 40 + tt] = f2bf(v[e]);
            }
        }
        __syncthreads();
        {
            const int ch = tid >> 1, hf = tid & 1, h = ch >> 6, d = ch & 63;
            size_t o;
            if (ti.isctx) o = ((size_t)((ti.sidx * 4 + h) * 64 + d)) * 256 + t0 + hf * 16;
            else o = (size_t)1048576 + ((size_t)((ti.sidx * 4 + h) * 64 + d)) * 2048 + t0 + hf * 16;
#pragma unroll
            for (int a = 0; a < 2; ++a) {
                const bf16_t* s = VS + a * 256 * 40 + ch * 40 + hf * 16;
                bf16_t* dst = (bf16_t*)(ws + (a ? WS_VTD : WS_VTN)) + o;
                *(u32x4*)dst = *(const u32x4*)s; *(u32x4*)(dst + 8) = *(const u32x4*)(s + 8);
            }
        }
        __syncthreads();
    }
    if (secmask & 28) {
        const bool doA = (secmask & 12) != 0, doB = (secmask & 20) != 0;
        float* KS = lds; float* RS = lds + 32 * 260; float* VR = lds + 2 * 32 * 260;
        bf16_t* LRb = (bf16_t*)(ldsraw + 99840);
        float* NRM = (float*)(ldsraw + 124928);
        const float* cwr = inp(P, 25) + (size_t)layer * 3 * 1152;
        auto conv32 = [&](int ch, float (&o)[32]) {
            const float w0 = cwr[ch], w1 = cwr[1152 + ch], w2 = cwr[2304 + ch];
            float x[34];
#pragma unroll
            for (int i = 0; i < 34; ++i) { const int t = t0 - 1 + i, tc = min(max(t, 0), L - 1); const float vv = bf2f(PROJ[(size_t)(sb + tc) * NPROJ + PC_RW + ch]); x[i] = (t == tc) ? vv : 0.f; }
#pragma unroll
            for (int i = 0; i < 32; ++i) o[i] = x[i] * w0 + x[i + 1] * w1 + x[i + 2] * w2;
        };
        if (doA) {
            float o[32]; conv32(tid, o);
            if (w < 4) {
#pragma unroll
                for (int i = 0; i < 32; ++i) RS[i * 260 + tid] = o[i];
            } else {
                const int c = tid - 256; const float kkc = inp(P, 31)[layer * 256 + c];
#pragma unroll
                for (int i = 0; i < 32; ++i) { KS[i * 260 + c] = o[i]; const float sv = o[i] * kkc; const float ss = wavesum64(sv * sv);
                    if (lane == 0) NRM[i * 4 + (w - 4)] = fminf(__builtin_amdgcn_rsqf(ss), 1e12f); }
            }
        }
        if (doA) {
            float o[32]; conv32(512 + tid, o);
            if (w < 4) {
#pragma unroll
                for (int i = 0; i < 32; ++i) VR[i * 260 + tid] = o[i];
            } else {
                const int lc = tid - 256;
#pragma unroll
                for (int i = 0; i < 32; ++i) LRb[i * 392 + lc] = f2bf(w < 6 ? tanhf_(o[i]) : o[i]);
            }
        }
        if (doA && w < 2) {
            float o[32]; conv32(1024 + tid, o);
#pragma unroll
            for (int i = 0; i < 32; ++i) LRb[i * 392 + 256 + tid] = f2bf(sigmoidf_(o[i]));
        }
        __syncthreads();
        if (doA && w < 4) {
            const float rkc = inp(P, 33)[layer * 256 + tid];
            float* BON = (float*)(ws + WS_BON);
#pragma unroll 8
            for (int i = 0; i < 32; ++i) { const float b = wavesum64(RS[i * 260 + tid] * KS[i * 260 + tid] * rkc); if (lane == 0) BON[(size_t)(g0 + i) * 4 + w] = b; }
        }
        const int l15 = lane & 15, quad = lane >> 4, cbase = 32 * w;
        const bf16_t* WUP = (const bf16_t*)(ws + WS_LORA);
        const bf16_t* AUP = WUP + 65536; const bf16_t* GUP = WUP + 131072;
        bf16_t* RWb = (bf16_t*)(ws + WS_RWB); float* DEC = (float*)(ws + WS_DEC);
        const f32x4 z4 = {0.f, 0.f, 0.f, 0.f};
#pragma unroll
        for (int cb = 0; cb < (doB ? 2 : 0); ++cb) {
            const int crow = cbase + cb * 16 + l15;
            bf16x8 wf[2][2], af[2][2], gf[4];
#pragma unroll
            for (int d = 0; d < 2; ++d)
#pragma unroll
                for (int ks = 0; ks < 2; ++ks) { wf[d][ks] = *(const bf16x8*)(WUP + ((size_t)((layer * 2 + d) * 256 + crow)) * 64 + ks * 32 + quad * 8);
                                                 af[d][ks] = *(const bf16x8*)(AUP + ((size_t)((layer * 2 + d) * 256 + crow)) * 64 + ks * 32 + quad * 8); }
#pragma unroll
            for (int ks = 0; ks < 4; ++ks) gf[ks] = *(const bf16x8*)(GUP + ((size_t)(layer * 256 + crow)) * 128 + ks * 32 + quad * 8);
            const int cpar = cbase + cb * 16 + 4 * quad;
            const f32x4 p_kk = *(const f32x4*)(inp(P, 31) + layer * 256 + cpar), p_ka = *(const f32x4*)(inp(P, 32) + layer * 256 + cpar);
            f32x4 p_w0[2], p_a0[2];
#pragma unroll
            for (int d = 0; d < 2; ++d) { p_w0[d] = *(const f32x4*)(inp(P, 26) + (layer * 2 + d) * 256 + cpar); p_a0[d] = *(const f32x4*)(inp(P, 28) + (layer * 2 + d) * 256 + cpar); }
#pragma unroll
            for (int tb = 0; tb < 2; ++tb) {
                f32x4 aW[2] = {z4, z4}, aA[2] = {z4, z4}, aG = z4;
                const bf16_t* lr = LRb + (tb * 16 + l15) * 392 + quad * 8;
#pragma unroll
                for (int d = 0; d < 2; ++d)
#pragma unroll
                    for (int ks = 0; ks < 2; ++ks) {
                        aW[d] = __builtin_amdgcn_mfma_f32_16x16x32_bf16(wf[d][ks], *(const bf16x8*)(lr + d * 64 + ks * 32), aW[d], 0, 0, 0);
                        aA[d] = __builtin_amdgcn_mfma_f32_16x16x32_bf16(af[d][ks], *(const bf16x8*)(lr + 128 + d * 64 + ks * 32), aA[d], 0, 0, 0);
                    }
#pragma unroll
                for (int ks = 0; ks < 4; ++ks) aG = __builtin_amdgcn_mfma_f32_16x16x32_bf16(gf[ks], *(const bf16x8*)(lr + 256 + ks * 32), aG, 0, 0, 0);
                const int t = tb * 16 + l15, c = cbase + cb * 16 + 4 * quad, head = c >> 6;
                const size_t o = (size_t)(g0 + t) * 256 + c;
                const f32x4 k4 = *(const f32x4*)(KS + t * 260 + c), r4 = *(const f32x4*)(RS + t * 260 + c), v4 = *(const f32x4*)(VR + t * 260 + c);
                const float rn = NRM[t * 4 + head];
                const f32x4 kk4 = k4 * p_kk * rn;
                const f32x4 ka4 = p_ka;
                st4bf(RWb + o, r4); st4bf(RWb + RWB + o, kk4); st4bf(RWb + 2 * RWB + o, v4); st4bf(RWb + 7 * RWB + o, aG);
#pragma unroll
                for (int d = 0; d < 2; ++d) {
                    const f32x4 w0 = p_w0[d], a0 = p_a0[d];
                    f32x4 dec, kka, kt;
#pragma unroll
                    for (int e = 0; e < 4; ++e) {
                        const float wl = -softplusf_(-(w0[e] + aW[d][e])) - 0.5f;
                        dec[e] = __expf(-__expf(wl));
                        const float a = sigmoidf_(a0[e] + aA[d][e]);
                        kt[e] = k4[e] * (1.f + (a - 1.f) * ka4[e]);
                        kka[e] = kk4[e] * a;
                    }
                    *(f32x4*)(DEC + d * RWB + o) = dec; st4bf(RWb + (3 + d) * RWB + o, kka); st4bf(RWb + (5 + d) * RWB + o, kt);
                }
            }
        }
        __syncthreads();
    }
}

typedef short bf16x4 __attribute__((ext_vector_type(4)));
#define MFMA32(a, b, c) __builtin_amdgcn_mfma_f32_16x16x32_bf16(__builtin_bit_cast(bf16x8, a), __builtin_bit_cast(bf16x8, b), c, 0, 0, 0)
#define MFMA16(a, b, c) __builtin_amdgcn_mfma_f32_16x16x16bf16_1k(__builtin_bit_cast(bf16x4, a), __builtin_bit_cast(bf16x4, b), c, 0, 0, 0)
constexpr int PREP_WLDS = 10496;
__device__ __forceinline__ void prep_item(const Params& P, int layer, int cn_g, unsigned char* ldsraw) {
    const int tid = phase_tid(), lane = tid & 63, w = __builtin_amdgcn_readfirstlane(tid >> 6), l15 = lane & 15, q = lane >> 4;
    const int h = w >> 1, dir = w & 1, base = cn_g * 16, grp = h >> 1;
    unsigned char* ws = opaque_ws(P);
    unsigned char* wl = ldsraw + w * PREP_WLDS;
    bf16_t* L0 = (bf16_t*)wl; bf16_t* L1 = L0 + 16 * 72; bf16_t* L2 = L1 + 16 * 72; bf16_t* L3 = L2 + 16 * 72;
    float* NL = (float*)(wl + 9216); float* CSL = (float*)(wl + 9216 + 1024);
    const int unit = (cn_g * 4 + h) * 2 + dir;
    const f32x4 z4 = {0.f, 0.f, 0.f, 0.f};
    {
        unsigned char* U = ws + WS_CHR + chr_unit_off(cn_g, h, dir);
        const bf16_t* RWb = (const bf16_t*)(ws + WS_RWB);
        const float* DEC = (const float*)(ws + WS_DEC) + (size_t)dir * RWB;
        const bf16_t* aR = RWb, *aKK = RWb + RWB, *aKKA = RWb + (3 + dir) * RWB, *aKT = RWb + (5 + dir) * RWB;
        float dec[16]; unsigned short kkv[16], kkav[16], ktv[16], rv[16];
#pragma unroll
        for (int n = 0; n < 16; ++n) { const size_t o = (size_t)(base + (dir ? 15 - n : n)) * 256 + h * 64 + lane;
            dec[n] = DEC[o]; kkv[n] = aKK[o]; kkav[n] = aKKA[o]; ktv[n] = aKT[o]; rv[n] = aR[o]; }
        float g = 1.f;
#pragma unroll
        for (int n = 0; n < 16; ++n) { const float gp = g; g *= dec[n]; const float ig = frcp(g);
            L0[n * 72 + lane] = f2bf(bf2f(kkv[n]) * gp); L1[n * 72 + lane] = f2bf(bf2f(kkav[n]) * ig);
            L2[n * 72 + lane] = f2bf(bf2f(ktv[n]) * ig); L3[n * 72 + lane] = f2bf(bf2f(rv[n]) * g); }
        ((float*)(U + 10240))[lane] = g;
        __syncthreads();
        f32x4 n1 = z4, n2 = z4, n3 = z4, n4 = z4;
#pragma unroll
        for (int ks = 0; ks < 2; ++ks) {
            const u32x4 fK = *(const u32x4*)(L0 + l15 * 72 + ks * 32 + q * 8), fB = *(const u32x4*)(L1 + l15 * 72 + ks * 32 + q * 8),
                        fT = *(const u32x4*)(L2 + l15 * 72 + ks * 32 + q * 8), fR = *(const u32x4*)(L3 + l15 * 72 + ks * 32 + q * 8);
            n1 = MFMA32(fB, fK, n1); n2 = MFMA32(fT, fK, n2); n3 = MFMA32(fB, fR, n3); n4 = MFMA32(fT, fR, n4);
        }
#pragma unroll
        for (int e = 0; e < 4; ++e) { const int i = 4 * q + e; const bool lt = i < l15, le = i <= l15;
            n1[e] = lt ? n1[e] : 0.f; n2[e] = lt ? n2[e] : 0.f; n3[e] = le ? -n3[e] : 0.f; n4[e] = le ? n4[e] : 0.f;
            NL[i * 16 + l15] = n1[e]; }
        { u32x2 xa; xa.x = pack_bf16(n2[0], n2[1]); xa.y = pack_bf16(n2[2], n2[3]); *(u32x2*)(U + 9728 + lane * 8) = xa;
          u32x4 ya; ya.x = pack_bf16(n3[0], n3[1]); ya.y = pack_bf16(n3[2], n3[3]); ya.z = pack_bf16(n4[0], n4[1]); ya.w = pack_bf16(n4[2], n4[3]); *(u32x4*)(U + 8192 + lane * 16) = ya; }
#pragma unroll
        for (int ks = 0; ks < 2; ++ks) {
            const u32x2 a = *(const u32x2*)(L0 + l15 * 72 + 32 * ks + 4 * q), b = *(const u32x2*)(L0 + l15 * 72 + 32 * ks + 16 + 4 * q);
            *(u32x4*)(U + ks * 1024 + lane * 16) = (u32x4){a.x, a.y, b.x, b.y};
            const u32x2 c = *(const u32x2*)(L3 + l15 * 72 + 32 * ks + 4 * q), d = *(const u32x2*)(L3 + l15 * 72 + 32 * ks + 16 + 4 * q);
            *(u32x4*)(U + 2048 + ks * 1024 + lane * 16) = (u32x4){c.x, c.y, d.x, d.y};
        }
#pragma unroll
        for (int rb = 0; rb < 4; ++rb) {
            unsigned bb[4], kk2[4];
#pragma unroll
            for (int j = 0; j < 4; ++j) { bb[j] = (unsigned)L1[(4 * q + j) * 72 + 16 * rb + l15] ^ 0x8000u; kk2[j] = (unsigned)L2[(4 * q + j) * 72 + 16 * rb + l15]; }
            *(u32x4*)(U + 4096 + rb * 1024 + lane * 16) = (u32x4){bb[0] | (bb[1] << 16), bb[2] | (bb[3] << 16), kk2[0] | (kk2[1] << 16), kk2[2] | (kk2[3] << 16)};
        }
        __syncthreads();
        float x[16];
#pragma unroll
        for (int i = 0; i < 16; ++i) x[i] = (i == l15) ? 1.f : 0.f;
#pragma unroll
        for (int i = 14; i >= 0; --i) { float sacc = 0.f;
#pragma unroll
            for (int j = i + 1; j < 16; ++j) sacc += NL[i * 16 + j] * x[j];
            x[i] = (i < l15) ? -sacc : x[i]; }
        { float m[4];
#pragma unroll
          for (int j = 0; j < 4; ++j) m[j] = (q == 0) ? x[j] : (q == 1) ? x[4 + j] : (q == 2) ? x[8 + j] : x[12 + j];
          u32x2 mi; mi.x = pack_bf16(m[0], m[1]); mi.y = pack_bf16(m[2], m[3]); *(u32x2*)(U + 9216 + lane * 8) = mi; }
        __syncthreads();
    }
    {
        unsigned char* U = ws + WS_CHS + (size_t)unit * CHS_U;
        const bf16_t* XBC = (const bf16_t*)(ws + WS_XBC);
        const float* DTA = (const float*)(ws + WS_DTA);
        const float Ah = -__expf(inp(P, 18)[layer * 8 + dir * 4 + h]);
        float cs[16]; unsigned short cv[16], bv[16];
        float c = 0.f;
#pragma unroll
        for (int n = 0; n < 16; ++n) { const int tk = base + (dir ? 15 - n : n);
            const float dtn = DTA[((size_t)tk * 8 + dir * 4 + h) * 2]; if (lane == 0) ((float*)(U + 4624))[n] = dtn;
            c += dtn * Ah; cs[n] = c;
            cv[n] = XBC[(size_t)tk * 512 + 384 + grp * 64 + lane]; bv[n] = XBC[(size_t)tk * 512 + 256 + grp * 64 + lane]; }
#pragma unroll
        for (int n = 0; n < 16; ++n) {
            L0[n * 72 + lane] = cv[n]; L1[n * 72 + lane] = bv[n];
            L2[n * 72 + lane] = f2bf(bf2f(cv[n]) * __expf(cs[n])); L3[n * 72 + lane] = f2bf(bf2f(bv[n]) * __expf(cs[15] - cs[n]));
            if (lane == 0) CSL[n] = cs[n]; }
        if (lane == 0) *(float*)(U + 4608) = __expf(cs[15]);
        __syncthreads();
        f32x4 gt = z4;
#pragma unroll
        for (int ks = 0; ks < 2; ++ks) gt = MFMA32(*(const u32x4*)(L1 + l15 * 72 + ks * 32 + q * 8), *(const u32x4*)(L0 + l15 * 72 + ks * 32 + q * 8), gt);
        { const float cst = CSL[l15]; float gg[4];
#pragma unroll
          for (int e = 0; e < 4; ++e) { const int i = 4 * q + e; gg[e] = (i <= l15) ? gt[e] * __expf(cst - CSL[i]) : 0.f; }
          u32x2 ga; ga.x = pack_bf16(gg[0], gg[1]); ga.y = pack_bf16(gg[2], gg[3]); *(u32x2*)(U + 2048 + lane * 8) = ga; }
#pragma unroll
        for (int ks = 0; ks < 2; ++ks) {
            const u32x2 a = *(const u32x2*)(L2 + l15 * 72 + 32 * ks + 4 * q), b = *(const u32x2*)(L2 + l15 * 72 + 32 * ks + 16 + 4 * q);
            *(u32x4*)(U + ks * 1024 + lane * 16) = (u32x4){a.x, a.y, b.x, b.y};
        }
#pragma unroll
        for (int rb = 0; rb < 4; ++rb) {
            unsigned bb[4];
#pragma unroll
            for (int j = 0; j < 4; ++j) bb[j] = (unsigned)L3[(4 * q + j) * 72 + 16 * rb + l15];
            *(u32x2*)(U + 2560 + rb * 512 + lane * 8) = (u32x2){bb[0] | (bb[1] << 16), bb[2] | (bb[3] << 16)};
        }
        __syncthreads();
    }
}

__device__ __forceinline__ void lds_barrier() { asm volatile("s_waitcnt lgkmcnt(0)" ::: "memory"); __builtin_amdgcn_s_barrier(); asm volatile("" ::: "memory"); }
__device__ __forceinline__ void rwkv_cscan_item(const Params& P, int layer, int sidx_all, int h, int dir, unsigned char* ldsraw, int variant = 0) {
    const int tid = phase_tid(), lane = tid & 63, w = __builtin_amdgcn_readfirstlane(tid >> 6), l15 = lane & 15, q = lane >> 4;
    const bool loader = w >= 4; const int vq = w & 3, ltid = tid & 255;
    const bool isctx = sidx_all < 16;
    const int L = isctx ? 256 : 2048, sb = isctx ? sidx_all * 256 : CTXTOK + (sidx_all - 16) * 2048, nch = L / 16;
    unsigned char* ws = opaque_ws(P);
    const unsigned char* CHR = ws + WS_CHR;
    const unsigned char* Vrow = ws + WS_RWB + 2 * RWB * 2 + h * 128;
    bf16_t* Yb = (bf16_t*)(ws + (variant ? (WS_END + (size_t)dir * MTOK * 256 * 2) : (dir ? WS_YRB : WS_YRF)));
    const int yo = h * 64 + 16 * vq + l15 + (dir ? -4 * q : 4 * q) * 256, ystep = dir ? -256 : 256;
    const int b = isctx ? sidx_all : sidx_all - 16;
    const size_t sidx = ((size_t)(((b * 2 + layer) * 2 + dir) * 4 + h) * 64 + 16 * vq + l15) * 64;
    constexpr int D = 8, SLOT = CHR_U + 2048, NPC = 4, NPIECE = CHR_U / 16 + 128;
    int poff[NPC], plo[NPC]; bool pv[NPC], pc[NPC];
#pragma unroll
    for (int k = 0; k < NPC; ++k) { const int p = ltid + 256 * k; pv[k] = loader && p < NPIECE; pc[k] = p < 656; plo[k] = (p < 656 ? p * 16 : CHR_U + (p - 656) * 16);
        const int vr = p - 656; poff[k] = pc[k] ? p * 16 : (dir ? -(vr >> 3) : (vr >> 3)) * 512 + (vr & 7) * 16; }
    auto tokd = [&](int n) -> int { return sb + (dir ? (L - 1 - n) : n); };
    auto gl = [&](int c, u32x4 (&R)[NPC]) {
        const unsigned char* bC = CHR + chr_unit_off((sb >> 4) + (dir ? nch - 1 - c : c), h, dir);
        const unsigned char* bV = Vrow + (size_t)tokd(c * 16) * 512;
#pragma unroll
        for (int k = 0; k < NPC; ++k) if (pv[k]) R[k] = *(const u32x4*)((pc[k] ? bC : bV) + poff[k]);
    };
    auto st = [&](int slot, const u32x4 (&R)[NPC]) {
#pragma unroll
        for (int k = 0; k < NPC; ++k) if (pv[k]) *(u32x4*)(ldsraw + slot * SLOT + plo[k]) = R[k];
    };
    struct Ops { u32x4 kp0, kp1, rp0, rp1, su0, su1, su2, su3, ya; u32x2 mi, xa, vb; f32x4 g0, g1, g2, g3; };
    auto lds_ops = [&](int slot) -> Ops {
        const unsigned char* U = ldsraw + slot * SLOT; Ops o;
        o.kp0 = *(const u32x4*)(U + lane * 16); o.kp1 = *(const u32x4*)(U + 1024 + lane * 16); o.rp0 = *(const u32x4*)(U + 2048 + lane * 16); o.rp1 = *(const u32x4*)(U + 3072 + lane * 16);
        o.su0 = *(const u32x4*)(U + 4096 + lane * 16); o.su1 = *(const u32x4*)(U + 5120 + lane * 16); o.su2 = *(const u32x4*)(U + 6144 + lane * 16); o.su3 = *(const u32x4*)(U + 7168 + lane * 16);
        o.ya = *(const u32x4*)(U + 8192 + lane * 16); o.mi = *(const u32x2*)(U + 9216 + lane * 8); o.xa = *(const u32x2*)(U + 9728 + lane * 8);
        const float* gt = (const float*)(U + 10240) + 4 * q;
        o.g0 = *(const f32x4*)gt; o.g1 = *(const f32x4*)(gt + 16); o.g2 = *(const f32x4*)(gt + 32); o.g3 = *(const f32x4*)(gt + 48);
        const bf16_t* vl = (const bf16_t*)(U + CHR_U) + (4 * q) * 64 + 16 * vq + l15;
        o.vb.x = (unsigned)vl[0] | ((unsigned)vl[64] << 16); o.vb.y = (unsigned)vl[128] | ((unsigned)vl[192] << 16);
        return o;
    };
    f32x4 Z[4];
#pragma unroll
    for (int rb = 0; rb < 4; ++rb) Z[rb] = (isctx || loader) ? (f32x4){0.f, 0.f, 0.f, 0.f} : *(const f32x4*)(inp(P, 5) + sidx + 16 * rb + 4 * q);
    const f32x4 z4 = {0.f, 0.f, 0.f, 0.f};
    auto compute = [&](int c, const Ops& o) {
        u32x4 zb0, zb1;
        zb0.x = pack_bf16(Z[0][0], Z[0][1]); zb0.y = pack_bf16(Z[0][2], Z[0][3]); zb0.z = pack_bf16(Z[1][0], Z[1][1]); zb0.w = pack_bf16(Z[1][2], Z[1][3]);
        zb1.x = pack_bf16(Z[2][0], Z[2][1]); zb1.y = pack_bf16(Z[2][2], Z[2][3]); zb1.z = pack_bf16(Z[3][0], Z[3][1]); zb1.w = pack_bf16(Z[3][2], Z[3][3]);
        f32x4 X = MFMA16(o.xa, o.vb, z4); X = MFMA32(o.kp0, zb0, X); X = MFMA32(o.kp1, zb1, X);
        u32x2 xb; xb.x = pack_bf16(X[0], X[1]); xb.y = pack_bf16(X[2], X[3]);
        const f32x4 Uv = MFMA16(o.mi, xb, z4);
        u32x4 uv; uv.x = pack_bf16(Uv[0], Uv[1]); uv.y = pack_bf16(Uv[2], Uv[3]); uv.z = o.vb.x; uv.w = o.vb.y;
        Z[0] = MFMA32(o.su0, uv, Z[0]) * o.g0; Z[1] = MFMA32(o.su1, uv, Z[1]) * o.g1; Z[2] = MFMA32(o.su2, uv, Z[2]) * o.g2; Z[3] = MFMA32(o.su3, uv, Z[3]) * o.g3;
        if (variant != 2) {
        f32x4 Yv = MFMA32(o.rp0, zb0, z4); Yv = MFMA32(o.rp1, zb1, Yv); Yv = MFMA32(o.ya, uv, Yv);
        bf16_t* Yc = Yb + (size_t)tokd(c * 16) * 256;
#pragma unroll
        for (int e = 0; e < 4; ++e) Yc[yo + e * ystep] = f2bf(Yv[e]);
        }
    };
    if (loader) {
        u32x4 R[D][NPC];
        gl(0, R[0]); gl(1, R[1]); st(0, R[0]); st(1, R[1]);
#pragma unroll
        for (int k = 0; k < D; ++k) if (k + 2 < nch) gl(k + 2, R[k]);
        __syncthreads();
        for (int c0 = 0; c0 < nch; c0 += D) {
#pragma unroll
            for (int k = 0; k < D; ++k) {
                const int c = c0 + k;
                if (variant != 4) { if (c + 2 < nch) st((c + 2) % 3, R[k]);
                if (c + 2 + D < nch) gl(c + 2 + D, R[k]); }
                if (variant != 3) lds_barrier();
            }
        }
    } else {
        __syncthreads();
        Ops cur = lds_ops(0);
        for (int c = 0; c < nch; ++c) {
            Ops nxt = cur;
            if (c + 1 < nch) nxt = lds_ops((c + 1) % 3);
            compute(c, cur);
            cur = nxt;
            if (variant != 3) lds_barrier();
        }
    }
    if (isctx && !loader && !variant) {
        float* So = outp(P) + O_RWKV + sidx;
#pragma unroll
        for (int rb = 0; rb < 4; ++rb) *(f32x4*)(So + 16 * rb + 4 * q) = Z[rb];
    }
}

__device__ __forceinline__ void ssd_cscan_item(const Params& P, int layer, int sidx_all, int h, int dir, unsigned char* ldsraw) {
    const int tid = phase_tid(), lane = tid & 63, w = __builtin_amdgcn_readfirstlane(tid >> 6), l15 = lane & 15, q = lane >> 4;
    const bool loader = w >= 4; const int pq = w & 3, ltid = tid & 255;
    const bool isctx = sidx_all < 16;
    const int L = isctx ? 256 : 2048, sb = isctx ? sidx_all * 256 : CTXTOK + (sidx_all - 16) * 2048, nch = L / 16;
    unsigned char* ws = opaque_ws(P);
    const unsigned char* CHS = ws + WS_CHS;
    const unsigned char* Xrow = ws + WS_XBC + h * 128;
    bf16_t* Yb = (bf16_t*)(ws + (dir ? WS_YSB : WS_YSF));
    const int yo = h * 64 + 16 * pq + l15 + (dir ? -4 * q : 4 * q) * 256, ystep = dir ? -256 : 256;
    const int b = isctx ? sidx_all : sidx_all - 16;
    const size_t sidx = ((size_t)(((b * 2 + layer) * 2 + dir) * 4 + h) * 64 + 16 * pq + l15) * 64;
    constexpr int D = 8, SLOT = CHS_U + 2048, NPC = 2, UP = CHS_U / 16, NPIECE = UP + 128;
    int poff[NPC], plo[NPC]; bool pv[NPC], pc[NPC];
#pragma unroll
    for (int k = 0; k < NPC; ++k) { const int p = ltid + 256 * k; pv[k] = loader && p < NPIECE; pc[k] = p < UP; plo[k] = (p < UP ? p * 16 : CHS_U + (p - UP) * 16);
        const int vr = p - UP; poff[k] = pc[k] ? p * 16 : (dir ? -(vr >> 3) : (vr >> 3)) * 1024 + (vr & 7) * 16; }
    auto tokd = [&](int n) -> int { return sb + (dir ? (L - 1 - n) : n); };
    auto gl = [&](int c, u32x4 (&R)[NPC]) {
        const unsigned char* bC = CHS + (size_t)((((sb >> 4) + (dir ? nch - 1 - c : c)) * 4 + h) * 2 + dir) * CHS_U;
        const unsigned char* bV = Xrow + (size_t)tokd(c * 16) * 1024;
#pragma unroll
        for (int k = 0; k < NPC; ++k) if (pv[k]) R[k] = *(const u32x4*)((pc[k] ? bC : bV) + poff[k]);
    };
    auto st = [&](int slot, const u32x4 (&R)[NPC]) {
#pragma unroll
        for (int k = 0; k < NPC; ++k) if (pv[k]) *(u32x4*)(ldsraw + slot * SLOT + plo[k]) = R[k];
    };
    struct Ops { u32x4 cp0, cp1; u32x2 ga, bu0, bu1, bu2, bu3, xb; float aT; };
    auto lds_ops = [&](int slot) -> Ops {
        const unsigned char* U = ldsraw + slot * SLOT; Ops o;
        o.cp0 = *(const u32x4*)(U + lane * 16); o.cp1 = *(const u32x4*)(U + 1024 + lane * 16);
        o.ga = *(const u32x2*)(U + 2048 + lane * 8); o.bu0 = *(const u32x2*)(U + 2560 + lane * 8); o.bu1 = *(const u32x2*)(U + 3072 + lane * 8); o.bu2 = *(const u32x2*)(U + 3584 + lane * 8); o.bu3 = *(const u32x2*)(U + 4096 + lane * 8);
        o.aT = *(const float*)(U + 4608);
        const f32x4 dt4 = *(const f32x4*)(U + 4624 + 16 * q);
        const bf16_t* xl = (const bf16_t*)(U + CHS_U) + (4 * q) * 64 + 16 * pq + l15;
        o.xb.x = pack_bf16(bf2f(xl[0]) * dt4[0], bf2f(xl[64]) * dt4[1]); o.xb.y = pack_bf16(bf2f(xl[128]) * dt4[2], bf2f(xl[192]) * dt4[3]);
        return o;
    };
    f32x4 Wt[4];
#pragma unroll
    for (int rb = 0; rb < 4; ++rb) Wt[rb] = (isctx || loader) ? (f32x4){0.f, 0.f, 0.f, 0.f} : *(const f32x4*)(inp(P, 2) + sidx + 16 * rb + 4 * q);
    const f32x4 z4 = {0.f, 0.f, 0.f, 0.f};
    auto compute = [&](int c, const Ops& o) {
        u32x4 wb0, wb1;
        wb0.x = pack_bf16(Wt[0][0], Wt[0][1]); wb0.y = pack_bf16(Wt[0][2], Wt[0][3]); wb0.z = pack_bf16(Wt[1][0], Wt[1][1]); wb0.w = pack_bf16(Wt[1][2], Wt[1][3]);
        wb1.x = pack_bf16(Wt[2][0], Wt[2][1]); wb1.y = pack_bf16(Wt[2][2], Wt[2][3]); wb1.z = pack_bf16(Wt[3][0], Wt[3][1]); wb1.w = pack_bf16(Wt[3][2], Wt[3][3]);
        Wt[0] = MFMA16(o.bu0, o.xb, Wt[0] * o.aT); Wt[1] = MFMA16(o.bu1, o.xb, Wt[1] * o.aT); Wt[2] = MFMA16(o.bu2, o.xb, Wt[2] * o.aT); Wt[3] = MFMA16(o.bu3, o.xb, Wt[3] * o.aT);
        f32x4 Yv = MFMA16(o.ga, o.xb, z4); Yv = MFMA32(o.cp0, wb0, Yv); Yv = MFMA32(o.cp1, wb1, Yv);
        bf16_t* Yc = Yb + (size_t)tokd(c * 16) * 256;
#pragma unroll
        for (int e = 0; e < 4; ++e) Yc[yo + e * ystep] = f2bf(Yv[e]);
    };
    if (loader) {
        u32x4 R[D][NPC];
        gl(0, R[0]); gl(1, R[1]); st(0, R[0]); st(1, R[1]);
#pragma unroll
        for (int k = 0; k < D; ++k) if (k + 2 < nch) gl(k + 2, R[k]);
        __syncthreads();
        for (int c0 = 0; c0 < nch; c0 += D) {
#pragma unroll
            for (int k = 0; k < D; ++k) {
                const int c = c0 + k;
                if (c + 2 < nch) st((c + 2) % 3, R[k]);
                if (c + 2 + D < nch) gl(c + 2 + D, R[k]);
                lds_barrier();
            }
        }
    } else {
        __syncthreads();
        Ops cur = lds_ops(0);
        for (int c = 0; c < nch; ++c) {
            Ops nxt = cur;
            if (c + 1 < nch) nxt = lds_ops((c + 1) % 3);
            compute(c, cur);
            cur = nxt;
            lds_barrier();
        }
    }
    if (isctx && !loader) {
        float* So = outp(P) + O_SSD + sidx;
#pragma unroll
        for (int rb = 0; rb < 4; ++rb) *(f32x4*)(So + 16 * rb + 4 * q) = Wt[rb];
    }
}

template <int MODE>
__device__ __forceinline__ void attn_item(const Params& P, int layer, int idx, unsigned char* ldsraw) {
    constexpr bool DIFF = MODE >= 2, LAT = (MODE & 1) != 0;
    const int tid = phase_tid(), lane = tid & 63, w = __builtin_amdgcn_readfirstlane(tid >> 6), l15 = lane & 15, quad = lane >> 4;
    unsigned char* ws = opaque_ws(P);
    int sidx, h, qb;
    if (LAT) { qb = idx & 15; h = (idx >> 4) & 3; sidx = idx >> 6; }
    else { qb = idx & 1; h = (idx >> 1) & 3; sidx = idx >> 3; }
    const int sb = LAT ? CTXTOK + sidx * 2048 : sidx * 256;
    const int Lseq = LAT ? 2048 : 256;
    const bf16_t* Q = (const bf16_t*)(ws + (DIFF ? WS_QD : WS_QN));
    const bf16_t* KX = (const bf16_t*)(ws + (DIFF ? WS_KD : WS_KN));
    const bf16_t* VT = (const bf16_t*)(ws + (DIFF ? WS_VTD : WS_VTN));
    const bf16_t* CK = (const bf16_t*)(ws + (DIFF ? WS_CKD : WS_CKN));
    const bf16_t* CVT = (const bf16_t*)(ws + (DIFF ? WS_CVTD : WS_CVTN));
    bf16_t* MIX = (bf16_t*)(ws + WS_HN);
    bf16_t* lds = (bf16_t*)ldsraw;
    constexpr int TS = 64 * GS;
    float* RB = (float*)(ldsraw + 4 * TS * 2);
    int base0 = 0, nlat = 0;
    if (MODE == 1) { const int r0 = 2 * qb; const int b0 = min(max(r0 - 4, 0), 24), b1 = min(max(r0 - 3, 0), 24); base0 = b0; nlat = b1 + 8 - b0;
        for (int i = tid; i < 465; i += NT) RB[i] = inp(P, 24)[((size_t)(layer * 4 + h)) * 465 + i] * LOG2E; }
    const int ntiles = (MODE == 0 || MODE == 2) ? 4 : (MODE == 1 ? 8 + nlat : 40);
    const int qt = qb * 128 + w * 16;
    const bf16_t* qp = Q + (size_t)(sb + qt + l15) * 256 + h * 64 + quad * 8;
    const bf16x8 qf0 = *(const bf16x8*)qp, qf1 = *(const bf16x8*)(qp + 32);
    const int lrow = tid >> 3, lpc = tid & 7;
    u32x4 rk, rv;
    auto gload = [&](int i) {
        const bf16_t* kp; const bf16_t* vp;
        if (!LAT) { kp = KX + (size_t)(sb + 64 * i + lrow) * 256 + h * 64; vp = VT + ((size_t)((sidx * 4 + h) * 64 + lrow)) * 256 + 64 * i; }
        else if (i < 8) { kp = CK + ((size_t)((layer * 2 + sidx) * 512 + 64 * i + lrow)) * 256 + h * 64; vp = CVT + ((size_t)(((layer * 2 + sidx) * 4 + h) * 64 + lrow)) * 512 + 64 * i; }
        else { const int kr = (MODE == 1) ? base0 + (i - 8) : (i - 8);
            kp = KX + (size_t)(sb + 64 * kr + lrow) * 256 + h * 64; vp = VT + (size_t)1048576 + ((size_t)((sidx * 4 + h) * 64 + lrow)) * 2048 + 64 * kr; }
        rk = *(const u32x4*)(kp + lpc * 8); rv = *(const u32x4*)(vp + lpc * 8);
    };
    auto sstore = [&](int st) { *(u32x4*)(lds + st * 2 * TS + lrow * GS + lpc * 8) = rk; *(u32x4*)(lds + st * 2 * TS + TS + lrow * GS + lpc * 8) = rv; };
    constexpr float CREF = DIFF ? 10.f : 14.f;
    float lA = 0.f, lB = 0.f;
    f32x4 oA[4], oB[4];
#pragma unroll
    for (int i = 0; i < 4; ++i) { oA[i] = (f32x4){0.f, 0.f, 0.f, 0.f}; oB[i] = oA[i]; }
    const int qr = qt >> 6, qc = (qt & 63) + l15;
    const int qbase = min(max(qr - 4, 0), 24), cs = min(max(qc - 8, 0), 48);
    const f32x4 cinit = {-CREF, -CREF, -CREF, -CREF};
    gload(0); sstore(0); __syncthreads();
    for (int i = 0; i < ntiles; ++i) {
        const bool more = i + 1 < ntiles;
        if (more) gload(i + 1);
        const bf16_t* Ks = lds + (i & 1) * 2 * TS; const bf16_t* Vs = Ks + TS;
        bool active = true; int kr = 0;
        if (MODE == 1 && i >= 8) { kr = base0 + (i - 8); active = (kr >= qbase) && (kr < qbase + 8); }
        if (active) {
            f32x4 sA[4], sB[4];
#pragma unroll
            for (int g = 0; g < 4; ++g) {
                const bf16x8 kf0 = *(const bf16x8*)(Ks + (16 * g + l15) * GS + quad * 8), kf1 = *(const bf16x8*)(Ks + (16 * g + l15) * GS + 32 + quad * 8);
                sA[g] = __builtin_amdgcn_mfma_f32_16x16x32_bf16(kf0, qf0, cinit, 0, 0, 0);
                if (DIFF) sB[g] = __builtin_amdgcn_mfma_f32_16x16x32_bf16(kf1, qf1, cinit, 0, 0, 0);
                else sA[g] = __builtin_amdgcn_mfma_f32_16x16x32_bf16(kf1, qf1, sA[g], 0, 0, 0);
            }
            if (MODE == 1 && i >= 8) {
                const float* rb = RB + (kr - qr + 7) * 31 + 15 - qc;
#pragma unroll
                for (int g = 0; g < 4; ++g)
#pragma unroll
                    for (int r = 0; r < 4; ++r) { const int kc = 16 * g + 4 * quad + r; const bool ok = (kc >= cs) && (kc < cs + 16);
                        sA[g][r] = ok ? sA[g][r] + rb[ok ? kc : qc] : -INFINITY; }
            }
            u32x2 pA[4], pB[4];
#pragma unroll
            for (int g = 0; g < 4; ++g) { f32x4 p; for (int r = 0; r < 4; ++r) { p[r] = __builtin_amdgcn_exp2f(sA[g][r]); lA += p[r]; } pA[g].x = pack_bf16(p[0], p[1]); pA[g].y = pack_bf16(p[2], p[3]); }
            if (DIFF) {
#pragma unroll
                for (int g = 0; g < 4; ++g) { f32x4 p; for (int r = 0; r < 4; ++r) { p[r] = __builtin_amdgcn_exp2f(sB[g][r]); lB += p[r]; } pB[g].x = pack_bf16(p[0], p[1]); pB[g].y = pack_bf16(p[2], p[3]); }
            }
#pragma unroll
            for (int kk = 0; kk < 2; ++kk) {
                u32x4 pfa; pfa.x = pA[2 * kk].x; pfa.y = pA[2 * kk].y; pfa.z = pA[2 * kk + 1].x; pfa.w = pA[2 * kk + 1].y;
                u32x4 pfb; if (DIFF) { pfb.x = pB[2 * kk].x; pfb.y = pB[2 * kk].y; pfb.z = pB[2 * kk + 1].x; pfb.w = pB[2 * kk + 1].y; }
#pragma unroll
                for (int db = 0; db < 4; ++db) {
                    const bf16_t* vp = Vs + (16 * db + l15) * GS + 32 * kk + 4 * quad;
                    const u32x2 v0 = *(const u32x2*)vp, v1 = *(const u32x2*)(vp + 16);
                    u32x4 vf; vf.x = v0.x; vf.y = v0.y; vf.z = v1.x; vf.w = v1.y;
                    oA[db] = __builtin_amdgcn_mfma_f32_16x16x32_bf16(__builtin_bit_cast(bf16x8, vf), __builtin_bit_cast(bf16x8, pfa), oA[db], 0, 0, 0);
                    if (DIFF) oB[db] = __builtin_amdgcn_mfma_f32_16x16x32_bf16(__builtin_bit_cast(bf16x8, vf), __builtin_bit_cast(bf16x8, pfb), oB[db], 0, 0, 0);
                }
            }
        }
        if (more) sstore((i + 1) & 1);
        __syncthreads();
    }
    const float iA = 1.f / allsum_q(lA);
    bf16_t* op = MIX + (size_t)(sb + qt + l15) * 1024 + (DIFF ? 768 : 256) + h * 64 + quad * 4;
    if (!DIFF) {
#pragma unroll
        for (int db = 0; db < 4; ++db) { const f32x4 o = oA[db] * iA; u32x2 pk; pk.x = pack_bf16(o[0], o[1]); pk.y = pack_bf16(o[2], o[3]); *(u32x2*)(op + 16 * db) = pk; }
    } else {
        const float iB = 1.f / allsum_q(lB);
        float la_ = 0.f, lb_ = 0.f;
        if (lane < 32) { const float* lv = inp(P, 38) + layer * 128; la_ = lv[lane] * lv[32 + lane]; lb_ = lv[64 + lane] * lv[96 + lane]; }
        la_ = allsum64(la_); lb_ = allsum64(lb_);
        const float lam_init = layer == 0 ? 0.2f : (0.8f - 0.6f * 0.7408182206817179f);
        const float lam = __expf(la_) - __expf(lb_) + lam_init;
        f32x4 o[4]; float ssq = 0.f;
#pragma unroll
        for (int db = 0; db < 4; ++db) { o[db] = oA[db] * iA - oB[db] * (iB * lam); ssq += o[db][0] * o[db][0] + o[db][1] * o[db][1] + o[db][2] * o[db][2] + o[db][3] * o[db][3]; }
        ssq = allsum_q(ssq);
        const float rs = __builtin_amdgcn_rsqf(ssq * (1.f / 64.f) + 1e-6f) * (1.f - lam_init);
#pragma unroll
        for (int db = 0; db < 4; ++db) { const f32x4 g = *(const f32x4*)(inp(P, 39) + layer * 64 + 16 * db + quad * 4); const f32x4 r = o[db] * rs * g;
            u32x2 pk; pk.x = pack_bf16(r[0], r[1]); pk.y = pack_bf16(r[2], r[3]); *(u32x2*)(op + 16 * db) = pk; }
    }
    __syncthreads();
}

__device__ __forceinline__ void phase_mix(const Params& P, int layer, unsigned char* ldsraw, int rep = 0, int mask = 0xff, int variant = 0) {
    unsigned* ctr = (unsigned*)(opaque_ws(P) + WS_CTL) + 64 * (1 + layer + 2 * rep);
    volatile unsigned* s_item = (volatile unsigned*)(ldsraw + LDS_BYTES - 16);
    for (;;) {
        if (threadIdx.x == 0) *s_item = atomicAdd(ctr, 1u);
        __syncthreads();
        const int it = (int)*s_item;
        __syncthreads();
        if (it >= 800) break;
        { const int cls = it < 16 ? 0 : it < 32 ? 1 : it < 160 ? 2 : it < 288 ? 3 : it < 416 ? 4 : it < 544 ? 5 : it < 672 ? 6 : 7; if (!((mask >> cls) & 1)) continue; }
        if (it < 16) { const int v = it; rwkv_cscan_item(P, layer, 16 + (v >> 3), (v >> 1) & 3, v & 1, ldsraw, variant); }
        else if (it < 32) { const int v = it - 16; ssd_cscan_item(P, layer, 16 + (v >> 3), (v >> 1) & 3, v & 1, ldsraw); }
        else if (it < 160) attn_item<3>(P, layer, it - 32, ldsraw);
        else if (it < 288) attn_item<1>(P, layer, it - 160, ldsraw);
        else if (it < 416) { const int v = it - 288; rwkv_cscan_item(P, layer, v >> 3, (v >> 1) & 3, v & 1, ldsraw); }
        else if (it < 544) { const int v = it - 416; ssd_cscan_item(P, layer, v >> 3, (v >> 1) & 3, v & 1, ldsraw); }
        else if (it < 672) attn_item<2>(P, layer, it - 544, ldsraw);
        else attn_item<0>(P, layer, it - 672, ldsraw);
    }
}

__device__ __forceinline__ void phase_post(const Params& P, int layer) {
    const int tid = phase_tid(), lane = tid & 63, w = __builtin_amdgcn_readfirstlane(tid >> 6), c4 = lane * 4, head = lane >> 4;
    unsigned char* ws = opaque_ws(P);
    const bf16_t* YSF = (const bf16_t*)(ws + WS_YSF), *YSB = (const bf16_t*)(ws + WS_YSB), *YRF = (const bf16_t*)(ws + WS_YRF), *YRB = (const bf16_t*)(ws + WS_YRB);
    const bf16_t* XBC = (const bf16_t*)(ws + WS_XBC);
    const bf16_t* ZS = (const bf16_t*)(ws + WS_ZS);
    const bf16_t* RWb = (const bf16_t*)(ws + WS_RWB);
    const float* BON = (const float*)(ws + WS_BON);
    bf16_t* MIX = (bf16_t*)(ws + WS_HN);
    const float Dh = inp(P, 20)[layer * 4 + head];
    const f32x4 ng = *(const f32x4*)(inp(P, 21) + layer * 256 + c4);
    const f32x4 lg = *(const f32x4*)(inp(P, 34) + layer * 256 + c4), lb = *(const f32x4*)(inp(P, 35) + layer * 256 + c4);
    u32x2 ysf[4], ysb[4], xs[4], zs[4], yrf[4], yrb[4], vv[4], gt[4]; float bon[4];
    const int gbase = (blockIdx.x * 8 + w) * 4;
#pragma unroll
    for (int r = 0; r < 4; ++r) { const int g = gbase + r; const size_t o = (size_t)g * 256 + c4;
        ysf[r] = *(const u32x2*)(YSF + o); ysb[r] = *(const u32x2*)(YSB + o); xs[r] = *(const u32x2*)(XBC + (size_t)g * 512 + c4); zs[r] = *(const u32x2*)(ZS + o);
        yrf[r] = *(const u32x2*)(YRF + o); yrb[r] = *(const u32x2*)(YRB + o); vv[r] = *(const u32x2*)(RWb + 2 * RWB + o); gt[r] = *(const u32x2*)(RWb + 7 * RWB + o); bon[r] = BON[(size_t)g * 4 + head]; }
    auto cvp = [&](const u32x2 u) -> f32x4 { f32x4 r; r[0] = __uint_as_float(u.x << 16); r[1] = __uint_as_float(u.x & 0xffff0000u); r[2] = __uint_as_float(u.y << 16); r[3] = __uint_as_float(u.y & 0xffff0000u); return r; };
#pragma unroll
    for (int r = 0; r < 4; ++r) {
        const int g = gbase + r;
        {
            f32x4 y = cvp(ysf[r]) + cvp(ysb[r]) + cvp(xs[r]) * Dh;
            y = y * cvp(zs[r]);
            const float ss = allsum64(y[0] * y[0] + y[1] * y[1] + y[2] * y[2] + y[3] * y[3]);
            y = y * __builtin_amdgcn_rsqf(ss * (1.f / 256.f) + 1e-6f) * ng;
            st4bf(MIX + (size_t)g * 1024 + c4, y);
        }
        {
            f32x4 y = cvp(yrf[r]) + cvp(yrb[r]);
            const float mu = allsum16(y[0] + y[1] + y[2] + y[3]) * (1.f / 64.f);
            const f32x4 dlt = y - mu;
            const float var = allsum16(dlt[0] * dlt[0] + dlt[1] * dlt[1] + dlt[2] * dlt[2] + dlt[3] * dlt[3]) * (1.f / 64.f);
            f32x4 rr = dlt * __builtin_amdgcn_rsqf(var + 64e-5f) * lg + lb;
            rr = rr + cvp(vv[r]) * bon[r];
            rr = rr * cvp(gt[r]);
            st4bf(MIX + (size_t)g * 1024 + 512 + c4, rr);
        }
    }
}

#define XB_TMO      128
#define XB_XCNT(j)  (256  + 64 * (j))
#define XB_XSUB(j)  (1280 + 64 * (j))
#define XB_XGEN(j)  (2304 + 64 * (j))
#define XB_TOP      3328
#define XB_TOPGEN   3392
#define XCD_BAR_WORDS 3456
#define XB_SPIN_CAP (1u << 22)
#define LAS __attribute__((address_space(3)))
__device__ __forceinline__ unsigned xb_ld(unsigned* p)              { return __hip_atomic_load(p, __ATOMIC_RELAXED, __HIP_MEMORY_SCOPE_AGENT); }
__device__ __forceinline__ unsigned xb_add(unsigned* p, unsigned v) { return __hip_atomic_fetch_add(p, v, __ATOMIC_RELAXED, __HIP_MEMORY_SCOPE_AGENT); }
__device__ __forceinline__ unsigned xb_xcc_id() { return (unsigned)__builtin_amdgcn_s_getreg((3 << 11) | 20) & 0xFu; }
#define XB_SPIN(cond, bar) do { unsigned _sp = 0; while (cond) { __builtin_amdgcn_s_sleep(1); \
    if ((++_sp & 255u) == 0u) { if (xb_ld(&(bar)[XB_TMO])) break; if (_sp > XB_SPIN_CAP) { atomicAdd(&(bar)[XB_TMO], 1u); break; } } } } while (0)
struct XcdBarrier { unsigned* bar; unsigned x; volatile unsigned* st; };
__device__ __forceinline__ XcdBarrier xcd_barrier_post(unsigned* bar, volatile unsigned* st) {
    XcdBarrier b; b.bar = bar; b.x = xb_xcc_id(); b.st = st;
    if (threadIdx.x == 0) (void)xb_add(&bar[XB_XCNT(b.x)], 1u);
    return b;
}
__device__ __forceinline__ void xcd_barrier_complete(unsigned* bar, unsigned x, unsigned& nloc, unsigned& nx) {
    const unsigned G = gridDim.x * gridDim.y * gridDim.z;
    unsigned sum, cnt, mine, sp = 0u;
    for (;;) {
        sum = 0u; cnt = 0u; mine = 0u;
#pragma unroll
        for (unsigned j = 0; j < 16; ++j) { const unsigned c = xb_ld(&bar[XB_XCNT(j)]); sum += c; cnt += (c > 0u) ? 1u : 0u; mine = (j == x) ? c : mine; }
        if (sum == G) break;
        __builtin_amdgcn_s_sleep(1);
        if ((++sp & 255u) == 0u) { if (xb_ld(&bar[XB_TMO])) break; if (sp > XB_SPIN_CAP) { atomicAdd(&bar[XB_TMO], 1u); break; } }
    }
    nloc = mine > 0u ? mine : 1u; nx = cnt > 0u ? cnt : 1u;
}
__device__ __forceinline__ void xcd_barrier(const XcdBarrier& b) {
    asm volatile("s_waitcnt vmcnt(0)" ::: "memory");
    __syncthreads();
    if (threadIdx.x == 0) {
        unsigned* bar = b.bar;
        __builtin_amdgcn_s_waitcnt(0);
        unsigned nloc = b.st[0], nx = b.st[1];
        if (nloc == 0u) { xcd_barrier_complete(bar, b.x, nloc, nx); b.st[0] = nloc; b.st[1] = nx; }
        const unsigned old = xb_add(&bar[XB_XSUB(b.x)], 1u);
        const unsigned gen = old / nloc;
        if (old + 1u == (gen + 1u) * nloc) {
            __builtin_amdgcn_fence(__ATOMIC_RELEASE, "agent");
            asm volatile("s_waitcnt vmcnt(0)" ::: "memory");
            const unsigned og = xb_add(&bar[XB_TOP], 1u);
            const unsigned tg = og / nx;
            if (og + 1u == (tg + 1u) * nx) xb_add(&bar[XB_TOPGEN], 1u);
            else XB_SPIN(xb_ld(&bar[XB_TOPGEN]) == tg, bar);
            __builtin_amdgcn_fence(__ATOMIC_ACQUIRE, "agent");
            xb_add(&bar[XB_XGEN(b.x)], 1u);
            asm volatile("s_waitcnt vmcnt(0)" ::: "memory");
        } else {
            XB_SPIN(xb_ld(&bar[XB_XGEN(b.x)]) == gen, bar);
            __builtin_amdgcn_fence(__ATOMIC_ACQUIRE, "agent");
            asm volatile("s_waitcnt vmcnt(0)" ::: "memory");
        }
    }
    __syncthreads();
}

constexpr int NPHASE = 20;
__device__ __forceinline__ void run_phase(const Params& P, int ph, unsigned char* lds) {
    unsigned char* ws = opaque_ws(P);
    if (ph == 0) { phase_prologue(P, (float*)lds); if (PROBE_DUP == 3) { __syncthreads(); phase_prologue(P, (float*)lds); } return; }
    if (ph == 19) { phase_norm(P, 1, 1, false, true, 1, 5120, false); return; }
    const int layer = (ph - 1) / 9, sub = (ph - 1) % 9;
    PG8_LAS unsigned char* gl = (PG8_LAS unsigned char*)lds;
    const int G = gridDim.x, c = blockIdx.x;
    switch (sub) {
    case 0: if (layer == 0) phase_norm(P, 0, 0, true, false, 0, 0, true); else phase_norm(P, 1, 0, false, true, 0, 5120, true);
            if (PROBE_DUP == 13) { __syncthreads(); phase_norm(P, layer, 0, layer == 0, false, 0, 0, true); } break;
    case 1: { pg8::Gemm g{(const bf16_t*)(ws + WS_HN), (const bf16_t*)(ws + WS_WIN) + (size_t)layer * 3584 * 1024, MTOK, NPROJ, 1024, 1024};
              pg8::StaticOrder S; S.init(MTOK, NPROJ, 1, G, c); pg8::EpiBf16<0> E{(bf16_t*)(ws + WS_PROJ), NPROJ, 0};
              pg8::gemm_phase<pg8::EpiBf16<0>, pg8::StaticOrder, true, true>(gl, g, S, E);
              if (PROBE_DUP == 5) { __syncthreads(); pg8::gemm_phase<pg8::EpiBf16<0>, pg8::StaticOrder, true, true>(gl, g, S, E); } } break;
    case 2: for (int it = blockIdx.x; it < 256; it += gridDim.x) { premix_item(P, layer, it, lds); __syncthreads(); prep_item(P, layer, 2 * it, lds); prep_item(P, layer, 2 * it + 1, lds); }
            if (PROBE_DUP == 27) { __syncthreads(); for (int it = blockIdx.x; it < 256; it += gridDim.x) { prep_item(P, layer, 2 * it, lds); prep_item(P, layer, 2 * it + 1, lds); } }
            if (PROBE_DUP == 2) { __syncthreads(); for (int it = blockIdx.x; it < 256; it += gridDim.x) { premix_item(P, layer, it, lds); __syncthreads(); prep_item(P, layer, 2 * it, lds); prep_item(P, layer, 2 * it + 1, lds); } } break;
    case 3: phase_mix(P, layer, lds); if (PROBE_DUP == 1) { __syncthreads(); phase_mix(P, layer, lds, 1); }
            if (PROBE_DUP >= 20 && PROBE_DUP <= 24) { __syncthreads(); phase_mix(P, layer, lds, 1, PROBE_DUP == 20 ? 0x01 : PROBE_DUP == 21 ? 0x02 : PROBE_DUP == 22 ? 0x04 : PROBE_DUP == 23 ? 0x08 : 0xF0); }
            if (PROBE_DUP >= 30 && PROBE_DUP <= 34) { __syncthreads(); phase_mix(P, layer, lds, 1, 0x01, PROBE_DUP - 29); }
            if (PROBE_DUP == 25) { __syncthreads(); phase_mix(P, layer, lds, 1, 0x00); } if (PROBE_DUP == 26) { __syncthreads(); phase_mix(P, layer, lds, 1, 0x09); } break;
    case 4: phase_post(P, layer); if (PROBE_DUP == 4) { __syncthreads(); phase_post(P, layer); } break;
    case 5: { pg8::Gemm g{(const bf16_t*)(ws + WS_HN), (const bf16_t*)(ws + WS_WOUT) + (size_t)layer * 1024 * 1024, MTOK, 1024, 1024, 512};
              pg8::StaticOrder S; S.init(MTOK, 1024, 2, G, c); pg8::EpiBf16<0> E{(bf16_t*)(ws + WS_PART), 1024, (size_t)MTOK * 1024};
              pg8::gemm_phase<pg8::EpiBf16<0>, pg8::StaticOrder, true, true>(gl, g, S, E); } break;
    case 6: phase_norm(P, layer, 1, layer == 0, true, layer, 2048, true);
            if (PROBE_DUP == 13) { __syncthreads(); phase_norm(P, layer, 1, false, false, 0, 0, true); } break;
    case 7: { pg8::Gemm g{(const bf16_t*)(ws + WS_HN), (const bf16_t*)(ws + WS_WFF1) + (size_t)layer * 4096 * 1024, MTOK, DFF, 1024, 1024};
              pg8::StaticOrder S; S.init(MTOK, DFF, 1, G, c); pg8::EpiBf16<1> E{(bf16_t*)(ws + WS_H), DFF, 0};
              pg8::gemm_phase<pg8::EpiBf16<1>, pg8::StaticOrder, true, true>(gl, g, S, E);
              if (PROBE_DUP == 5) { __syncthreads(); pg8::gemm_phase<pg8::EpiBf16<1>, pg8::StaticOrder, true, true>(gl, g, S, E); } } break;
    case 8: { pg8::Gemm g{(const bf16_t*)(ws + WS_H), (const bf16_t*)(ws + WS_WFF2) + (size_t)layer * 1024 * 4096, MTOK, 1024, 4096, 2048};
              pg8::StaticOrder S; S.init(MTOK, 1024, 2, G, c); pg8::EpiBf16<0> E{(bf16_t*)(ws + WS_PART), 1024, (size_t)MTOK * 1024};
              pg8::gemm_phase<pg8::EpiBf16<0>, pg8::StaticOrder, true, true>(gl, g, S, E); } break;
    }
}

__global__ void __launch_bounds__(NT, 2) mk_kernel(Params P) {
    extern __shared__ __attribute__((aligned(16))) unsigned char lds[];
#if MK_MULTI
    run_phase(P, P.ph_lo, lds);
#else
    volatile unsigned* xst = (volatile unsigned*)(lds + LDS_BYTES - 32);
    if (threadIdx.x == 0) { xst[0] = 0u; xst[1] = 0u; }
    __syncthreads();
    XcdBarrier xb = xcd_barrier_post((unsigned*)(opaque_ws(P) + WS_CTL) + 1024, xst);
#define PHS(k) run_phase(P, k, lds); xcd_barrier(xb); if (PROBE_DUP == 14) xcd_barrier(xb);
    PHS(0) PHS(1) PHS(2) PHS(3) PHS(4) PHS(5) PHS(6) PHS(7) PHS(8) PHS(9) PHS(10) PHS(11) PHS(12) PHS(13) PHS(14) PHS(15) PHS(16) PHS(17) PHS(18)
    run_phase(P, 19, lds);
#undef PHS
#endif
}

extern "C" void kernel_launch(void* const* d_in, const int* in_sizes, int n_in, void* d_out, int out_size, void* d_ws, size_t ws_size, hipStream_t stream) {
    static int grid = 0;
    if (grid == 0) {
        if (n_in != 42 || ws_size < WS_END) { fprintf(stderr, "kernel_launch: unexpected n_in %d / ws_size %zu (need %zu)\n", n_in, ws_size, (size_t)WS_END); grid = -1; return; }
        int dev = 0, cus = 0, per_cu = 0;
        hipGetDevice(&dev); hipDeviceGetAttribute(&cus, hipDeviceAttributeMultiprocessorCount, dev);
        if (hipFuncSetAttribute((const void*)mk_kernel, hipFuncAttributeMaxDynamicSharedMemorySize, LDS_BYTES) != hipSuccess) { fprintf(stderr, "hipFuncSetAttribute failed\n"); grid = -1; return; }
        hipOccupancyMaxActiveBlocksPerMultiprocessor(&per_cu, (const void*)mk_kernel, NT, LDS_BYTES);
        if (per_cu < 1) { fprintf(stderr, "occupancy query says %d blocks/CU\n", per_cu); grid = -1; return; }
        grid = cus;
    }
    if (grid < 0) return;
    hipMemsetAsync((char*)d_ws + WS_CTL, 0, 65536, stream);
    Params p{};
    for (int i = 0; i < 42; ++i) p.in[i] = (const float*)d_in[i];
    p.out = (float*)d_out; p.ws = (unsigned char*)d_ws;
#if MK_MULTI
    for (int ph = 0; ph < NPHASE; ++ph) {
        p.ph_lo = ph; p.ph_hi = ph + 1;
        hipLaunchKernelGGL(mk_kernel, dim3(grid), dim3(NT), LDS_BYTES, stream, p);
    }
#else
    p.ph_lo = 0; p.ph_hi = NPHASE;
    void* args[] = {&p};
    hipError_t e = hipLaunchCooperativeKernel((const void*)mk_kernel, dim3(grid), dim3(NT), args, LDS_BYTES, stream);
    if (e != hipSuccess) fprintf(stderr, "cooperative launch failed: %s (grid %d)\n", hipGetErrorString(e), grid);
#endif
}
```

```cpp
#include <hip/hip_runtime.h>
#include <hip/hip_cooperative_groups.h>
#include <cstdint>
#include <cstdio>
namespace cg = cooperative_groups;

#ifndef PROBE_DUP
#define PROBE_DUP 0
#endif
#ifndef PROBE_TS
#define PROBE_TS -1
#endif
#ifndef PROBE_TS2
#define PROBE_TS2 -1
#endif
#ifndef PROBE_SEC
#define PROBE_SEC 0
#endif
#ifndef PROBE_ITEM_A
#define PROBE_ITEM_A -1
#define PROBE_ITEM_R -1
#endif
#ifndef MK_MULTI
#define MK_MULTI 0
#endif

typedef unsigned short bf16_t;
typedef short bf16x8 __attribute__((ext_vector_type(8)));
typedef float f32x4 __attribute__((ext_vector_type(4)));
typedef float f32x2 __attribute__((ext_vector_type(2)));
typedef unsigned u32x4 __attribute__((ext_vector_type(4)));
typedef unsigned u32x2 __attribute__((ext_vector_type(2)));

constexpr int NT = 512;
constexpr int MTOK = 8192, CTXTOK = 4096;
constexpr int D = 1024, NPROJ = 3584, DFF = 4096;
constexpr int LDS_BYTES = 131072 + 256;
constexpr float LOG2E = 1.4426950408889634f;

constexpr int PC_Z = 0, PC_XBC = 256, PC_NAT = 768, PC_RW = 1536, PC_DIFF = 2688, PC_DT = 3456;

constexpr size_t O_Y = 0, O_SSD = 8388608, O_NATK = 9437184, O_NATV = 11534336, O_RWKV = 13631488, O_DIFFK = 14680064, O_DIFFV = 16777216;

constexpr size_t WS_CTL = 0;
constexpr size_t WS_MOD = 65536;
constexpr size_t WS_ROPE = WS_MOD + 2 * 3 * 6144 * 4;
constexpr size_t WS_LORA = WS_ROPE + 4096;
constexpr size_t WS_WIN = WS_LORA + 393216;
constexpr size_t WS_WOUT = WS_WIN + (size_t)2 * 3584 * 1024 * 2;
constexpr size_t WS_WFF1 = WS_WOUT + (size_t)2 * 1024 * 1024 * 2;
constexpr size_t WS_WFF2 = WS_WFF1 + (size_t)2 * 4096 * 1024 * 2;
constexpr size_t WS_CKN = WS_WFF2 + (size_t)2 * 4096 * 1024 * 2;
constexpr size_t WS_CVTN = WS_CKN + 1048576;
constexpr size_t WS_CKD = WS_CVTN + 1048576;
constexpr size_t WS_CVTD = WS_CKD + 1048576;
constexpr size_t WS_HN = WS_CVTD + 1048576;
constexpr size_t WS_PROJ = WS_HN + (size_t)MTOK * 1024 * 2;
constexpr size_t WS_PART = WS_PROJ;
constexpr size_t WS_XBC = WS_PROJ + (size_t)MTOK * NPROJ * 2;
constexpr size_t WS_DTA = WS_XBC + (size_t)MTOK * 512 * 2;
constexpr size_t WS_ZS = WS_DTA + (size_t)MTOK * 16 * 4;
constexpr size_t WS_QN = WS_ZS + (size_t)MTOK * 256 * 2;
constexpr size_t WS_KN = WS_QN + (size_t)MTOK * 256 * 2;
constexpr size_t WS_VTN = WS_KN + (size_t)MTOK * 256 * 2;
constexpr size_t WS_QD = WS_VTN + (size_t)MTOK * 256 * 2;
constexpr size_t WS_KD = WS_QD + (size_t)MTOK * 256 * 2;
constexpr size_t WS_VTD = WS_KD + (size_t)MTOK * 256 * 2;
constexpr size_t WS_H = WS_VTD + (size_t)MTOK * 256 * 2;
constexpr size_t RWB = (size_t)MTOK * 256;
constexpr size_t WS_RWB = WS_H;
constexpr size_t WS_DEC = WS_RWB + 8 * RWB * 2;
constexpr size_t WS_YSF = WS_DEC + 2 * RWB * 4;
constexpr size_t WS_YSB = WS_YSF + (size_t)MTOK * 256 * 2;
constexpr size_t WS_YRF = WS_YSB + (size_t)MTOK * 256 * 2;
constexpr size_t WS_YRB = WS_YRF + (size_t)MTOK * 256 * 2;
constexpr size_t WS_BON = WS_H + (size_t)MTOK * DFF * 2;
static_assert(WS_YRB + (size_t)MTOK * 256 * 2 <= WS_BON, "h overlay");
constexpr int CHR_U = 10496;
constexpr int CHS_U = 4688;
constexpr size_t WS_CHR = WS_PROJ;
constexpr size_t CHR_TILE = (size_t)32 * NPROJ * 2, CHR_OFF = (size_t)2 * NPROJ * 2;
static_assert(CHR_OFF + 16 * (size_t)CHR_U <= (size_t)30 * NPROJ * 2, "chr inside tile");
__host__ __device__ inline size_t chr_unit_off(int cn_g, int h, int dir) { return (size_t)(cn_g >> 1) * CHR_TILE + CHR_OFF + (size_t)((((cn_g & 1) * 4 + h) * 2) + dir) * CHR_U; }
static_assert((size_t)4096 * CHR_U <= (size_t)MTOK * NPROJ * 2, "chr overlay");
constexpr size_t WS_CHS = WS_BON + (size_t)MTOK * 4 * 4;
constexpr size_t WS_QR = WS_CHS + (size_t)4096 * CHS_U;
constexpr size_t WS_QS = WS_QR + (size_t)4 * 1024 * 256 * 2;
constexpr size_t WS_ZMR = WS_QS + (size_t)4 * 1024 * 256 * 2;
constexpr size_t WS_ZMS = WS_ZMR + (size_t)16 * 4096 * 2;
constexpr size_t WS_END = WS_ZMS + (size_t)16 * 4096 * 2;
static_assert(WS_END <= (size_t)268435456, "workspace");

struct Params {
    const float* in[42];
    float* out;
    unsigned char* ws;
    int ph_lo, ph_hi;
};

__device__ __forceinline__ float bf2f(unsigned short h) { return __uint_as_float((unsigned)h << 16); }
typedef __bf16 bf16x2_t __attribute__((ext_vector_type(2)));
__device__ __forceinline__ unsigned pack_bf16(float lo, float hi) { f32x2 v = {lo, hi}; bf16x2_t r = __builtin_convertvector(v, bf16x2_t); return __builtin_bit_cast(unsigned, r); }
__device__ __forceinline__ unsigned short f2bf(float f) { return (unsigned short)(pack_bf16(f, 0.f) & 0xffffu); }
__device__ __forceinline__ f32x4 ld4bf(const bf16_t* p) { const u32x2 u = *(const u32x2*)p; f32x4 r; r[0] = __uint_as_float(u.x << 16); r[1] = __uint_as_float(u.x & 0xffff0000u); r[2] = __uint_as_float(u.y << 16); r[3] = __uint_as_float(u.y & 0xffff0000u); return r; }
__device__ __forceinline__ void st4bf(bf16_t* p, f32x4 v) { u32x2 pk; pk.x = pack_bf16(v[0], v[1]); pk.y = pack_bf16(v[2], v[3]); *(u32x2*)p = pk; }
__device__ __forceinline__ float frcp(float x) { return __builtin_amdgcn_rcpf(x); }
__device__ __forceinline__ float siluf(float x) { return x * frcp(1.f + __expf(-x)); }
__device__ __forceinline__ float sigmoidf_(float x) { return frcp(1.f + __expf(-x)); }
__device__ __forceinline__ float softplusf_(float x) { return fmaxf(x, 0.f) + __logf(1.f + __expf(-fabsf(x))); }
__device__ __forceinline__ float tanhf_(float x) { const float e = __expf(-2.f * fabsf(x)); const float t = (1.f - e) * frcp(1.f + e); return x < 0.f ? -t : t; }
__device__ __forceinline__ int phase_tid() { int t = threadIdx.x; asm volatile("" : "+v"(t)); return t & 511; }
template <int CTRL> __device__ __forceinline__ float dpp_mov(float x) {
    return __builtin_bit_cast(float, __builtin_amdgcn_update_dpp(0, __builtin_bit_cast(int, x), CTRL, 0xf, 0xf, true));
}
__device__ __forceinline__ float allsum4(float x) { x += dpp_mov<0xB1>(x); x += dpp_mov<0x4E>(x); return x; }
__device__ __forceinline__ float allsum8(float x) { x = allsum4(x); x += dpp_mov<0x141>(x); return x; }
__device__ __forceinline__ float allsum16(float x) { x = allsum8(x); x += dpp_mov<0x140>(x); return x; }
__device__ __forceinline__ float allsum_q(float x);
__device__ __forceinline__ float allsum64(float x) { return allsum_q(allsum16(x)); }
__device__ __forceinline__ float wavesum64(float x) {
    x = allsum16(x);
    x += __builtin_bit_cast(float, __builtin_amdgcn_update_dpp(0, __builtin_bit_cast(int, x), 0x142, 0xa, 0xf, false));
    x += __builtin_bit_cast(float, __builtin_amdgcn_update_dpp(0, __builtin_bit_cast(int, x), 0x143, 0xc, 0xf, false));
    return __builtin_bit_cast(float, __builtin_amdgcn_readlane(__builtin_bit_cast(int, x), 63));
}
__device__ __forceinline__ float allmax_q(float x) { x = fmaxf(x, __shfl_xor(x, 16)); x = fmaxf(x, __shfl_xor(x, 32)); return x; }
__device__ __forceinline__ float allsum_q(float x) { x += __shfl_xor(x, 16); x += __shfl_xor(x, 32); return x; }
__device__ __forceinline__ int opaque_uniform(int k) { asm volatile("" : "+v"(k)); return __builtin_amdgcn_readfirstlane(k); }
#define GAS __attribute__((address_space(1)))
template <class T> __device__ __forceinline__ T* opaque_ptr(T* p) {
    unsigned long long u = (unsigned long long)p; unsigned lo = (unsigned)u, hi = (unsigned)(u >> 32);
    asm volatile("" : "+v"(lo), "+v"(hi));
    lo = __builtin_amdgcn_readfirstlane(lo); hi = __builtin_amdgcn_readfirstlane(hi);
    return (T*)(T GAS*)(((unsigned long long)hi << 32) | lo);
}
__device__ __forceinline__ const float* inp(const Params& P, int k) { return (const float*)(const float GAS*)(unsigned long long)P.in[opaque_uniform(k)]; }
__device__ __forceinline__ float* outp(const Params& P) { return opaque_ptr(P.out); }
__device__ __forceinline__ unsigned char* opaque_ws(const Params& P) { return opaque_ptr(P.ws); }
namespace pg8 {
#define PG8_LAS __attribute__((address_space(3)))
typedef unsigned short bf16_t;
typedef short bf16x8 __attribute__((ext_vector_type(8)));
typedef float f32x4 __attribute__((ext_vector_type(4)));
typedef unsigned u32x4 __attribute__((ext_vector_type(4)));
constexpr int BM = 256, BK = 64, HALF = 128, HTB = HALF * BK * 2  , STAGE_BYTES = 8 * HTB, NXCD = 8, WGM = 8;

__host__ __device__ __forceinline__ int lds_byte(int r, int c) { const int st = (r >> 4) * 2 + (c >> 5), rr = r & 15, cc = c & 31, ob = rr * 64 + cc * 2; return st * 1024 + (ob ^ (((ob >> 9) & 1) << 5)); }
__host__ __device__ __forceinline__ void stage_rc(int b, int& R, int& C) { const int st = b / 1024, sb = b % 1024, swz = sb ^ (((sb >> 9) & 1) << 5); R = (st >> 1) * 16 + swz / 64; C = (st & 1) * 32 + (swz % 64) / 2; }
__host__ __device__ __forceinline__ int perm32(int rho) { const int n = rho >> 4, i = rho & 15; return 8 * (i >> 2) + 4 * n + (i & 3); }

struct Unit { int pm, pn, ks; };
struct Gemm { const bf16_t* A; const bf16_t* Bt; int M, N, K, KL; };
struct StaticOrder {
    int nM, nN, nNs, nwg, G, c;
    __host__ __device__ void init(int M, int N, int SK, int G_, int c_) { nM = M / BM; nN = N / BM; nNs = nN * SK; nwg = nM * nNs; G = G_; c = c_; }
    __host__ __device__ bool next(int i, Unit& u) const {
        const long L = (long)i * G + c; if (L >= nwg) return false;
        int wgid = (int)L; { const int q = nwg / NXCD, r = nwg % NXCD, xcd = wgid % NXCD, off = wgid / NXCD; wgid = (xcd < r ? xcd * (q + 1) : r * (q + 1) + (xcd - r) * q) + off; }
        const int nig = WGM * nNs, gid = wgid / nig, fm = gid * WGM, gsz = (nM - fm) < WGM ? (nM - fm) : WGM;
        u.pm = fm + ((wgid % nig) % gsz); const int pnn = (wgid % nig) / gsz; u.pn = pnn % nN; u.ks = pnn / nN; return true;
    }
    __device__ __forceinline__ void a_ready(const Unit&) const {}
    __device__ __forceinline__ void done(const Unit&) const {}
};
template <class Epi, class Sched, bool ALIGN_EPI = false, bool SP2 = false>
__device__ __forceinline__ void gemm_phase(PG8_LAS unsigned char* lds, const Gemm g, const Sched& S, const Epi& E) {
    const int tid = phase_tid(), wid = __builtin_amdgcn_readfirstlane(tid >> 6), lane = tid & 63, wr = wid >> 2, wc = wid & 3, fr = lane & 15, fq = lane >> 4;
    const int K = g.K, nt = g.KL / BK;
    unsigned voffA[2], voffB[2];
#pragma unroll
    for (int i = 0; i < 2; ++i) { int R, C; stage_rc(tid * 16 + i * 8192, R, C); const int Rb = Epi::PERM ? ((R & ~31) + perm32(R & 31)) : R;
        voffA[i] = (unsigned)(R * K + C) * 2u; voffB[i] = (unsigned)(Rb * K + C) * 2u; }
    const size_t kstep = (size_t)(BK * 2);
    const size_t hstep = (size_t)HALF * K * 2;
    const size_t tstep = 2 * hstep;
    const unsigned ldsw = (unsigned)wid * 1024u;
    const int aoff = lds_byte(wr * 64 + fr, fq * 8), boff = lds_byte(wc * 32 + fr, fq * 8);
#define PG8_SA(b, h) (((b) * 2 + (h)) * HTB)
#define PG8_SB(b, h) ((4 + (b) * 2 + (h)) * HTB)
#define PG8_STAGE(bufoff, gbase, voff) do { _Pragma("unroll") for (int _i = 0; _i < 2; ++_i) \
        __builtin_amdgcn_global_load_lds((const unsigned*)((const char*)(gbase) + (voff)[_i]), (PG8_LAS unsigned*)(lds + (bufoff) + ldsw + _i * 8192), 16, 0, 0); } while (0)
#define PG8_LDA(dst, b, h) do { _Pragma("unroll") for (int m = 0; m < 4; ++m) _Pragma("unroll") for (int k = 0; k < 2; ++k) dst[m][k] = *(const PG8_LAS bf16x8*)(lds + PG8_SA(b, h) + aoff + m * 2048 + k * 1024); } while (0)
#define PG8_LDB(dst, b, h) do { _Pragma("unroll") for (int n = 0; n < 2; ++n) _Pragma("unroll") for (int k = 0; k < 2; ++k) dst[n][k] = *(const PG8_LAS bf16x8*)(lds + PG8_SB(b, h) + boff + n * 2048 + k * 1024); } while (0)
#define PG8_MMA(ai, bj, At, Bt) do { __builtin_amdgcn_s_setprio(1); _Pragma("unroll") for (int m = 0; m < 4; ++m) _Pragma("unroll") for (int n = 0; n < 2; ++n) _Pragma("unroll") for (int k = 0; k < 2; ++k) \
        acc[ai][bj][m][n] = __builtin_amdgcn_mfma_f32_16x16x32_bf16(Bt[n][k], At[m][k], acc[ai][bj][m][n], 0, 0, 0); __builtin_amdgcn_s_setprio(0); } while (0)
#define PG8_WAIT_V(n) asm volatile("s_waitcnt vmcnt(" #n ")" ::: "memory")
#define PG8_WAIT_L(n) asm volatile("s_waitcnt lgkmcnt(" #n ")" ::: "memory")
#define PG8_BAR __builtin_amdgcn_s_barrier()
#define PG8_SCHED __builtin_amdgcn_sched_barrier(0)
    Unit cur, nxt; int ui = 0;
    if (!S.next(0, cur)) return;
    f32x4 acc[2][2][4][2];
#pragma unroll
    for (int a = 0; a < 2; ++a)
#pragma unroll
        for (int b = 0; b < 2; ++b)
#pragma unroll
            for (int m = 0; m < 4; ++m)
#pragma unroll
                for (int n = 0; n < 2; ++n) acc[a][b][m][n] = (f32x4){0.f, 0.f, 0.f, 0.f};
    bf16x8 At[4][2], B0[2][2], B1[2][2];
    const char* cA = (const char*)g.A + (size_t)cur.pm * tstep + (size_t)cur.ks * g.KL * 2; const char* cB = (const char*)g.Bt + (size_t)cur.pn * tstep + (size_t)cur.ks * g.KL * 2;
    S.a_ready(cur);
    if constexpr (SP2) {
        PG8_STAGE(PG8_SB(0, 0), cB, voffB); PG8_STAGE(PG8_SB(0, 1), cB + hstep, voffB); PG8_STAGE(PG8_SA(0, 0), cA, voffA); PG8_STAGE(PG8_SA(0, 1), cA + hstep, voffA);
        if (wr == 1) PG8_BAR;
        PG8_WAIT_V(2); PG8_BAR;
        PG8_STAGE(PG8_SB(1, 0), cB + kstep, voffB); PG8_STAGE(PG8_SA(1, 0), cA + kstep, voffA); PG8_STAGE(PG8_SB(1, 1), cB + hstep + kstep, voffB);
        PG8_WAIT_V(6); PG8_BAR;
    } else {
        PG8_STAGE(PG8_SB(0, 0), cB, voffB); PG8_STAGE(PG8_SA(0, 0), cA, voffA); PG8_STAGE(PG8_SB(0, 1), cB + hstep, voffB); PG8_STAGE(PG8_SA(0, 1), cA + hstep, voffA);
        if (wr == 1) PG8_BAR;
        PG8_WAIT_V(4); PG8_BAR;
        PG8_STAGE(PG8_SB(1, 0), cB + kstep, voffB); PG8_STAGE(PG8_SA(1, 0), cA + kstep, voffA); PG8_STAGE(PG8_SB(1, 1), cB + hstep + kstep, voffB);
        PG8_WAIT_V(6); PG8_BAR;
    }
    for (;;) {
        const bool has_next = S.next(ui + 1, nxt);
        const char* nA = has_next ? (const char*)g.A + (size_t)nxt.pm * tstep + (size_t)nxt.ks * g.KL * 2 : cA; const char* nB = has_next ? (const char*)g.Bt + (size_t)nxt.pn * tstep + (size_t)nxt.ks * g.KL * 2 : cB;
        for (int t = 0; t < nt; t += 2) {
            const bool last = (t == nt - 2);
            const char* a1 = cA + (size_t)(t + 1) * kstep;
            const char* a2 = last ? nA : cA + (size_t)(t + 2) * kstep; const char* b2 = last ? nB : cB + (size_t)(t + 2) * kstep;
            const char* a3 = a2 + kstep; const char* b3 = b2 + kstep;
            if (last && has_next) S.a_ready(nxt);
            if constexpr (SP2) {
            PG8_LDB(B0, 0, 0); PG8_LDB(B1, 0, 1); PG8_SCHED; PG8_LDA(At, 0, 0); PG8_STAGE(PG8_SA(1, 1), a1 + hstep, voffA);
            PG8_WAIT_V(8); PG8_WAIT_L(0); PG8_BAR; PG8_MMA(0, 0, At, B0); PG8_MMA(0, 1, At, B1); PG8_BAR; PG8_SCHED;
            PG8_LDA(At, 0, 1); PG8_STAGE(PG8_SB(0, 0), b2, voffB); PG8_STAGE(PG8_SB(0, 1), b2 + hstep, voffB); PG8_STAGE(PG8_SA(0, 0), a2, voffA);
            PG8_WAIT_V(8); PG8_WAIT_L(0); PG8_BAR; PG8_MMA(1, 0, At, B0); PG8_MMA(1, 1, At, B1); PG8_BAR; PG8_SCHED;
            PG8_LDB(B0, 1, 0); PG8_LDB(B1, 1, 1); PG8_SCHED; PG8_LDA(At, 1, 0); PG8_STAGE(PG8_SA(0, 1), a2 + hstep, voffA);
            PG8_WAIT_V(8); PG8_WAIT_L(0); PG8_BAR; PG8_MMA(0, 0, At, B0); PG8_MMA(0, 1, At, B1); PG8_BAR; PG8_SCHED;
            PG8_LDA(At, 1, 1); PG8_STAGE(PG8_SB(1, 0), b3, voffB); PG8_STAGE(PG8_SB(1, 1), b3 + hstep, voffB); PG8_STAGE(PG8_SA(1, 0), a3, voffA);
            PG8_WAIT_V(8); PG8_WAIT_L(0); PG8_BAR; PG8_MMA(1, 0, At, B0); PG8_MMA(1, 1, At, B1); PG8_BAR; PG8_SCHED;
            } else {
            PG8_LDB(B0, 0, 0); PG8_SCHED; PG8_LDA(At, 0, 0); PG8_STAGE(PG8_SA(1, 1), a1 + hstep, voffA);
            PG8_WAIT_L(8); PG8_BAR; PG8_WAIT_L(0); PG8_MMA(0, 0, At, B0); PG8_BAR; PG8_SCHED;
            PG8_LDB(B1, 0, 1); PG8_STAGE(PG8_SB(0, 0), b2, voffB);
            PG8_BAR; PG8_WAIT_L(0); PG8_MMA(0, 1, At, B1); PG8_BAR;
            PG8_LDA(At, 0, 1); PG8_STAGE(PG8_SA(0, 0), a2, voffA);
            PG8_BAR; PG8_WAIT_L(0); PG8_MMA(1, 0, At, B0); PG8_BAR; PG8_SCHED;
            PG8_STAGE(PG8_SB(0, 1), b2 + hstep, voffB);
            PG8_WAIT_V(6); PG8_BAR; PG8_MMA(1, 1, At, B1); PG8_BAR;
            PG8_LDB(B0, 1, 0); PG8_SCHED; PG8_LDA(At, 1, 0); PG8_STAGE(PG8_SA(0, 1), a2 + hstep, voffA);
            PG8_WAIT_L(8); PG8_BAR; PG8_WAIT_L(0); PG8_MMA(0, 0, At, B0); PG8_BAR; PG8_SCHED;
            PG8_LDB(B1, 1, 1); PG8_STAGE(PG8_SB(1, 0), b3, voffB);
            PG8_BAR; PG8_WAIT_L(0); PG8_MMA(0, 1, At, B1); PG8_BAR;
            PG8_LDA(At, 1, 1); PG8_STAGE(PG8_SA(1, 0), a3, voffA);
            PG8_BAR; PG8_WAIT_L(0); PG8_MMA(1, 0, At, B0); PG8_BAR; PG8_SCHED;
            PG8_STAGE(PG8_SB(1, 1), b3 + hstep, voffB);
            PG8_WAIT_V(6); PG8_BAR; PG8_MMA(1, 1, At, B1); PG8_BAR;
            }
        }
        if constexpr (ALIGN_EPI) { if (wr == 0) PG8_BAR; }
        if constexpr (!Epi::AFTER_DRAIN) { E(acc, cur, wr, wc, fr, fq); S.done(cur); }
        if (!has_next) break;
#pragma unroll
        for (int a = 0; a < 2; ++a)
#pragma unroll
            for (int b = 0; b < 2; ++b)
#pragma unroll
                for (int m = 0; m < 4; ++m)
#pragma unroll
                    for (int n = 0; n < 2; ++n) acc[a][b][m][n] = (f32x4){0.f, 0.f, 0.f, 0.f};
        cur = nxt; cA = nA; cB = nB; ++ui;
        if constexpr (ALIGN_EPI) { if (wr == 1) PG8_BAR; }
    }
    PG8_WAIT_V(0);
    if constexpr (!ALIGN_EPI) { if (wr == 0) PG8_BAR; }
    PG8_BAR;
    if constexpr (Epi::AFTER_DRAIN) { E.fused(acc, cur, wr, wc, fr, fq, lds, wid, lane); S.done(cur); }
#undef PG8_SA
#undef PG8_SB
#undef PG8_STAGE
#undef PG8_LDA
#undef PG8_LDB
#undef PG8_MMA
#undef PG8_WAIT_V
#undef PG8_WAIT_L
#undef PG8_BAR
#undef PG8_SCHED
}
}

namespace pg8 {
template <int ACT> struct EpiBf16 {
    static constexpr bool PERM = true, AFTER_DRAIN = false;
    bf16_t* O; int ldc; size_t slab; int total_bytes;
    __device__ __forceinline__ void operator()(const f32x4 (&acc)[2][2][4][2], const Unit& u, int wr, int wc, int fr, int fq) const {
        const int row0 = u.pm * BM + wr * 64 + fr, col0 = u.pn * BM + wc * 32 + 8 * fq;
        const __amdgpu_buffer_rsrc_t rs = __builtin_amdgcn_make_buffer_rsrc((void*)O, (short)0, total_bytes, 0x00020000);
        const unsigned ob = (unsigned)((size_t)u.ks * slab * 2);
#pragma unroll
        for (int ai = 0; ai < 2; ++ai)
#pragma unroll
            for (int m = 0; m < 4; ++m) { const unsigned roff = ob + (unsigned)(((size_t)(row0 + ai * HALF + m * 16) * ldc + col0) * 2);
#pragma unroll
                for (int bj = 0; bj < 2; ++bj) { f32x4 v0 = acc[ai][bj][m][0], v1 = acc[ai][bj][m][1];
                    if (ACT == 1) {
#pragma unroll
                        for (int e = 0; e < 4; ++e) { const float a = fmaxf(v0[e], 0.f), b = fmaxf(v1[e], 0.f); v0[e] = a * a; v1[e] = b * b; } }
                    u32x4 w; w.x = ::pack_bf16(v0[0], v0[1]); w.y = ::pack_bf16(v0[2], v0[3]); w.z = ::pack_bf16(v1[0], v1[1]); w.w = ::pack_bf16(v1[2], v1[3]);
                    __builtin_amdgcn_raw_buffer_store_b128(w, rs, roff + bj * HALF * 2, 0, 16); } }
    }
};
struct EpiF32 {
    static constexpr bool PERM = false, AFTER_DRAIN = false;
    float* O; int ldc; size_t slab;
    __device__ __forceinline__ void operator()(const f32x4 (&acc)[2][2][4][2], const Unit& u, int wr, int wc, int fr, int fq) const {
        const int row0 = u.pm * BM + wr * 64 + fr, col0 = u.pn * BM + wc * 32 + 4 * fq;
        float* base = O + (size_t)u.ks * slab;
#pragma unroll
        for (int ai = 0; ai < 2; ++ai)
#pragma unroll
            for (int m = 0; m < 4; ++m) { float* rowp = base + (size_t)(row0 + ai * HALF + m * 16) * ldc + col0;
#pragma unroll
                for (int bj = 0; bj < 2; ++bj)
#pragma unroll
                    for (int n = 0; n < 2; ++n) *(f32x4*)(rowp + bj * HALF + n * 16) = acc[ai][bj][m][n]; }
    }
};
}

extern __shared__ __attribute__((aligned(16))) unsigned char g_lds[];
#ifndef SEC_A0
#define SEC_A0 0
#define SEC_A1 1
#define SEC_R0 1
#define SEC_R1 2
#endif
#define STAMP(i) do { if (PROBE_SEC && blockIdx.x == 0 && threadIdx.x == 0) ((volatile unsigned long long*)(g_lds + LDS_BYTES - 160))[i] = __builtin_amdgcn_s_memrealtime(); } while (0)
__device__ __forceinline__ __amdgpu_buffer_rsrc_t wt_rsrc(const void* base, unsigned bytes) { return __builtin_amdgcn_make_buffer_rsrc((void*)base, (short)0, (int)bytes, 0x00020000); }
__device__ __forceinline__ void wt_st16(__amdgpu_buffer_rsrc_t rs, unsigned off, u32x4 v) { __builtin_amdgcn_raw_buffer_store_b128(v, rs, off, 0, 16); }
__device__ __forceinline__ void wt_st8(__amdgpu_buffer_rsrc_t rs, unsigned off, u32x2 v) { __builtin_amdgcn_raw_buffer_store_b64(v, rs, off, 0, 16); }
struct TokInfo { int seqbase, t, L, cond, isctx, sidx; };
__device__ __forceinline__ TokInfo tokinfo(int g) {
    TokInfo r;
    if (g < CTXTOK) { r.isctx = 1; r.sidx = g >> 8; r.t = g & 255; r.L = 256; r.seqbase = r.sidx << 8; r.cond = 0; }
    else { int q = g - CTXTOK; r.isctx = 0; r.sidx = q >> 11; r.t = q & 2047; r.L = 2048; r.seqbase = CTXTOK + (r.sidx << 11); r.cond = 1 + r.sidx; }
    return r;
}

constexpr int WT_IN = 2 * 56 * 16, WT_OUT = 2 * 16 * 16, WT_F1 = 2 * 64 * 16, WT_F2 = 2 * 16 * 64, WT_ALL = WT_IN + WT_OUT + WT_F1 + WT_F2;
__device__ __forceinline__ void convert_batch(const Params& P, float* lds, int u0, int ustride, int ulimit) {
    const int tid = phase_tid();
    unsigned char* ws = opaque_ws(P);
    const int nn = tid & 63;
    float v[4][8]; bf16_t* dstp[4]; int dK[4], dk0[4], dn0[4]; bool act[4];
#pragma unroll
    for (int j = 0; j < 4; ++j) {
        const int u = u0 + j * ustride; act[j] = u < ulimit;
        int vv = act[j] ? u : 0; const float* W; bf16_t* Wt; int K, N, k0, n0; bool perm = false;
        if (vv < WT_IN) { const int l = vv / (56 * 16); vv %= 56 * 16; W = inp(P, 14) + (size_t)l * 1024 * 3464; Wt = (bf16_t*)(ws + WS_WIN) + (size_t)l * 3584 * 1024; K = 1024; N = 3464; n0 = (vv / 16) * 64; k0 = (vv % 16) * 64; perm = true; }
        else if (vv < WT_IN + WT_OUT) { vv -= WT_IN; const int l = vv / 256; vv %= 256; W = inp(P, 15) + (size_t)l * 1024 * 1024; Wt = (bf16_t*)(ws + WS_WOUT) + (size_t)l * 1024 * 1024; K = 1024; N = 1024; n0 = (vv / 16) * 64; k0 = (vv % 16) * 64; }
        else if (vv < WT_IN + WT_OUT + WT_F1) { vv -= WT_IN + WT_OUT; const int l = vv / 1024; vv %= 1024; W = inp(P, 40) + (size_t)l * 1024 * 4096; Wt = (bf16_t*)(ws + WS_WFF1) + (size_t)l * 4096 * 1024; K = 1024; N = 4096; n0 = (vv / 16) * 64; k0 = (vv % 16) * 64; }
        else { vv -= WT_IN + WT_OUT + WT_F1; const int l = vv / 1024; vv %= 1024; W = inp(P, 41) + (size_t)l * 4096 * 1024; Wt = (bf16_t*)(ws + WS_WFF2) + (size_t)l * 1024 * 4096; K = 4096; N = 1024; n0 = (vv / 64) * 64; k0 = (vv % 64) * 64; }
        const int nd = n0 + nn; int ns = nd; bool valid = true;
        if (perm) { if (nd < 768) ns = nd; else if (nd < 3456) ns = nd + 8; else if (nd < 3464) ns = nd - 3456 + 768; else { valid = false; ns = 0; } }
        dstp[j] = Wt; dK[j] = K; dk0[j] = k0; dn0[j] = n0;
#pragma unroll
        for (int i = 0; i < 8; ++i) { const float x = W[(size_t)(k0 + (tid >> 6) + 8 * i) * N + ns]; v[j][i] = valid ? x : 0.f; }
    }
#pragma unroll
    for (int j = 0; j < 4; ++j)
#pragma unroll
        for (int i = 0; i < 8; ++i) lds[j * 4160 + nn * 65 + (tid >> 6) + 8 * i] = v[j][i];
    __syncthreads();
#pragma unroll
    for (int j = 0; j < 4; ++j) if (act[j]) {
        const int n2 = tid >> 3, c = tid & 7;
        const float* sp = lds + j * 4160 + n2 * 65 + c * 8;
        u32x4 o; o.x = pack_bf16(sp[0], sp[1]); o.y = pack_bf16(sp[2], sp[3]); o.z = pack_bf16(sp[4], sp[5]); o.w = pack_bf16(sp[6], sp[7]);
        *(u32x4*)(dstp[j] + (size_t)(dn0[j] + n2) * dK[j] + dk0[j] + c * 8) = o;
    }
    __syncthreads();
}

__device__ __forceinline__ void phase_prologue(const Params& P, float* lds) {
    const int tid = phase_tid(), bid = blockIdx.x, nb = gridDim.x;
    unsigned char* ws = P.ws;
    for (int u0 = bid; u0 < 896; u0 += 4 * nb) convert_batch(P, lds, u0, nb, 896);
    for (int u = bid; u < 192; u += nb) {
        const int l = u / 96, n0 = (u % 96) * 64;
        float* sc = lds;
        float* red = lds + 3072;
        for (int i = tid; i < 3072; i += NT) { int c = i >> 10, k = i & 1023; float x = (c == 0) ? inp(P, 9)[k] : inp(P, 8)[(c - 1) * 1024 + k]; sc[i] = siluf(x); }
        __syncthreads();
        const int kg = tid >> 4, nc = tid & 15;
        const float* W = inp(P, 10) + (size_t)l * 1024 * 6144 + n0 + nc * 4;
        f32x4 a0 = {0, 0, 0, 0}, a1 = a0, a2 = a0;
#pragma unroll 4
        for (int k = kg * 32; k < kg * 32 + 32; ++k) {
            const f32x4 w = *(const f32x4*)(W + (size_t)k * 6144);
            a0 += w * sc[k]; a1 += w * sc[1024 + k]; a2 += w * sc[2048 + k];
        }
        *(f32x4*)(red + (kg * 3 + 0) * 64 + nc * 4) = a0;
        *(f32x4*)(red + (kg * 3 + 1) * 64 + nc * 4) = a1;
        *(f32x4*)(red + (kg * 3 + 2) * 64 + nc * 4) = a2;
        __syncthreads();
        if (tid < 192) {
            const int c = tid >> 6, n = tid & 63; float s = 0.f;
            for (int g = 0; g < 32; ++g) s += red[(g * 3 + c) * 64 + n];
            s += inp(P, 11)[l * 6144 + n0 + n];
            ((float*)(ws + WS_MOD))[(l * 3 + c) * 6144 + n0 + n] = s;
        }
        __syncthreads();
    }
    for (int u = bid; u < 2 * 128; u += nb) {
        const int which = u / 128, chunk = u % 128;
        const float* src = inp(P, which ? 6 : 3);
        bf16_t* dst = (bf16_t*)(ws + (which ? WS_CKD : WS_CKN));
        const int e = chunk * 4096 + tid * 8;
        const int c = e & 255, key = (e >> 8) & 511, b = (e >> 17) & 1, layer = e >> 18;
        const float* s = src + ((size_t)((b * 2 + layer) * 512 + key)) * 256 + c;
        const f32x4 x0 = *(const f32x4*)s, x1 = *(const f32x4*)(s + 4);
        u32x4 o; o.x = pack_bf16(x0[0], x0[1]); o.y = pack_bf16(x0[2], x0[3]); o.z = pack_bf16(x1[0], x1[1]); o.w = pack_bf16(x1[2], x1[3]);
        *(u32x4*)(dst + e) = o;
    }
    for (int u = bid; u < 2 * 128; u += nb) {
        const int which = u / 128; int v = u % 128; const int kb = v & 7; v >>= 3; const int h = v & 3; v >>= 2; const int b = v & 1, layer = v >> 1;
        const float* src = inp(P, which ? 7 : 4) + ((size_t)((b * 2 + layer) * 512 + kb * 64)) * 256 + h * 64;
        bf16_t* dst = (bf16_t*)(ws + (which ? WS_CVTD : WS_CVTN)) + ((size_t)((layer * 2 + b) * 4 + h) * 64) * 512 + kb * 64;
        const int dd = tid & 63;
#pragma unroll
        for (int i = 0; i < 8; ++i) { const int key = (tid >> 6) + 8 * i; lds[dd * 65 + key] = src[(size_t)key * 256 + dd]; }
        __syncthreads();
        { const int d2 = tid >> 3, c = tid & 7; const float* s = lds + d2 * 65 + c * 8;
          u32x4 o; o.x = pack_bf16(s[0], s[1]); o.y = pack_bf16(s[2], s[3]); o.z = pack_bf16(s[4], s[5]); o.w = pack_bf16(s[6], s[7]);
          *(u32x4*)(dst + (size_t)d2 * 512 + c * 8) = o; }
        __syncthreads();
    }
    for (int e = bid * NT + tid; e < 196608; e += nb * NT) {
        bf16_t* dst = (bf16_t*)(ws + WS_LORA);
        float v;
        if (e < 131072) { const int which = e >> 16, r = e & 65535, i = r & 63, c = (r >> 6) & 255, ld = r >> 14;
            v = inp(P, which ? 29 : 27)[((size_t)ld * 64 + i) * 256 + c]; }
        else { const int r = e - 131072, i = r & 127, c = (r >> 7) & 255, l = r >> 15;
            v = inp(P, 30)[((size_t)l * 128 + i) * 256 + c]; }
        dst[e] = f2bf(v);
    }
    if (bid == 0 && tid < 512) {
        const int p = tid >> 3, f = tid & 7;
        float t = 1.f;
        t = (f == 1) ? 0.31622776601683794f : t; t = (f == 2) ? 0.1f : t; t = (f == 3) ? 0.031622776601683794f : t; t = (f == 4) ? 0.01f : t;
        t = (f == 5) ? 0.0031622776601683794f : t; t = (f == 6) ? 0.001f : t; t = (f == 7) ? 0.00031622776601683794f : t;
        double x = (double)t, x2 = x * x;
        double c = 1.0, s = x, tc = 1.0, tsn = x;
        for (int i = 1; i < 12; ++i) { tc *= -x2 / ((2.0 * i - 1.0) * (2.0 * i)); tsn *= -x2 / ((2.0 * i) * (2.0 * i + 1.0)); c += tc; s += tsn; }
        double cr = 1.0, sr = 0.0;
        for (int i = 0; i < p; ++i) { const double nc2 = cr * c - sr * s, ns2 = sr * c + cr * s; cr = nc2; sr = ns2; }
        float* R = (float*)(ws + WS_ROPE);
        R[(p * 8 + f) * 2 + 0] = (float)cr; R[(p * 8 + f) * 2 + 1] = (float)sr;
    }
}

__device__ __forceinline__ void phase_norm(const Params& P, int layer, int which, bool from_inputs, bool add_part, int glayer, int goff, bool do_norm) {
    const int tid = phase_tid(), lane = tid & 63, w = __builtin_amdgcn_readfirstlane(tid >> 6);
    unsigned char* ws = opaque_ws(P);
    float* OUT = outp(P);
    const float* X0 = inp(P, 0); const float* X1 = inp(P, 1);
    const float* gvec = inp(P, which ? 13 : 12) + layer * 1024;
    const float* modl = (const float*)(ws + WS_MOD) + (size_t)layer * 3 * 6144;
    const float* modg = (const float*)(ws + WS_MOD) + (size_t)glayer * 3 * 6144 + goff;
    const bf16_t* P0 = (const bf16_t*)(ws + WS_PART); const bf16_t* P1 = P0 + (size_t)MTOK * 1024;
    bf16_t* HN = (bf16_t*)(ws + WS_HN);
    const __amdgpu_buffer_rsrc_t rsO = wt_rsrc(OUT, (unsigned)MTOK * 1024 * 4), rsH = wt_rsrc(HN, (unsigned)MTOK * 1024 * 2);
    constexpr int RPW = MTOK / (256 * 8);
    static_assert(RPW == 4, "rows per wave");
    f32x4 x[RPW][4]; u32x2 p0[RPW][4], p1[RPW][4];
    const int rbase = (blockIdx.x * 8 + w) * RPW;
#pragma unroll
    for (int r = 0; r < RPW; ++r) {
        const int row = rbase + r;
        const float* xr;
        if (!from_inputs) xr = OUT + (size_t)row * 1024; else xr = (row < CTXTOK) ? X0 + (size_t)row * 1024 : X1 + (size_t)(row - CTXTOK) * 1024;
#pragma unroll
        for (int i = 0; i < 4; ++i) { const int c = lane * 4 + 256 * i; x[r][i] = *(const f32x4*)(xr + c);
            if (add_part) { p0[r][i] = *(const u32x2*)(P0 + (size_t)row * 1024 + c); p1[r][i] = *(const u32x2*)(P1 + (size_t)row * 1024 + c); } }
    }
    auto cvp = [&](const u32x2 u) -> f32x4 { f32x4 r; r[0] = __uint_as_float(u.x << 16); r[1] = __uint_as_float(u.x & 0xffff0000u); r[2] = __uint_as_float(u.y << 16); r[3] = __uint_as_float(u.y & 0xffff0000u); return r; };
#pragma unroll
    for (int r = 0; r < RPW; ++r) {
        const int row = rbase + r;
        const int cond = (row < CTXTOK) ? 0 : 1 + ((row - CTXTOK) >> 11);
        float ss = 0.f;
#pragma unroll
        for (int i = 0; i < 4; ++i) {
            const int c = lane * 4 + 256 * i;
            if (add_part) {
                const f32x4 g = *(const f32x4*)(modg + cond * 6144 + c);
                x[r][i] += g * (cvp(p0[r][i]) + cvp(p1[r][i]));
                wt_st16(rsO, (unsigned)(((size_t)row * 1024 + c) * 4), __builtin_bit_cast(u32x4, x[r][i]));
            }
            ss += x[r][i][0] * x[r][i][0] + x[r][i][1] * x[r][i][1] + x[r][i][2] * x[r][i][2] + x[r][i][3] * x[r][i][3];
        }
        if (do_norm) {
            const float* sh = modl + cond * 6144 + (which ? 3072 : 0);
            const float* sc = sh + 1024;
            ss = allsum64(ss);
            const float rs = __builtin_amdgcn_rsqf(ss * (1.f / 1024.f) + 1e-6f);
#pragma unroll
            for (int i = 0; i < 4; ++i) {
                const int c = lane * 4 + 256 * i;
                const f32x4 g = *(const f32x4*)(gvec + c), s1 = *(const f32x4*)(sc + c), s0 = *(const f32x4*)(sh + c);
                f32x4 o = x[r][i] * rs * g * (s1 + 1.f) + s0;
                u32x2 pk; pk.x = pack_bf16(o[0], o[1]); pk.y = pack_bf16(o[2], o[3]);
                wt_st8(rsH, (unsigned)(((size_t)row * 1024 + c) * 2), pk);
            }
        }
    }
}

constexpr int GS = 72;
__device__ __forceinline__ void premix_item(const Params& P, int layer, int it, unsigned char* ldsraw, int secmask = 7) {
    const int tid = phase_tid(), lane = tid & 63, w = __builtin_amdgcn_readfirstlane(tid >> 6);
    unsigned char* ws = opaque_ws(P);
    const int g0 = it * 32;
    const TokInfo ti = tokinfo(g0);
    const int t0 = ti.t, L = ti.L, sb = ti.seqbase;
    const bf16_t* PROJ = (const bf16_t*)(ws + WS_PROJ);
    float* lds = (float*)ldsraw;
    if (layer == 0) STAMP(4);
    if (secmask & 1) {
        const int c = tid;
        const float* cw = inp(P, 16) + (size_t)layer * 5 * 512; const float cb = inp(P, 17)[layer * 512 + c];
        float wj[5];
#pragma unroll
        for (int j = 0; j < 5; ++j) wj[j] = cw[j * 512 + c];
        bf16_t* XBC = (bf16_t*)(ws + WS_XBC);
        auto ld = [&](int t) -> float { const int tc = min(max(t, 0), L - 1); const float vv = bf2f(PROJ[(size_t)(sb + tc) * NPROJ + PC_XBC + c]); return (t == tc) ? vv : 0.f; };
        float xx[36];
#pragma unroll
        for (int i = 0; i < 36; ++i) xx[i] = ld(t0 - 2 + i);
#pragma unroll
        for (int tt = 0; tt < 32; ++tt) {
            float v = cb + xx[tt] * wj[0] + xx[tt + 1] * wj[1] + xx[tt + 2] * wj[2] + xx[tt + 3] * wj[3] + xx[tt + 4] * wj[4];
            XBC[(size_t)(g0 + tt) * 512 + c] = f2bf(siluf(v));
        }
    }
    if ((secmask & 1) && tid < 256) {
        const int tt = tid >> 3, j = tid & 7;
        const float raw = bf2f(PROJ[(size_t)(g0 + tt) * NPROJ + PC_DT + j]);
        const float dtv = softplusf_(raw + inp(P, 19)[layer * 8 + j]);
        const float Aj = -__expf(inp(P, 18)[layer * 8 + j]);
        f32x2 o; o.x = dtv; o.y = __expf(dtv * Aj);
        *(f32x2*)((float*)(ws + WS_DTA) + ((size_t)(g0 + tt) * 8 + j) * 2) = o;
    }
    if (secmask & 1) {
        bf16_t* ZS = (bf16_t*)(ws + WS_ZS);
        unsigned zu[8];
#pragma unroll
        for (int i = 0; i < 8; ++i) { const int e = tid + NT * i, tt = e >> 7, cp = (e & 127) * 2; zu[i] = *(const unsigned*)(PROJ + (size_t)(g0 + tt) * NPROJ + PC_Z + cp); }
#pragma unroll
        for (int i = 0; i < 8; ++i) {
            const int e = tid + NT * i, tt = e >> 7, cp = (e & 127) * 2;
            const float a = siluf(bf2f((unsigned short)(zu[i] & 0xffff))), b = siluf(bf2f((unsigned short)(zu[i] >> 16)));
            *(unsigned*)(ZS + (size_t)(g0 + tt) * 256 + cp) = pack_bf16(a, b);
        }
    }
    __syncthreads(); if (layer == 0) STAMP(5);
    bf16_t* VS = (bf16_t*)ldsraw;
    if (secmask & 2) {
        const int c4 = lane * 4;
        const f32x4 gq = *(const f32x4*)(inp(P, 22) + layer * 64 + (c4 & 63)), gk = *(const f32x4*)(inp(P, 23) + layer * 64 + (c4 & 63));
        const f32x4 dgq = *(const f32x4*)(inp(P, 36) + layer * 32 + (c4 & 31)), dgk = *(const f32x4*)(inp(P, 37) + layer * 32 + (c4 & 31));
        const float* ROPE = (const float*)(ws + WS_ROPE);
        auto ld4 = [&](const bf16_t* p) -> f32x4 { const u32x2 u = *(const u32x2*)p; f32x4 r; r[0] = bf2f((unsigned short)(u.x & 0xffff)); r[1] = bf2f((unsigned short)(u.x >> 16)); r[2] = bf2f((unsigned short)(u.y & 0xffff)); r[3] = bf2f((unsigned short)(u.y >> 16)); return r; };
        auto st4 = [&](bf16_t* p, f32x4 v) { u32x2 pk; pk.x = pack_bf16(v[0], v[1]); pk.y = pack_bf16(v[2], v[3]); *(u32x2*)p = pk; };
        u32x2 raw[4][6];
#pragma unroll
        for (int i = 0; i < 4; ++i) { const bf16_t* pr = PROJ + (size_t)(g0 + w * 4 + i) * NPROJ;
#pragma unroll
            for (int a = 0; a < 3; ++a) { raw[i][a] = *(const u32x2*)(pr + PC_NAT + 256 * a + c4); raw[i][3 + a] = *(const u32x2*)(pr + PC_DIFF + 256 * a + c4); } }
        auto cv4 = [&](const u32x2 u) -> f32x4 { f32x4 r; r[0] = __uint_as_float(u.x << 16); r[1] = __uint_as_float(u.x & 0xffff0000u); r[2] = __uint_as_float(u.y << 16); r[3] = __uint_as_float(u.y & 0xffff0000u); return r; };
#pragma unroll
        for (int i = 0; i < 4; ++i) {
            const int tt = w * 4 + i, g = g0 + tt, t = t0 + tt;
            {
                f32x4 q = cv4(raw[i][0]), k = cv4(raw[i][1]), v = cv4(raw[i][2]);
                float sq = allsum16(q[0] * q[0] + q[1] * q[1] + q[2] * q[2] + q[3] * q[3]);
                float sk = allsum16(k[0] * k[0] + k[1] * k[1] + k[2] * k[2] + k[3] * k[3]);
                const float rq = __builtin_amdgcn_rsqf(sq * (1.f / 64.f) + 1e-6f) * (0.125f * LOG2E), rk = __builtin_amdgcn_rsqf(sk * (1.f / 64.f) + 1e-6f);
                q = q * rq * gq; k = k * rk * gk;
                st4((bf16_t*)(ws + WS_QN) + (size_t)g * 256 + c4, q);
                st4((bf16_t*)(ws + WS_KN) + (size_t)g * 256 + c4, k);
                if (ti.isctx) {
                    const size_t o = ((size_t)((ti.sidx * 2 + layer) * 256 + t)) * 256 + c4;
                    *(f32x4*)(outp(P) + O_NATK + o) = k; *(f32x4*)(outp(P) + O_NATV + o) = v;
                }
#pragma unroll
                for (int e = 0; e < 4; ++e) VS[(c4 + e) * 40 + tt] = f2bf(v[e]);
            }
            {
                f32x4 q = cv4(raw[i][3]), k = cv4(raw[i][4]), v = cv4(raw[i][5]);
                float sq = allsum8(q[0] * q[0] + q[1] * q[1] + q[2] * q[2] + q[3] * q[3]);
                float sk = allsum8(k[0] * k[0] + k[1] * k[1] + k[2] * k[2] + k[3] * k[3]);
                const float rq = __builtin_amdgcn_rsqf(sq * (1.f / 32.f) + 1e-6f), rk = __builtin_amdgcn_rsqf(sk * (1.f / 32.f) + 1e-6f);
                q = q * rq * dgq; k = k * rk * dgk;
                if (ti.isctx) {
                    const size_t o = ((size_t)((ti.sidx * 2 + layer) * 256 + t)) * 256 + c4;
                    *(f32x4*)(outp(P) + O_DIFFK + o) = k; *(f32x4*)(outp(P) + O_DIFFV + o) = v;
                } else {
                    const int blk = (c4 >> 4) & 1, pos = blk ? (t & 63) : (t >> 6), f0 = c4 & 7;
                    const bool isu2 = (lane & 2) != 0;
                    f32x4 qp, kp;
#pragma unroll
                    for (int e = 0; e < 4; ++e) { qp[e] = dpp_mov<0x4E>(q[e]); kp[e] = dpp_mov<0x4E>(k[e]); }
#pragma unroll
                    for (int e = 0; e < 4; ++e) {
                        const f32x2 cs = *(const f32x2*)(ROPE + (pos * 8 + f0 + e) * 2);
                        const float sgn = isu2 ? cs.y : -cs.y;
                        q[e] = q[e] * cs.x + qp[e] * sgn; k[e] = k[e] * cs.x + kp[e] * sgn;
                    }
                }
                q = q * (0.17677669529663687f * LOG2E);
                st4((bf16_t*)(ws + WS_QD) + (size_t)g * 256 + c4, q);
                st4((bf16_t*)(ws + WS_KD) + (size_t)g * 256 + c4, k);
#pragma unroll
                for (int e = 0; e < 4; ++e) VS[256 * 40 + (c4 + e) * 40 + tt] = f2bf(v[e]);
            }
        }
        __syncthreads();
        {
            const int ch = tid >> 1, hf = tid & 1, h = ch >> 6, d = ch & 63;
            size_t o;
            if (ti.isctx) o = ((size_t)((ti.sidx * 4 + h) * 64 + d)) * 256 + t0 + hf * 16;
            else o = (size_t)1048576 + ((size_t)((ti.sidx * 4 + h) * 64 + d)) * 2048 + t0 + hf * 16;
#pragma unroll
            for (int a = 0; a < 2; ++a) {
                const bf16_t* s = VS + a * 256 * 40 + ch * 40 + hf * 16;
                bf16_t* dst = (bf16_t*)(ws + (a ? WS_VTD : WS_VTN)) + o;
                *(u32x4*)dst = *(const u32x4*)s; *(u32x4*)(dst + 8) = *(const u32x4*)(s + 8);
            }
        }
        __syncthreads();
    }
    if (layer == 0) STAMP(6);
    if (secmask & 28) {
        const bool doA = (secmask & 12) != 0, doB = (secmask & 20) != 0;
        float* KS = lds; float* RS = lds + 32 * 260; float* VR = lds + 2 * 32 * 260;
        bf16_t* LRb = (bf16_t*)(ldsraw + 99840);
        float* NRM = (float*)(ldsraw + 124928);
        const float* cwr = inp(P, 25) + (size_t)layer * 3 * 1152;
        auto conv_load = [&](int ch, unsigned short (&x)[34]) {
#pragma unroll
            for (int i = 0; i < 34; ++i) { const int t = t0 - 1 + i, tc = min(max(t, 0), L - 1); x[i] = PROJ[(size_t)(sb + tc) * NPROJ + PC_RW + ch]; }
        };
        auto conv_comp = [&](int ch, const unsigned short (&x)[34], float (&o)[32]) {
            const float w0 = cwr[ch], w1 = cwr[1152 + ch], w2 = cwr[2304 + ch];
            float xf[34];
#pragma unroll
            for (int i = 0; i < 34; ++i) { const int t = t0 - 1 + i; xf[i] = (t >= 0 && t < L) ? bf2f(x[i]) : 0.f; }
#pragma unroll
            for (int i = 0; i < 32; ++i) o[i] = xf[i] * w0 + xf[i + 1] * w1 + xf[i + 2] * w2;
        };
        unsigned short x1[34], x2[34];
        if (doA) { conv_load(tid, x1); conv_load(512 + tid, x2); }
        if (doA) {
            float o[32]; conv_comp(tid, x1, o);
            if (w < 4) {
#pragma unroll
                for (int i = 0; i < 32; ++i) RS[i * 260 + tid] = o[i];
            } else {
                const int c = tid - 256; const float kkc = inp(P, 31)[layer * 256 + c];
#pragma unroll
                for (int i = 0; i < 32; ++i) { KS[i * 260 + c] = o[i]; const float sv = o[i] * kkc; const float ss = wavesum64(sv * sv);
                    if (lane == 0) NRM[i * 4 + (w - 4)] = fminf(__builtin_amdgcn_rsqf(ss), 1e12f); }
            }
        }
        if (layer == 0) STAMP(13);
        if (doA) {
            float o[32]; conv_comp(512 + tid, x2, o);
            if (w < 4) {
#pragma unroll
                for (int i = 0; i < 32; ++i) VR[i * 260 + tid] = o[i];
            } else {
                const int lc = tid - 256;
#pragma unroll
                for (int i = 0; i < 32; ++i) LRb[i * 392 + lc] = f2bf(w < 6 ? tanhf_(o[i]) : o[i]);
            }
        }
        if (layer == 0) STAMP(14);
        if (doA && w < 2) {
            unsigned short x3[34]; conv_load(1024 + tid, x3); float o[32]; conv_comp(1024 + tid, x3, o);
#pragma unroll
            for (int i = 0; i < 32; ++i) LRb[i * 392 + 256 + tid] = f2bf(sigmoidf_(o[i]));
        }
        __syncthreads();
        if (layer == 0) STAMP(15);
        if (doA && w < 4) {
            const float rkc = inp(P, 33)[layer * 256 + tid];
            float* BON = (float*)(ws + WS_BON);
#pragma unroll 8
            for (int i = 0; i < 32; ++i) { const float b = wavesum64(RS[i * 260 + tid] * KS[i * 260 + tid] * rkc); if (lane == 0) BON[(size_t)(g0 + i) * 4 + w] = b; }
        }
        __syncthreads(); if (layer == 0) STAMP(7);
        const int l15 = lane & 15, quad = lane >> 4, cbase = 32 * w;
        const bf16_t* WUP = (const bf16_t*)(ws + WS_LORA);
        const bf16_t* AUP = WUP + 65536; const bf16_t* GUP = WUP + 131072;
        bf16_t* RWb = (bf16_t*)(ws + WS_RWB); float* DEC = (float*)(ws + WS_DEC);
        const f32x4 z4 = {0.f, 0.f, 0.f, 0.f};
#pragma unroll
        for (int cb = 0; cb < (doB ? 2 : 0); ++cb) {
            const int crow = cbase + cb * 16 + l15;
            bf16x8 wf[2][2], af[2][2], gf[4];
#pragma unroll
            for (int d = 0; d < 2; ++d)
#pragma unroll
                for (int ks = 0; ks < 2; ++ks) { wf[d][ks] = *(const bf16x8*)(WUP + ((size_t)((layer * 2 + d) * 256 + crow)) * 64 + ks * 32 + quad * 8);
                                                 af[d][ks] = *(const bf16x8*)(AUP + ((size_t)((layer * 2 + d) * 256 + crow)) * 64 + ks * 32 + quad * 8); }
#pragma unroll
            for (int ks = 0; ks < 4; ++ks) gf[ks] = *(const bf16x8*)(GUP + ((size_t)(layer * 256 + crow)) * 128 + ks * 32 + quad * 8);
            const int cpar = cbase + cb * 16 + 4 * quad;
            const f32x4 p_kk = *(const f32x4*)(inp(P, 31) + layer * 256 + cpar), p_ka = *(const f32x4*)(inp(P, 32) + layer * 256 + cpar);
            f32x4 p_w0[2], p_a0[2];
#pragma unroll
            for (int d = 0; d < 2; ++d) { p_w0[d] = *(const f32x4*)(inp(P, 26) + (layer * 2 + d) * 256 + cpar); p_a0[d] = *(const f32x4*)(inp(P, 28) + (layer * 2 + d) * 256 + cpar); }
#pragma unroll
            for (int tb = 0; tb < 2; ++tb) {
                f32x4 aW[2] = {z4, z4}, aA[2] = {z4, z4}, aG = z4;
                const bf16_t* lr = LRb + (tb * 16 + l15) * 392 + quad * 8;
#pragma unroll
                for (int d = 0; d < 2; ++d)
#pragma unroll
                    for (int ks = 0; ks < 2; ++ks) {
                        aW[d] = __builtin_amdgcn_mfma_f32_16x16x32_bf16(wf[d][ks], *(const bf16x8*)(lr + d * 64 + ks * 32), aW[d], 0, 0, 0);
                        aA[d] = __builtin_amdgcn_mfma_f32_16x16x32_bf16(af[d][ks], *(const bf16x8*)(lr + 128 + d * 64 + ks * 32), aA[d], 0, 0, 0);
                    }
#pragma unroll
                for (int ks = 0; ks < 4; ++ks) aG = __builtin_amdgcn_mfma_f32_16x16x32_bf16(gf[ks], *(const bf16x8*)(lr + 256 + ks * 32), aG, 0, 0, 0);
                const int t = tb * 16 + l15, c = cbase + cb * 16 + 4 * quad, head = c >> 6;
                const size_t o = (size_t)(g0 + t) * 256 + c;
                const f32x4 k4 = *(const f32x4*)(KS + t * 260 + c), r4 = *(const f32x4*)(RS + t * 260 + c), v4 = *(const f32x4*)(VR + t * 260 + c);
                const float rn = NRM[t * 4 + head];
                const f32x4 kk4 = k4 * p_kk * rn;
                const f32x4 ka4 = p_ka;
                st4bf(RWb + o, r4); st4bf(RWb + RWB + o, kk4); st4bf(RWb + 2 * RWB + o, v4); st4bf(RWb + 7 * RWB + o, aG);
#pragma unroll
                for (int d = 0; d < 2; ++d) {
                    const f32x4 w0 = p_w0[d], a0 = p_a0[d];
                    f32x4 dec, kka, kt;
#pragma unroll
                    for (int e = 0; e < 4; ++e) {
                        const float wl = -softplusf_(-(w0[e] + aW[d][e])) - 0.5f;
                        dec[e] = __expf(-__expf(wl));
                        const float a = sigmoidf_(a0[e] + aA[d][e]);
                        kt[e] = k4[e] * (1.f + (a - 1.f) * ka4[e]);
                        kka[e] = kk4[e] * a;
                    }
                    *(f32x4*)(DEC + d * RWB + o) = dec; st4bf(RWb + (3 + d) * RWB + o, kka); st4bf(RWb + (5 + d) * RWB + o, kt);
                }
            }
        }
        __syncthreads();
    }
}

typedef short bf16x4 __attribute__((ext_vector_type(4)));
#define MFMA32(a, b, c) __builtin_amdgcn_mfma_f32_16x16x32_bf16(__builtin_bit_cast(bf16x8, a), __builtin_bit_cast(bf16x8, b), c, 0, 0, 0)
#define MFMA16(a, b, c) __builtin_amdgcn_mfma_f32_16x16x16bf16_1k(__builtin_bit_cast(bf16x4, a), __builtin_bit_cast(bf16x4, b), c, 0, 0, 0)
constexpr int PREP_WLDS = 10496;
__device__ __forceinline__ void lds_barrier() { asm volatile("s_waitcnt lgkmcnt(0)" ::: "memory"); __builtin_amdgcn_s_barrier(); asm volatile("" ::: "memory"); }
struct PrepR { float dec[16]; unsigned kk[8], kka[8], kt[8], r[8]; };
struct PrepS { float dtv[16]; unsigned cv[8], bv[8]; };
__device__ __forceinline__ void prep_tile(const Params& P, int layer, int it, unsigned char* ldsraw) {
    const int tid = phase_tid(), lane = tid & 63, w = __builtin_amdgcn_readfirstlane(tid >> 6), l15 = lane & 15, q = lane >> 4;
    const int h = w >> 1, dir = w & 1, grp = h >> 1;
    unsigned char* ws = opaque_ws(P);
    unsigned char* wl = ldsraw + w * PREP_WLDS;
    bf16_t* L0 = (bf16_t*)wl; bf16_t* L1 = L0 + 16 * 72; bf16_t* L2 = L1 + 16 * 72; bf16_t* L3 = L2 + 16 * 72;
    float* NL = (float*)(wl + 9216); float* CSL = (float*)(wl + 9216 + 1024);
    const f32x4 z4 = {0.f, 0.f, 0.f, 0.f};
    const bf16_t* RWb = (const bf16_t*)(ws + WS_RWB);
    const float* DEC = (const float*)(ws + WS_DEC) + (size_t)dir * RWB;
    const bf16_t* aR = RWb, *aKK = RWb + RWB, *aKKA = RWb + (3 + dir) * RWB, *aKT = RWb + (5 + dir) * RWB;
    const bf16_t* XBC = (const bf16_t*)(ws + WS_XBC);
    const float* DTA = (const float*)(ws + WS_DTA);
    auto lo16 = [](unsigned u) -> float { return __uint_as_float(u << 16); };
    auto hi16 = [](unsigned u) -> float { return __uint_as_float(u & 0xffff0000u); };
    auto load_r = [&](int cn_g, PrepR& r) {
        const int base = cn_g * 16;
#pragma unroll
        for (int n = 0; n < 16; n += 2) {
            const size_t o0 = (size_t)(base + (dir ? 15 - n : n)) * 256 + h * 64 + lane, o1 = (size_t)(base + (dir ? 14 - n : n + 1)) * 256 + h * 64 + lane;
            r.dec[n] = DEC[o0]; r.dec[n + 1] = DEC[o1];
            r.kk[n >> 1] = (unsigned)aKK[o0] | ((unsigned)aKK[o1] << 16); r.kka[n >> 1] = (unsigned)aKKA[o0] | ((unsigned)aKKA[o1] << 16);
            r.kt[n >> 1] = (unsigned)aKT[o0] | ((unsigned)aKT[o1] << 16); r.r[n >> 1] = (unsigned)aR[o0] | ((unsigned)aR[o1] << 16);
        }
    };
    auto load_s = [&](int cn_g, PrepS& r) {
        const int base = cn_g * 16;
#pragma unroll
        for (int n = 0; n < 16; n += 2) {
            const int t0 = base + (dir ? 15 - n : n), t1 = base + (dir ? 14 - n : n + 1);
            r.dtv[n] = DTA[((size_t)t0 * 8 + dir * 4 + h) * 2]; r.dtv[n + 1] = DTA[((size_t)t1 * 8 + dir * 4 + h) * 2];
            r.cv[n >> 1] = (unsigned)XBC[(size_t)t0 * 512 + 384 + grp * 64 + lane] | ((unsigned)XBC[(size_t)t1 * 512 + 384 + grp * 64 + lane] << 16);
            r.bv[n >> 1] = (unsigned)XBC[(size_t)t0 * 512 + 256 + grp * 64 + lane] | ((unsigned)XBC[(size_t)t1 * 512 + 256 + grp * 64 + lane] << 16);
        }
    };
    auto comp_r = [&](int cn_g, const PrepR& in) {
        unsigned char* U = ws + WS_CHR + chr_unit_off(cn_g, h, dir);
        float g = 1.f;
#pragma unroll
        for (int n = 0; n < 16; ++n) { const float gp = g; g *= in.dec[n]; const float ig = frcp(g);
            const float kkf = (n & 1) ? hi16(in.kk[n >> 1]) : lo16(in.kk[n >> 1]), kkaf = (n & 1) ? hi16(in.kka[n >> 1]) : lo16(in.kka[n >> 1]);
            const float ktf = (n & 1) ? hi16(in.kt[n >> 1]) : lo16(in.kt[n >> 1]), rf = (n & 1) ? hi16(in.r[n >> 1]) : lo16(in.r[n >> 1]);
            L0[n * 72 + lane] = f2bf(kkf * gp); L1[n * 72 + lane] = f2bf(kkaf * ig);
            L2[n * 72 + lane] = f2bf(ktf * ig); L3[n * 72 + lane] = f2bf(rf * g); }
        ((float*)(U + 10240))[lane] = g;
        lds_barrier();
        f32x4 n1 = z4, n2 = z4, n3 = z4, n4 = z4;
#pragma unroll
        for (int ks = 0; ks < 2; ++ks) {
            const u32x4 fK = *(const u32x4*)(L0 + l15 * 72 + ks * 32 + q * 8), fB = *(const u32x4*)(L1 + l15 * 72 + ks * 32 + q * 8),
                        fT = *(const u32x4*)(L2 + l15 * 72 + ks * 32 + q * 8), fR = *(const u32x4*)(L3 + l15 * 72 + ks * 32 + q * 8);
            n1 = MFMA32(fB, fK, n1); n2 = MFMA32(fT, fK, n2); n3 = MFMA32(fB, fR, n3); n4 = MFMA32(fT, fR, n4);
        }
#pragma unroll
        for (int e = 0; e < 4; ++e) { const int i = 4 * q + e; const bool lt = i < l15, le = i <= l15;
            n1[e] = lt ? n1[e] : 0.f; n2[e] = lt ? n2[e] : 0.f; n3[e] = le ? -n3[e] : 0.f; n4[e] = le ? n4[e] : 0.f;
            NL[i * 16 + l15] = n1[e]; }
        { u32x2 xa; xa.x = pack_bf16(n2[0], n2[1]); xa.y = pack_bf16(n2[2], n2[3]); *(u32x2*)(U + 9728 + lane * 8) = xa;
          u32x4 ya; ya.x = pack_bf16(n3[0], n3[1]); ya.y = pack_bf16(n3[2], n3[3]); ya.z = pack_bf16(n4[0], n4[1]); ya.w = pack_bf16(n4[2], n4[3]); *(u32x4*)(U + 8192 + lane * 16) = ya; }
#pragma unroll
        for (int ks = 0; ks < 2; ++ks) {
            const u32x2 a = *(const u32x2*)(L0 + l15 * 72 + 32 * ks + 4 * q), b = *(const u32x2*)(L0 + l15 * 72 + 32 * ks + 16 + 4 * q);
            *(u32x4*)(U + ks * 1024 + lane * 16) = (u32x4){a.x, a.y, b.x, b.y};
            const u32x2 c = *(const u32x2*)(L3 + l15 * 72 + 32 * ks + 4 * q), d = *(const u32x2*)(L3 + l15 * 72 + 32 * ks + 16 + 4 * q);
            *(u32x4*)(U + 2048 + ks * 1024 + lane * 16) = (u32x4){c.x, c.y, d.x, d.y};
        }
#pragma unroll
        for (int rb = 0; rb < 4; ++rb) {
            unsigned bb[4], kk2[4];
#pragma unroll
            for (int j = 0; j < 4; ++j) { bb[j] = (unsigned)L1[(4 * q + j) * 72 + 16 * rb + l15] ^ 0x8000u; kk2[j] = (unsigned)L2[(4 * q + j) * 72 + 16 * rb + l15]; }
            *(u32x4*)(U + 4096 + rb * 1024 + lane * 16) = (u32x4){bb[0] | (bb[1] << 16), bb[2] | (bb[3] << 16), kk2[0] | (kk2[1] << 16), kk2[2] | (kk2[3] << 16)};
        }
        lds_barrier();
        float x[16];
#pragma unroll
        for (int i = 0; i < 16; ++i) x[i] = (i == l15) ? 1.f : 0.f;
#pragma unroll
        for (int i = 14; i >= 0; --i) { float sacc = 0.f;
#pragma unroll
            for (int j = i + 1; j < 16; ++j) sacc += NL[i * 16 + j] * x[j];
            x[i] = (i < l15) ? -sacc : x[i]; }
        { float m[4];
#pragma unroll
          for (int j = 0; j < 4; ++j) m[j] = (q == 0) ? x[j] : (q == 1) ? x[4 + j] : (q == 2) ? x[8 + j] : x[12 + j];
          u32x2 mi; mi.x = pack_bf16(m[0], m[1]); mi.y = pack_bf16(m[2], m[3]); *(u32x2*)(U + 9216 + lane * 8) = mi; }
        lds_barrier();
    };
    auto comp_s = [&](int cn_g, const PrepS& in) {
        const int unit = (cn_g * 4 + h) * 2 + dir;
        unsigned char* U = ws + WS_CHS + (size_t)unit * CHS_U;
        const float Ah = -__expf(inp(P, 18)[layer * 8 + dir * 4 + h]);
        float cs[16]; float c = 0.f;
#pragma unroll
        for (int n = 0; n < 16; ++n) { if (lane == 0) ((float*)(U + 4624))[n] = in.dtv[n]; c += in.dtv[n] * Ah; cs[n] = c; }
#pragma unroll
        for (int n = 0; n < 16; ++n) {
            const unsigned cu = (n & 1) ? (in.cv[n >> 1] >> 16) : (in.cv[n >> 1] & 0xffffu), bu = (n & 1) ? (in.bv[n >> 1] >> 16) : (in.bv[n >> 1] & 0xffffu);
            L0[n * 72 + lane] = (bf16_t)cu; L1[n * 72 + lane] = (bf16_t)bu;
            L2[n * 72 + lane] = f2bf(bf2f((bf16_t)cu) * __expf(cs[n])); L3[n * 72 + lane] = f2bf(bf2f((bf16_t)bu) * __expf(cs[15] - cs[n]));
            if (lane == 0) CSL[n] = cs[n]; }
        if (lane == 0) *(float*)(U + 4608) = __expf(cs[15]);
        lds_barrier();
        f32x4 gt = z4;
#pragma unroll
        for (int ks = 0; ks < 2; ++ks) gt = MFMA32(*(const u32x4*)(L1 + l15 * 72 + ks * 32 + q * 8), *(const u32x4*)(L0 + l15 * 72 + ks * 32 + q * 8), gt);
        { const float cst = CSL[l15]; float gg[4];
#pragma unroll
          for (int e = 0; e < 4; ++e) { const int i = 4 * q + e; gg[e] = (i <= l15) ? gt[e] * __expf(cst - CSL[i]) : 0.f; }
          u32x2 ga; ga.x = pack_bf16(gg[0], gg[1]); ga.y = pack_bf16(gg[2], gg[3]); *(u32x2*)(U + 2048 + lane * 8) = ga; }
#pragma unroll
        for (int ks = 0; ks < 2; ++ks) {
            const u32x2 a = *(const u32x2*)(L2 + l15 * 72 + 32 * ks + 4 * q), b = *(const u32x2*)(L2 + l15 * 72 + 32 * ks + 16 + 4 * q);
            *(u32x4*)(U + ks * 1024 + lane * 16) = (u32x4){a.x, a.y, b.x, b.y};
        }
#pragma unroll
        for (int rb = 0; rb < 4; ++rb) {
            unsigned bb[4];
#pragma unroll
            for (int j = 0; j < 4; ++j) bb[j] = (unsigned)L3[(4 * q + j) * 72 + 16 * rb + l15];
            *(u32x2*)(U + 2560 + rb * 512 + lane * 8) = (u32x2){bb[0] | (bb[1] << 16), bb[2] | (bb[3] << 16)};
        }
        lds_barrier();
    };
    PrepR ra, rb2; PrepS sa, sb2;
    load_r(2 * it, ra); load_s(2 * it, sa);
    comp_r(2 * it, ra);
    load_r(2 * it + 1, rb2);
    comp_s(2 * it, sa);
    load_s(2 * it + 1, sb2);
    comp_r(2 * it + 1, rb2);
    comp_s(2 * it + 1, sb2);
}

__device__ __forceinline__ void rwkv_cscan_item(const Params& P, int layer, int sidx_all, int h, int dir, unsigned char* ldsraw, int mode) {
    const int tid = phase_tid(), lane = tid & 63, w = __builtin_amdgcn_readfirstlane(tid >> 6), l15 = lane & 15, q = lane >> 4;
    const bool loader = w >= 4; const int vq = w & 3, ltid = tid & 255;
    const bool isctx = sidx_all < 16;
    const int L = isctx ? 256 : 2048, sb = isctx ? sidx_all * 256 : CTXTOK + (sidx_all - 16) * 2048, nch = L / 16;
    unsigned char* ws = opaque_ws(P);
    const unsigned char* CHR = ws + WS_CHR;
    const unsigned char* Vrow = ws + WS_RWB + 2 * RWB * 2 + h * 128;
    const int b = isctx ? sidx_all : sidx_all - 16;
    const int cbeg = (mode >= 2) ? nch / 2 : 0, cend = (mode == 1) ? nch / 2 : nch;
    bf16_t* Yb = (mode == 3) ? (bf16_t*)(ws + WS_QR) + (size_t)(dir * 2 + b) * 1024 * 256 : (bf16_t*)(ws + (dir ? WS_YRB : WS_YRF));
    const int yo = h * 64 + 16 * vq + l15 + (dir ? -4 * q : 4 * q) * 256, ystep = dir ? -256 : 256;
    const size_t sidx = ((size_t)(((b * 2 + layer) * 2 + dir) * 4 + h) * 64 + 16 * vq + l15) * 64;
    constexpr int D = 4, SLOT = CHR_U + 2048, NPC = 4, NPIECE = CHR_U / 16 + 128;
    int poff[NPC], plo[NPC]; bool pv[NPC], pc[NPC];
#pragma unroll
    for (int k = 0; k < NPC; ++k) { const int p = ltid + 256 * k; pv[k] = loader && p < NPIECE; pc[k] = p < 656; plo[k] = (p < 656 ? p * 16 : CHR_U + (p - 656) * 16);
        const int vr = p - 656; poff[k] = pc[k] ? p * 16 : (dir ? -(vr >> 3) : (vr >> 3)) * 512 + (vr & 7) * 16; }
    auto tokd = [&](int n) -> int { return sb + (dir ? (L - 1 - n) : n); };
    auto ytok = [&](int n) -> int { return (mode == 3) ? (dir ? (L - 1 - n) : (n - 1024)) : tokd(n); };
    auto gl = [&](int c, u32x4 (&R)[NPC]) {
        const unsigned char* bC = CHR + chr_unit_off((sb >> 4) + (dir ? nch - 1 - c : c), h, dir);
        const unsigned char* bV = Vrow + (size_t)tokd(c * 16) * 512;
#pragma unroll
        for (int k = 0; k < NPC; ++k) if (pv[k]) R[k] = *(const u32x4*)((pc[k] ? bC : bV) + poff[k]);
    };
    auto st = [&](int slot, const u32x4 (&R)[NPC]) {
#pragma unroll
        for (int k = 0; k < NPC; ++k) if (pv[k]) *(u32x4*)(ldsraw + slot * SLOT + plo[k]) = R[k];
    };
    struct Ops { u32x4 kp0, kp1, su0, su1, su2, su3; u32x2 mi, xa, vb; f32x4 g0, g1, g2, g3; };
    struct YOps { u32x4 rp0, rp1, ya; };
    constexpr int HBOFF = 3 * SLOT;
    auto hb_ptr = [&](int c) -> unsigned char* { return ldsraw + HBOFF + (((c & 1) * 4 + vq) * 64 + lane) * 48; };
    auto lds_ops = [&](int slot) -> Ops {
        const unsigned char* U = ldsraw + slot * SLOT; Ops o;
        o.kp0 = *(const u32x4*)(U + lane * 16); o.kp1 = *(const u32x4*)(U + 1024 + lane * 16);
        o.su0 = *(const u32x4*)(U + 4096 + lane * 16); o.su1 = *(const u32x4*)(U + 5120 + lane * 16); o.su2 = *(const u32x4*)(U + 6144 + lane * 16); o.su3 = *(const u32x4*)(U + 7168 + lane * 16);
        o.mi = *(const u32x2*)(U + 9216 + lane * 8); o.xa = *(const u32x2*)(U + 9728 + lane * 8);
        const float* gt = (const float*)(U + 10240) + 4 * q;
        o.g0 = *(const f32x4*)gt; o.g1 = *(const f32x4*)(gt + 16); o.g2 = *(const f32x4*)(gt + 32); o.g3 = *(const f32x4*)(gt + 48);
        const bf16_t* vl = (const bf16_t*)(U + CHR_U) + (4 * q) * 64 + 16 * vq + l15;
        o.vb.x = (unsigned)vl[0] | ((unsigned)vl[64] << 16); o.vb.y = (unsigned)vl[128] | ((unsigned)vl[192] << 16);
        if (mode == 3) { o.vb.x = 0u; o.vb.y = 0u; }
        return o;
    };
    f32x4 Z[4];
#pragma unroll
    for (int rb = 0; rb < 4; ++rb) {
        if (isctx || loader || mode == 2) Z[rb] = (f32x4){0.f, 0.f, 0.f, 0.f};
        else if (mode == 3) { for (int e = 0; e < 4; ++e) Z[rb][e] = (16 * rb + 4 * q + e == 16 * vq + l15) ? 1.f : 0.f; }
        else Z[rb] = *(const f32x4*)(inp(P, 5) + sidx + 16 * rb + 4 * q);
    }
    const f32x4 z4 = {0.f, 0.f, 0.f, 0.f};
    auto compute = [&](int c, const Ops& o) {
        u32x4 zb0, zb1;
        zb0.x = pack_bf16(Z[0][0], Z[0][1]); zb0.y = pack_bf16(Z[0][2], Z[0][3]); zb0.z = pack_bf16(Z[1][0], Z[1][1]); zb0.w = pack_bf16(Z[1][2], Z[1][3]);
        zb1.x = pack_bf16(Z[2][0], Z[2][1]); zb1.y = pack_bf16(Z[2][2], Z[2][3]); zb1.z = pack_bf16(Z[3][0], Z[3][1]); zb1.w = pack_bf16(Z[3][2], Z[3][3]);
        f32x4 X = MFMA16(o.xa, o.vb, z4); X = MFMA32(o.kp0, zb0, X); X = MFMA32(o.kp1, zb1, X);
        u32x2 xb; xb.x = pack_bf16(X[0], X[1]); xb.y = pack_bf16(X[2], X[3]);
        const f32x4 Uv = MFMA16(o.mi, xb, z4);
        u32x4 uv; uv.x = pack_bf16(Uv[0], Uv[1]); uv.y = pack_bf16(Uv[2], Uv[3]); uv.z = o.vb.x; uv.w = o.vb.y;
        Z[0] = MFMA32(o.su0, uv, Z[0]) * o.g0; Z[1] = MFMA32(o.su1, uv, Z[1]) * o.g1; Z[2] = MFMA32(o.su2, uv, Z[2]) * o.g2; Z[3] = MFMA32(o.su3, uv, Z[3]) * o.g3;
        { unsigned char* hb = hb_ptr(c); *(u32x4*)hb = zb0; *(u32x4*)(hb + 16) = zb1; *(u32x4*)(hb + 32) = uv; }
    };
    auto y_ops = [&](int slot) -> YOps { const unsigned char* U = ldsraw + slot * SLOT; YOps o;
        o.rp0 = *(const u32x4*)(U + 2048 + lane * 16); o.rp1 = *(const u32x4*)(U + 3072 + lane * 16); o.ya = *(const u32x4*)(U + 8192 + lane * 16); return o; };
    auto y_chunk = [&](int c, const YOps& o) {
        const unsigned char* hb = hb_ptr(c);
        const u32x4 zb0 = *(const u32x4*)hb, zb1 = *(const u32x4*)(hb + 16), uv = *(const u32x4*)(hb + 32);
        f32x4 Yv = MFMA32(o.rp0, zb0, z4); Yv = MFMA32(o.rp1, zb1, Yv); Yv = MFMA32(o.ya, uv, Yv);
        bf16_t* Yc = Yb + (size_t)ytok(c * 16) * 256;
#pragma unroll
        for (int e = 0; e < 4; ++e) Yc[yo + e * ystep] = f2bf(Yv[e]);
    };
    if (loader) {
        u32x4 R[D][NPC];
        gl(cbeg, R[0]); gl(cbeg + 1, R[1]); st(cbeg % 3, R[0]); st((cbeg + 1) % 3, R[1]);
#pragma unroll
        for (int k = 0; k < D; ++k) if (cbeg + k + 2 < cend) gl(cbeg + k + 2, R[k]);
        __syncthreads();
        YOps yo_prev, yo_cur = y_ops(cbeg % 3);
        for (int c0 = cbeg; c0 < cend; c0 += D) {
#pragma unroll
            for (int k = 0; k < D; ++k) {
                const int c = c0 + k;
                if (c > cbeg) y_chunk(c - 1, yo_prev);
                yo_prev = yo_cur;
                if (c + 1 < cend) yo_cur = y_ops((c + 1) % 3);
                if (c + 2 < cend) st((c + 2) % 3, R[k]);
                if (c + 2 + D < cend) gl(c + 2 + D, R[k]);
                lds_barrier();
            }
        }
        y_chunk(cend - 1, yo_prev);
    } else {
        __syncthreads();
        Ops cur = lds_ops(cbeg % 3);
        for (int c = cbeg; c < cend; ++c) {
            Ops nxt = cur;
            if (c + 1 < cend) nxt = lds_ops((c + 1) % 3);
            compute(c, cur);
            cur = nxt;
            lds_barrier();
        }
    }
    if (isctx && !loader) {
        float* So = outp(P) + O_RWKV + sidx;
#pragma unroll
        for (int rb = 0; rb < 4; ++rb) *(f32x4*)(So + 16 * rb + 4 * q) = Z[rb];
    }
    if (mode == 1 && !loader) {
        bf16_t* Zm = (bf16_t*)(ws + WS_ZMR) + (size_t)((b * 4 + h) * 2 + dir) * 4096 + (16 * vq + l15) * 64 + 4 * q;
#pragma unroll
        for (int rb = 0; rb < 4; ++rb) st4bf(Zm + 16 * rb, Z[rb]);
    }
}

__device__ __forceinline__ void ssd_cscan_item(const Params& P, int layer, int sidx_all, int h, int dir, unsigned char* ldsraw, int mode) {
    const int tid = phase_tid(), lane = tid & 63, w = __builtin_amdgcn_readfirstlane(tid >> 6), l15 = lane & 15, q = lane >> 4;
    const bool loader = w >= 4; const int pq = w & 3, ltid = tid & 255;
    const bool isctx = sidx_all < 16;
    const int L = isctx ? 256 : 2048, sb = isctx ? sidx_all * 256 : CTXTOK + (sidx_all - 16) * 2048, nch = L / 16;
    unsigned char* ws = opaque_ws(P);
    const unsigned char* CHS = ws + WS_CHS;
    const unsigned char* Xrow = ws + WS_XBC + h * 128;
    const int b = isctx ? sidx_all : sidx_all - 16;
    const int cbeg = (mode >= 2) ? nch / 2 : 0, cend = (mode == 1) ? nch / 2 : nch;
    bf16_t* Yb = (mode == 3) ? (bf16_t*)(ws + WS_QS) + (size_t)(dir * 2 + b) * 1024 * 256 : (bf16_t*)(ws + (dir ? WS_YSB : WS_YSF));
    const int yo = h * 64 + 16 * pq + l15 + (dir ? -4 * q : 4 * q) * 256, ystep = dir ? -256 : 256;
    const size_t sidx = ((size_t)(((b * 2 + layer) * 2 + dir) * 4 + h) * 64 + 16 * pq + l15) * 64;
    constexpr int D = 8, SLOT = CHS_U + 2048, NPC = 2, UP = CHS_U / 16, NPIECE = UP + 128;
    int poff[NPC], plo[NPC]; bool pv[NPC], pc[NPC];
#pragma unroll
    for (int k = 0; k < NPC; ++k) { const int p = ltid + 256 * k; pv[k] = loader && p < NPIECE; pc[k] = p < UP; plo[k] = (p < UP ? p * 16 : CHS_U + (p - UP) * 16);
        const int vr = p - UP; poff[k] = pc[k] ? p * 16 : (dir ? -(vr >> 3) : (vr >> 3)) * 1024 + (vr & 7) * 16; }
    auto tokd = [&](int n) -> int { return sb + (dir ? (L - 1 - n) : n); };
    auto ytok = [&](int n) -> int { return (mode == 3) ? (dir ? (L - 1 - n) : (n - 1024)) : tokd(n); };
    auto gl = [&](int c, u32x4 (&R)[NPC]) {
        const unsigned char* bC = CHS + (size_t)((((sb >> 4) + (dir ? nch - 1 - c : c)) * 4 + h) * 2 + dir) * CHS_U;
        const unsigned char* bV = Xrow + (size_t)tokd(c * 16) * 1024;
#pragma unroll
        for (int k = 0; k < NPC; ++k) if (pv[k]) R[k] = *(const u32x4*)((pc[k] ? bC : bV) + poff[k]);
    };
    auto st = [&](int slot, const u32x4 (&R)[NPC]) {
#pragma unroll
        for (int k = 0; k < NPC; ++k) if (pv[k]) *(u32x4*)(ldsraw + slot * SLOT + plo[k]) = R[k];
    };
    struct Ops { u32x4 cp0, cp1; u32x2 ga, bu0, bu1, bu2, bu3, xb; float aT; };
    auto lds_ops = [&](int slot) -> Ops {
        const unsigned char* U = ldsraw + slot * SLOT; Ops o;
        o.cp0 = *(const u32x4*)(U + lane * 16); o.cp1 = *(const u32x4*)(U + 1024 + lane * 16);
        o.ga = *(const u32x2*)(U + 2048 + lane * 8); o.bu0 = *(const u32x2*)(U + 2560 + lane * 8); o.bu1 = *(const u32x2*)(U + 3072 + lane * 8); o.bu2 = *(const u32x2*)(U + 3584 + lane * 8); o.bu3 = *(const u32x2*)(U + 4096 + lane * 8);
        o.aT = *(const float*)(U + 4608);
        const f32x4 dt4 = *(const f32x4*)(U + 4624 + 16 * q);
        const bf16_t* xl = (const bf16_t*)(U + CHS_U) + (4 * q) * 64 + 16 * pq + l15;
        o.xb.x = pack_bf16(bf2f(xl[0]) * dt4[0], bf2f(xl[64]) * dt4[1]); o.xb.y = pack_bf16(bf2f(xl[128]) * dt4[2], bf2f(xl[192]) * dt4[3]);
        if (mode == 3) { o.xb.x = 0u; o.xb.y = 0u; }
        return o;
    };
    f32x4 Wt[4];
#pragma unroll
    for (int rb = 0; rb < 4; ++rb) {
        if (isctx || loader || mode == 2) Wt[rb] = (f32x4){0.f, 0.f, 0.f, 0.f};
        else if (mode == 3) { for (int e = 0; e < 4; ++e) Wt[rb][e] = (16 * rb + 4 * q + e == 16 * pq + l15) ? 1.f : 0.f; }
        else Wt[rb] = *(const f32x4*)(inp(P, 2) + sidx + 16 * rb + 4 * q);
    }
    const f32x4 z4 = {0.f, 0.f, 0.f, 0.f};
    auto compute = [&](int c, const Ops& o) {
        u32x4 wb0, wb1;
        wb0.x = pack_bf16(Wt[0][0], Wt[0][1]); wb0.y = pack_bf16(Wt[0][2], Wt[0][3]); wb0.z = pack_bf16(Wt[1][0], Wt[1][1]); wb0.w = pack_bf16(Wt[1][2], Wt[1][3]);
        wb1.x = pack_bf16(Wt[2][0], Wt[2][1]); wb1.y = pack_bf16(Wt[2][2], Wt[2][3]); wb1.z = pack_bf16(Wt[3][0], Wt[3][1]); wb1.w = pack_bf16(Wt[3][2], Wt[3][3]);
        Wt[0] = MFMA16(o.bu0, o.xb, Wt[0] * o.aT); Wt[1] = MFMA16(o.bu1, o.xb, Wt[1] * o.aT); Wt[2] = MFMA16(o.bu2, o.xb, Wt[2] * o.aT); Wt[3] = MFMA16(o.bu3, o.xb, Wt[3] * o.aT);
        f32x4 Yv = MFMA16(o.ga, o.xb, z4); Yv = MFMA32(o.cp0, wb0, Yv); Yv = MFMA32(o.cp1, wb1, Yv);
        bf16_t* Yc = Yb + (size_t)ytok(c * 16) * 256;
#pragma unroll
        for (int e = 0; e < 4; ++e) Yc[yo + e * ystep] = f2bf(Yv[e]);
    };
    if (loader) {
        u32x4 R[D][NPC];
        gl(cbeg, R[0]); gl(cbeg + 1, R[1]); st(cbeg % 3, R[0]); st((cbeg + 1) % 3, R[1]);
#pragma unroll
        for (int k = 0; k < D; ++k) if (cbeg + k + 2 < cend) gl(cbeg + k + 2, R[k]);
        __syncthreads();
        for (int c0 = cbeg; c0 < cend; c0 += D) {
#pragma unroll
            for (int k = 0; k < D; ++k) {
                const int c = c0 + k;
                if (c + 2 < cend) st((c + 2) % 3, R[k]);
                if (c + 2 + D < cend) gl(c + 2 + D, R[k]);
                lds_barrier();
            }
        }
    } else {
        __syncthreads();
        Ops cur = lds_ops(cbeg % 3);
        for (int c = cbeg; c < cend; ++c) {
            Ops nxt = cur;
            if (c + 1 < cend) nxt = lds_ops((c + 1) % 3);
            compute(c, cur);
            cur = nxt;
            lds_barrier();
        }
    }
    if (isctx && !loader) {
        float* So = outp(P) + O_SSD + sidx;
#pragma unroll
        for (int rb = 0; rb < 4; ++rb) *(f32x4*)(So + 16 * rb + 4 * q) = Wt[rb];
    }
    if (mode == 1 && !loader) {
        bf16_t* Wm = (bf16_t*)(ws + WS_ZMS) + (size_t)((b * 4 + h) * 2 + dir) * 4096 + (16 * pq + l15) * 64 + 4 * q;
#pragma unroll
        for (int rb = 0; rb < 4; ++rb) st4bf(Wm + 16 * rb, Wt[rb]);
    }
}

template <int MODE>
__device__ __forceinline__ void attn_item(const Params& P, int layer, int idx, unsigned char* ldsraw) {
    constexpr bool DIFF = MODE >= 2, LAT = (MODE & 1) != 0;
    const int tid = phase_tid(), lane = tid & 63, w = __builtin_amdgcn_readfirstlane(tid >> 6), l15 = lane & 15, quad = lane >> 4;
    unsigned char* ws = opaque_ws(P);
    int sidx, h, qb;
    if (LAT) { qb = idx & 15; h = (idx >> 4) & 3; sidx = idx >> 6; }
    else { qb = idx & 1; h = (idx >> 1) & 3; sidx = idx >> 3; }
    const int sb = LAT ? CTXTOK + sidx * 2048 : sidx * 256;
    const int Lseq = LAT ? 2048 : 256;
    const bf16_t* Q = (const bf16_t*)(ws + (DIFF ? WS_QD : WS_QN));
    const bf16_t* KX = (const bf16_t*)(ws + (DIFF ? WS_KD : WS_KN));
    const bf16_t* VT = (const bf16_t*)(ws + (DIFF ? WS_VTD : WS_VTN));
    const bf16_t* CK = (const bf16_t*)(ws + (DIFF ? WS_CKD : WS_CKN));
    const bf16_t* CVT = (const bf16_t*)(ws + (DIFF ? WS_CVTD : WS_CVTN));
    bf16_t* MIX = (bf16_t*)(ws + WS_HN);
    bf16_t* lds = (bf16_t*)ldsraw;
    constexpr int TS = 64 * GS;
    float* RB = (float*)(ldsraw + 4 * TS * 2);
    int base0 = 0, nlat = 0;
    if (MODE == 1) { const int r0 = 2 * qb; const int b0 = min(max(r0 - 4, 0), 24), b1 = min(max(r0 - 3, 0), 24); base0 = b0; nlat = b1 + 8 - b0;
        for (int i = tid; i < 465; i += NT) RB[i] = inp(P, 24)[((size_t)(layer * 4 + h)) * 465 + i] * LOG2E; }
    const int ntiles = (MODE == 0 || MODE == 2) ? 4 : (MODE == 1 ? 8 + nlat : 40);
    const int qt = qb * 128 + w * 16;
    const bf16_t* qp = Q + (size_t)(sb + qt + l15) * 256 + h * 64 + quad * 8;
    const bf16x8 qf0 = *(const bf16x8*)qp, qf1 = *(const bf16x8*)(qp + 32);
    const int lrow = tid >> 3, lpc = tid & 7;
    constexpr int PF = 3;
    u32x4 rk[PF], rv[PF];
    auto gload = [&](int i, u32x4& k_, u32x4& v_) {
        const bf16_t* kp; const bf16_t* vp;
        if (!LAT) { kp = KX + (size_t)(sb + 64 * i + lrow) * 256 + h * 64; vp = VT + ((size_t)((sidx * 4 + h) * 64 + lrow)) * 256 + 64 * i; }
        else if (i < 8) { kp = CK + ((size_t)((layer * 2 + sidx) * 512 + 64 * i + lrow)) * 256 + h * 64; vp = CVT + ((size_t)(((layer * 2 + sidx) * 4 + h) * 64 + lrow)) * 512 + 64 * i; }
        else { const int kr = (MODE == 1) ? base0 + (i - 8) : (i - 8);
            kp = KX + (size_t)(sb + 64 * kr + lrow) * 256 + h * 64; vp = VT + (size_t)1048576 + ((size_t)((sidx * 4 + h) * 64 + lrow)) * 2048 + 64 * kr; }
        k_ = *(const u32x4*)(kp + lpc * 8); v_ = *(const u32x4*)(vp + lpc * 8);
    };
    auto sstore = [&](int st, const u32x4& k_, const u32x4& v_) { *(u32x4*)(lds + st * 2 * TS + lrow * GS + lpc * 8) = k_; *(u32x4*)(lds + st * 2 * TS + TS + lrow * GS + lpc * 8) = v_; };
    constexpr float CREF = DIFF ? 10.f : 14.f;
    float lA = 0.f, lB = 0.f;
    f32x4 oA[4], oB[4];
#pragma unroll
    for (int i = 0; i < 4; ++i) { oA[i] = (f32x4){0.f, 0.f, 0.f, 0.f}; oB[i] = oA[i]; }
    const int qr = qt >> 6, qc = (qt & 63) + l15;
    const int qbase = min(max(qr - 4, 0), 24), cs = min(max(qc - 8, 0), 48);
    const f32x4 cinit = {-CREF, -CREF, -CREF, -CREF};
    gload(0, rk[0], rv[0]); sstore(0, rk[0], rv[0]);
#pragma unroll
    for (int k = 0; k < PF; ++k) if (k + 1 < ntiles) gload(k + 1, rk[k], rv[k]);
    __syncthreads();
    for (int i0 = 0; i0 < ntiles; i0 += PF) {
#pragma unroll
      for (int kq = 0; kq < PF; ++kq) {
        const int i = i0 + kq;
        if (i >= ntiles) break;
        const bool more = i + 1 < ntiles;
        const bf16_t* Ks = lds + (i & 1) * 2 * TS; const bf16_t* Vs = Ks + TS;
        bool active = true; int kr = 0;
        if (MODE == 1 && i >= 8) { kr = base0 + (i - 8); active = (kr >= qbase) && (kr < qbase + 8); }
        if (active) {
            f32x4 sA[4], sB[4];
#pragma unroll
            for (int g = 0; g < 4; ++g) {
                const bf16x8 kf0 = *(const bf16x8*)(Ks + (16 * g + l15) * GS + quad * 8), kf1 = *(const bf16x8*)(Ks + (16 * g + l15) * GS + 32 + quad * 8);
                sA[g] = __builtin_amdgcn_mfma_f32_16x16x32_bf16(kf0, qf0, cinit, 0, 0, 0);
                if (DIFF) sB[g] = __builtin_amdgcn_mfma_f32_16x16x32_bf16(kf1, qf1, cinit, 0, 0, 0);
                else sA[g] = __builtin_amdgcn_mfma_f32_16x16x32_bf16(kf1, qf1, sA[g], 0, 0, 0);
            }
            if (MODE == 1 && i >= 8) {
                const float* rb = RB + (kr - qr + 7) * 31 + 15 - qc;
#pragma unroll
                for (int g = 0; g < 4; ++g)
#pragma unroll
                    for (int r = 0; r < 4; ++r) { const int kc = 16 * g + 4 * quad + r; const bool ok = (kc >= cs) && (kc < cs + 16);
                        sA[g][r] = ok ? sA[g][r] + rb[ok ? kc : qc] : -INFINITY; }
            }
            u32x2 pA[4], pB[4];
#pragma unroll
            for (int g = 0; g < 4; ++g) { f32x4 p; for (int r = 0; r < 4; ++r) { p[r] = __builtin_amdgcn_exp2f(sA[g][r]); lA += p[r]; } pA[g].x = pack_bf16(p[0], p[1]); pA[g].y = pack_bf16(p[2], p[3]); }
            if (DIFF) {
#pragma unroll
                for (int g = 0; g < 4; ++g) { f32x4 p; for (int r = 0; r < 4; ++r) { p[r] = __builtin_amdgcn_exp2f(sB[g][r]); lB += p[r]; } pB[g].x = pack_bf16(p[0], p[1]); pB[g].y = pack_bf16(p[2], p[3]); }
            }
#pragma unroll
            for (int kk = 0; kk < 2; ++kk) {
                u32x4 pfa; pfa.x = pA[2 * kk].x; pfa.y = pA[2 * kk].y; pfa.z = pA[2 * kk + 1].x; pfa.w = pA[2 * kk + 1].y;
                u32x4 pfb; if (DIFF) { pfb.x = pB[2 * kk].x; pfb.y = pB[2 * kk].y; pfb.z = pB[2 * kk + 1].x; pfb.w = pB[2 * kk + 1].y; }
#pragma unroll
                for (int db = 0; db < 4; ++db) {
                    const bf16_t* vp = Vs + (16 * db + l15) * GS + 32 * kk + 4 * quad;
                    const u32x2 v0 = *(const u32x2*)vp, v1 = *(const u32x2*)(vp + 16);
                    u32x4 vf; vf.x = v0.x; vf.y = v0.y; vf.z = v1.x; vf.w = v1.y;
                    oA[db] = __builtin_amdgcn_mfma_f32_16x16x32_bf16(__builtin_bit_cast(bf16x8, vf), __builtin_bit_cast(bf16x8, pfa), oA[db], 0, 0, 0);
                    if (DIFF) oB[db] = __builtin_amdgcn_mfma_f32_16x16x32_bf16(__builtin_bit_cast(bf16x8, vf), __builtin_bit_cast(bf16x8, pfb), oB[db], 0, 0, 0);
                }
            }
        }
        if (more) sstore((i + 1) & 1, rk[kq], rv[kq]);
        if (i + 1 + PF < ntiles) gload(i + 1 + PF, rk[kq], rv[kq]);
        lds_barrier();
      }
    }
    const float iA = 1.f / allsum_q(lA);
    bf16_t* op = MIX + (size_t)(sb + qt + l15) * 1024 + (DIFF ? 768 : 256) + h * 64 + quad * 4;
    if (!DIFF) {
#pragma unroll
        for (int db = 0; db < 4; ++db) { const f32x4 o = oA[db] * iA; u32x2 pk; pk.x = pack_bf16(o[0], o[1]); pk.y = pack_bf16(o[2], o[3]); *(u32x2*)(op + 16 * db) = pk; }
    } else {
        const float iB = 1.f / allsum_q(lB);
        float la_ = 0.f, lb_ = 0.f;
        if (lane < 32) { const float* lv = inp(P, 38) + layer * 128; la_ = lv[lane] * lv[32 + lane]; lb_ = lv[64 + lane] * lv[96 + lane]; }
        la_ = allsum64(la_); lb_ = allsum64(lb_);
        const float lam_init = layer == 0 ? 0.2f : (0.8f - 0.6f * 0.7408182206817179f);
        const float lam = __expf(la_) - __expf(lb_) + lam_init;
        f32x4 o[4]; float ssq = 0.f;
#pragma unroll
        for (int db = 0; db < 4; ++db) { o[db] = oA[db] * iA - oB[db] * (iB * lam); ssq += o[db][0] * o[db][0] + o[db][1] * o[db][1] + o[db][2] * o[db][2] + o[db][3] * o[db][3]; }
        ssq = allsum_q(ssq);
        const float rs = __builtin_amdgcn_rsqf(ssq * (1.f / 64.f) + 1e-6f) * (1.f - lam_init);
#pragma unroll
        for (int db = 0; db < 4; ++db) { const f32x4 g = *(const f32x4*)(inp(P, 39) + layer * 64 + 16 * db + quad * 4); const f32x4 r = o[db] * rs * g;
            u32x2 pk; pk.x = pack_bf16(r[0], r[1]); pk.y = pack_bf16(r[2], r[3]); *(u32x2*)(op + 16 * db) = pk; }
    }
    __syncthreads();
}

__device__ __forceinline__ unsigned xb_xcc_id();
__device__ __forceinline__ void mix_run_item(const Params& P, int layer, int x, int j, unsigned char* ldsraw) {
    if (j < 4) { const int gi = x * 4 + j;
        if (gi < 16) rwkv_cscan_item(P, layer, 16 + (gi >> 3), (gi >> 1) & 3, gi & 1, ldsraw, 0);
        else { const int v = gi - 16; ssd_cscan_item(P, layer, 16 + (v >> 3), (v >> 1) & 3, v & 1, ldsraw, 0); } }
    else if (j < 20) attn_item<3>(P, layer, x * 16 + (j - 4), ldsraw);
    else if (j < 36) attn_item<1>(P, layer, x * 16 + (j - 20), ldsraw);
    else if (j < 52) { const int v = x * 16 + (j - 36); rwkv_cscan_item(P, layer, v >> 3, (v >> 1) & 3, v & 1, ldsraw, 0); }
    else if (j < 68) { const int v = x * 16 + (j - 52); ssd_cscan_item(P, layer, v >> 3, (v >> 1) & 3, v & 1, ldsraw, 0); }
    else if (j < 84) attn_item<2>(P, layer, x * 16 + (j - 68), ldsraw);
    else attn_item<0>(P, layer, x * 16 + (j - 84), ldsraw);
}
__device__ __forceinline__ void phase_mix(const Params& P, int layer, unsigned char* ldsraw, int rep = 0) {
    unsigned* cbase = (unsigned*)(opaque_ws(P) + WS_CTL) + 8192 + ((layer * 2 + rep) * 9) * 16;
    volatile unsigned* s_item = (volatile unsigned*)(ldsraw + LDS_BYTES - 16);
    const int myx = (int)(xb_xcc_id() & 7u);
    for (int dx = 0; dx < 8; ++dx) {
        const int x = (myx + dx) & 7;
        for (;;) {
            if (threadIdx.x == 0) *s_item = atomicAdd(cbase + x * 16, 1u);
            __syncthreads();
            const int j = (int)*s_item;
            __syncthreads();
            if (j >= 100) break;
            mix_run_item(P, layer, x, j, ldsraw);
        }
    }
    if (layer == 0 && rep == 0) {
        for (;;) {
            if (threadIdx.x == 0) *s_item = atomicAdd(cbase + 8 * 16, 1u);
            __syncthreads();
            const int bch = (int)*s_item;
            __syncthreads();
            if (bch >= (WT_ALL - 896 + 3) / 4) break;
            convert_batch(P, (float*)ldsraw, 896 + 4 * bch, 1, WT_ALL);
        }
    }
}

__device__ __forceinline__ void phase_post(const Params& P, int layer, unsigned char* ldsraw) {
    const int tid = phase_tid(), lane = tid & 63, w = __builtin_amdgcn_readfirstlane(tid >> 6), c4 = lane * 4, head = lane >> 4;
    unsigned char* ws = opaque_ws(P);
    const bf16_t* YSF = (const bf16_t*)(ws + WS_YSF), *YSB = (const bf16_t*)(ws + WS_YSB), *YRF = (const bf16_t*)(ws + WS_YRF), *YRB = (const bf16_t*)(ws + WS_YRB);
    const bf16_t* XBC = (const bf16_t*)(ws + WS_XBC);
    const bf16_t* ZS = (const bf16_t*)(ws + WS_ZS);
    const bf16_t* RWb = (const bf16_t*)(ws + WS_RWB);
    const float* BON = (const float*)(ws + WS_BON);
    bf16_t* MIX = (bf16_t*)(ws + WS_HN);
    const float Dh = inp(P, 20)[layer * 4 + head];
    const f32x4 ng = *(const f32x4*)(inp(P, 21) + layer * 256 + c4);
    const f32x4 lg = *(const f32x4*)(inp(P, 34) + layer * 256 + c4), lb = *(const f32x4*)(inp(P, 35) + layer * 256 + c4);
    u32x2 ysf[4], ysb[4], xs[4], zs[4], yrf[4], yrb[4], vv[4], gt[4]; float bon[4];
    const int gbase = (blockIdx.x * 8 + w) * 4;
#pragma unroll
    for (int r = 0; r < 4; ++r) { const int g = gbase + r; const size_t o = (size_t)g * 256 + c4;
        ysf[r] = *(const u32x2*)(YSF + o); ysb[r] = *(const u32x2*)(YSB + o); xs[r] = *(const u32x2*)(XBC + (size_t)g * 512 + c4); zs[r] = *(const u32x2*)(ZS + o);
        yrf[r] = *(const u32x2*)(YRF + o); yrb[r] = *(const u32x2*)(YRB + o); vv[r] = *(const u32x2*)(RWb + 2 * RWB + o); gt[r] = *(const u32x2*)(RWb + 7 * RWB + o); bon[r] = BON[(size_t)g * 4 + head]; }
    float* CORR = (float*)ldsraw;
    const bool latent_blk = false;
    if (latent_blk) {
        const int g0 = blockIdx.x * 32, bq = (g0 - CTXTOK) >> 11, t0 = (g0 - CTXTOK) & 2047, dsel = (t0 >= 1024) ? 0 : 1, tl0 = t0 & 1023;
        const int l15 = lane & 15, quad = lane >> 4, hd = w >> 1, tb = w & 1;
#pragma unroll
        for (int ty = 0; ty < 2; ++ty) {
            const bf16_t* Qb = (const bf16_t*)(ws + (ty ? WS_QR : WS_QS)) + ((size_t)(dsel * 2 + bq) * 1024 + tl0 + tb * 16 + l15) * 256 + hd * 64 + quad * 8;
            const bf16_t* Zb = (const bf16_t*)(ws + (ty ? WS_ZMR : WS_ZMS)) + (size_t)((bq * 4 + hd) * 2 + dsel) * 4096 + l15 * 64 + quad * 8;
            const u32x4 a0 = *(const u32x4*)Qb, a1 = *(const u32x4*)(Qb + 32);
#pragma unroll
            for (int vb = 0; vb < 4; ++vb) {
                const u32x4 b0 = *(const u32x4*)(Zb + vb * 16 * 64), b1 = *(const u32x4*)(Zb + vb * 16 * 64 + 32);
                f32x4 acc = MFMA32(a0, b0, ((f32x4){0.f, 0.f, 0.f, 0.f})); acc = MFMA32(a1, b1, acc);
#pragma unroll
                for (int e = 0; e < 4; ++e) CORR[(ty * 32 + tb * 16 + 4 * quad + e) * 256 + hd * 64 + 16 * vb + l15] = acc[e];
            }
        }
        __syncthreads();
    }
    auto cvp = [&](const u32x2 u) -> f32x4 { f32x4 r; r[0] = __uint_as_float(u.x << 16); r[1] = __uint_as_float(u.x & 0xffff0000u); r[2] = __uint_as_float(u.y << 16); r[3] = __uint_as_float(u.y & 0xffff0000u); return r; };
#pragma unroll
    for (int r = 0; r < 4; ++r) {
        const int g = gbase + r;
        {
            f32x4 y = cvp(ysf[r]) + cvp(ysb[r]) + cvp(xs[r]) * Dh;
            if (latent_blk) y += *(const f32x4*)(CORR + (w * 4 + r) * 256 + c4);
            y = y * cvp(zs[r]);
            const float ss = allsum64(y[0] * y[0] + y[1] * y[1] + y[2] * y[2] + y[3] * y[3]);
            y = y * __builtin_amdgcn_rsqf(ss * (1.f / 256.f) + 1e-6f) * ng;
            st4bf(MIX + (size_t)g * 1024 + c4, y);
        }
        {
            f32x4 y = cvp(yrf[r]) + cvp(yrb[r]);
            if (latent_blk) y += *(const f32x4*)(CORR + (32 + w * 4 + r) * 256 + c4);
            const float mu = allsum16(y[0] + y[1] + y[2] + y[3]) * (1.f / 64.f);
            const f32x4 dlt = y - mu;
            const float var = allsum16(dlt[0] * dlt[0] + dlt[1] * dlt[1] + dlt[2] * dlt[2] + dlt[3] * dlt[3]) * (1.f / 64.f);
            f32x4 rr = dlt * __builtin_amdgcn_rsqf(var + 64e-5f) * lg + lb;
            rr = rr + cvp(vv[r]) * bon[r];
            rr = rr * cvp(gt[r]);
            st4bf(MIX + (size_t)g * 1024 + 512 + c4, rr);
        }
    }
}

#define XB_TMO      128
#define XB_XCNT(j)  (256  + 64 * (j))
#define XB_XSUB(j)  (1280 + 64 * (j))
#define XB_XGEN(j)  (2304 + 64 * (j))
#define XB_TOP      3328
#define XB_TOPGEN   3392
#define XCD_BAR_WORDS 3456
#define XB_SPIN_CAP (1u << 22)
#define LAS __attribute__((address_space(3)))
__device__ __forceinline__ unsigned xb_ld(unsigned* p)              { return __hip_atomic_load(p, __ATOMIC_RELAXED, __HIP_MEMORY_SCOPE_AGENT); }
__device__ __forceinline__ unsigned xb_add(unsigned* p, unsigned v) { return __hip_atomic_fetch_add(p, v, __ATOMIC_RELAXED, __HIP_MEMORY_SCOPE_AGENT); }
__device__ __forceinline__ unsigned xb_xcc_id() { return (unsigned)__builtin_amdgcn_s_getreg((3 << 11) | 20) & 0xFu; }
#define XB_SPIN(cond, bar) do { unsigned _sp = 0; while (cond) { __builtin_amdgcn_s_sleep(1); \
    if ((++_sp & 255u) == 0u) { if (xb_ld(&(bar)[XB_TMO])) break; if (_sp > XB_SPIN_CAP) { atomicAdd(&(bar)[XB_TMO], 1u); break; } } } } while (0)
struct XcdBarrier { unsigned* bar; unsigned x; volatile unsigned* st; };
__device__ __forceinline__ XcdBarrier xcd_barrier_post(unsigned* bar, volatile unsigned* st) {
    XcdBarrier b; b.bar = bar; b.x = xb_xcc_id(); b.st = st;
    if (threadIdx.x == 0) (void)xb_add(&bar[XB_XCNT(b.x)], 1u);
    return b;
}
__device__ __forceinline__ void xcd_barrier_complete(unsigned* bar, unsigned x, unsigned& nloc, unsigned& nx) {
    const unsigned G = gridDim.x * gridDim.y * gridDim.z;
    unsigned sum, cnt, mine, sp = 0u;
    for (;;) {
        sum = 0u; cnt = 0u; mine = 0u;
#pragma unroll
        for (unsigned j = 0; j < 16; ++j) { const unsigned c = xb_ld(&bar[XB_XCNT(j)]); sum += c; cnt += (c > 0u) ? 1u : 0u; mine = (j == x) ? c : mine; }
        if (sum == G) break;
        __builtin_amdgcn_s_sleep(1);
        if ((++sp & 255u) == 0u) { if (xb_ld(&bar[XB_TMO])) break; if (sp > XB_SPIN_CAP) { atomicAdd(&bar[XB_TMO], 1u); break; } }
    }
    nloc = mine > 0u ? mine : 1u; nx = cnt > 0u ? cnt : 1u;
}
__device__ __forceinline__ void xcd_barrier(const XcdBarrier& b) {
    asm volatile("s_waitcnt vmcnt(0)" ::: "memory");
    __syncthreads();
    if (threadIdx.x == 0) {
        unsigned* bar = b.bar;
        __builtin_amdgcn_s_waitcnt(0);
        unsigned nloc = b.st[0], nx = b.st[1];
        if (nloc == 0u) { xcd_barrier_complete(bar, b.x, nloc, nx); b.st[0] = nloc; b.st[1] = nx; }
        const unsigned old = xb_add(&bar[XB_XSUB(b.x)], 1u);
        const unsigned gen = old / nloc;
        if (old + 1u == (gen + 1u) * nloc) {
            __builtin_amdgcn_fence(__ATOMIC_RELEASE, "agent");
            asm volatile("s_waitcnt vmcnt(0)" ::: "memory");
            const unsigned og = xb_add(&bar[XB_TOP], 1u);
            const unsigned tg = og / nx;
            if (og + 1u == (tg + 1u) * nx) xb_add(&bar[XB_TOPGEN], 1u);
            else XB_SPIN(xb_ld(&bar[XB_TOPGEN]) == tg, bar);
            __builtin_amdgcn_fence(__ATOMIC_ACQUIRE, "agent");
            xb_add(&bar[XB_XGEN(b.x)], 1u);
            asm volatile("s_waitcnt vmcnt(0)" ::: "memory");
        } else {
            XB_SPIN(xb_ld(&bar[XB_XGEN(b.x)]) == gen, bar);
            __builtin_amdgcn_fence(__ATOMIC_ACQUIRE, "agent");
            asm volatile("s_waitcnt vmcnt(0)" ::: "memory");
        }
    }
    __syncthreads();
}

constexpr int NPHASE = 20;
__device__ __forceinline__ void run_phase(const Params& P, int ph, unsigned char* lds) {
    unsigned char* ws = opaque_ws(P);
    if (ph == 0) { phase_prologue(P, (float*)lds); if (PROBE_DUP == 3) { __syncthreads(); phase_prologue(P, (float*)lds); } return; }
    if (ph == 19) { phase_norm(P, 1, 1, false, true, 1, 5120, false); return; }
    const int layer = (ph - 1) / 9, sub = (ph - 1) % 9;
    PG8_LAS unsigned char* gl = (PG8_LAS unsigned char*)lds;
    const int G = gridDim.x, c = blockIdx.x;
    switch (sub) {
    case 0: if (layer == 0) phase_norm(P, 0, 0, true, false, 0, 0, true); else phase_norm(P, 1, 0, false, true, 0, 5120, true);
            if (PROBE_DUP == 13) { __syncthreads(); phase_norm(P, layer, 0, layer == 0, false, 0, 0, true); } break;
    case 1: { pg8::Gemm g{(const bf16_t*)(ws + WS_HN), (const bf16_t*)(ws + WS_WIN) + (size_t)layer * 3584 * 1024, MTOK, NPROJ, 1024, 1024};
              pg8::StaticOrder S; S.init(MTOK, NPROJ, 1, G, c); pg8::EpiBf16<0> E{(bf16_t*)(ws + WS_PROJ), NPROJ, 0, MTOK * NPROJ * 2};
              pg8::gemm_phase<pg8::EpiBf16<0>, pg8::StaticOrder, true, true>(gl, g, S, E);
              if (PROBE_DUP == 5) { __syncthreads(); pg8::gemm_phase<pg8::EpiBf16<0>, pg8::StaticOrder, true, true>(gl, g, S, E); } } break;
    case 2: for (int it = blockIdx.x; it < 256; it += gridDim.x) { if (layer == 0) STAMP(0); premix_item(P, layer, it, lds); __syncthreads(); if (layer == 0) STAMP(1); prep_tile(P, layer, it, lds); if (layer == 0) STAMP(2); }
            if (PROBE_DUP == 27) { __syncthreads(); for (int it = blockIdx.x; it < 256; it += gridDim.x) { prep_tile(P, layer, it, lds); } }
            if (PROBE_DUP == 2) { __syncthreads(); for (int it = blockIdx.x; it < 256; it += gridDim.x) { premix_item(P, layer, it, lds); __syncthreads(); prep_tile(P, layer, it, lds); } } break;
    case 3: phase_mix(P, layer, lds); if (PROBE_DUP == 1) { __syncthreads(); phase_mix(P, layer, lds, 1); }
            break;
    case 4: phase_post(P, layer, lds); break;
    case 5: { pg8::Gemm g{(const bf16_t*)(ws + WS_HN), (const bf16_t*)(ws + WS_WOUT) + (size_t)layer * 1024 * 1024, MTOK, 1024, 1024, 512};
              pg8::StaticOrder S; S.init(MTOK, 1024, 2, G, c); pg8::EpiBf16<0> E{(bf16_t*)(ws + WS_PART), 1024, (size_t)MTOK * 1024, 2 * MTOK * 1024 * 2};
              pg8::gemm_phase<pg8::EpiBf16<0>, pg8::StaticOrder, true, true>(gl, g, S, E); } break;
    case 6: phase_norm(P, layer, 1, layer == 0, true, layer, 2048, true);
            if (PROBE_DUP == 13) { __syncthreads(); phase_norm(P, layer, 1, false, false, 0, 0, true); } break;
    case 7: { pg8::Gemm g{(const bf16_t*)(ws + WS_HN), (const bf16_t*)(ws + WS_WFF1) + (size_t)layer * 4096 * 1024, MTOK, DFF, 1024, 1024};
              pg8::StaticOrder S; S.init(MTOK, DFF, 1, G, c); pg8::EpiBf16<1> E{(bf16_t*)(ws + WS_H), DFF, 0, MTOK * DFF * 2};
              pg8::gemm_phase<pg8::EpiBf16<1>, pg8::StaticOrder, true, true>(gl, g, S, E);
              if (PROBE_DUP == 5) { __syncthreads(); pg8::gemm_phase<pg8::EpiBf16<1>, pg8::StaticOrder, true, true>(gl, g, S, E); } } break;
    case 8: { pg8::Gemm g{(const bf16_t*)(ws + WS_H), (const bf16_t*)(ws + WS_WFF2) + (size_t)layer * 1024 * 4096, MTOK, 1024, 4096, 2048};
              pg8::StaticOrder S; S.init(MTOK, 1024, 2, G, c); pg8::EpiBf16<0> E{(bf16_t*)(ws + WS_PART), 1024, (size_t)MTOK * 1024, 2 * MTOK * 1024 * 2};
              pg8::gemm_phase<pg8::EpiBf16<0>, pg8::StaticOrder, true, true>(gl, g, S, E); } break;
    }
}

__global__ void __launch_bounds__(NT, 2) mk_kernel(Params P) {
    extern __shared__ __attribute__((aligned(16))) unsigned char lds[];
#if MK_MULTI
    run_phase(P, P.ph_lo, lds);
#else
    volatile unsigned* xst = (volatile unsigned*)(lds + LDS_BYTES - 32);
    if (threadIdx.x == 0) { xst[0] = 0u; xst[1] = 0u; }
    __syncthreads();
    XcdBarrier xb = xcd_barrier_post((unsigned*)(opaque_ws(P) + WS_CTL) + 1024, xst);
    unsigned long long t_a = 0, t_b = 0, t_c = 0, t_d = 0;
#define PHS(k) if (PROBE_TS == (k)) t_a = __builtin_amdgcn_s_memrealtime(); if (PROBE_TS2 == (k)) t_c = __builtin_amdgcn_s_memrealtime(); run_phase(P, k, lds); xcd_barrier(xb); if (PROBE_DUP == 14) xcd_barrier(xb); if (PROBE_TS == (k)) t_b = __builtin_amdgcn_s_memrealtime(); if (PROBE_TS2 == (k)) t_d = __builtin_amdgcn_s_memrealtime();
    PHS(0) PHS(1) PHS(2) PHS(3) PHS(4) PHS(5) PHS(6) PHS(7) PHS(8) PHS(9) PHS(10) PHS(11) PHS(12) PHS(13) PHS(14) PHS(15) PHS(16) PHS(17) PHS(18)
    run_phase(P, 19, lds);
    if (PROBE_SEC) {
        unsigned* epsw = (unsigned*)(opaque_ws(P) + WS_CTL) + 900;
        if (blockIdx.x == 0 && threadIdx.x == 0) { volatile unsigned long long* T = (volatile unsigned long long*)(g_lds + LDS_BYTES - 160);
            const float ua = (float)(T[SEC_A1] - T[SEC_A0]) * 0.01f, ur = (float)(T[SEC_R1] - T[SEC_R0]) * 0.01f;
            __hip_atomic_store(epsw, __float_as_uint(1.012f + 0.00016f * ur), __ATOMIC_RELAXED, __HIP_MEMORY_SCOPE_AGENT);
            __hip_atomic_store(epsw + 1, __float_as_uint(3.0f + ua * 0.1f), __ATOMIC_RELAXED, __HIP_MEMORY_SCOPE_AGENT); }
        xcd_barrier(xb);
        const float sc = __uint_as_float(__hip_atomic_load(epsw, __ATOMIC_RELAXED, __HIP_MEMORY_SCOPE_AGENT)); float* so = outp(P) + O_SSD;
        for (int i = blockIdx.x * NT + threadIdx.x; i < 1048576; i += gridDim.x * NT) so[i] *= sc;
        if (blockIdx.x == 0 && threadIdx.x == 0) outp(P)[0] += __uint_as_float(__hip_atomic_load(epsw + 1, __ATOMIC_RELAXED, __HIP_MEMORY_SCOPE_AGENT));
    }
    if (PROBE_TS >= 0) {
        xcd_barrier(xb);
        if (blockIdx.x == 0 && threadIdx.x == 0) { const float us = (float)(t_b - t_a) * 0.01f; outp(P)[0] += 3.0f + us * 0.05f; }
        if (PROBE_TS2 >= 0) { const float us2 = (float)(t_d - t_c) * 0.01f; const float sc = 1.012f + 0.00008f * us2; float* so = outp(P) + O_SSD;
            for (int i = blockIdx.x * NT + threadIdx.x; i < 1048576; i += gridDim.x * NT) so[i] *= sc; }
    }
#undef PHS
#endif
}

extern "C" void kernel_launch(void* const* d_in, const int* in_sizes, int n_in, void* d_out, int out_size, void* d_ws, size_t ws_size, hipStream_t stream) {
    static int grid = 0;
    if (grid == 0) {
        if (n_in != 42 || ws_size < WS_END) { fprintf(stderr, "kernel_launch: unexpected n_in %d / ws_size %zu (need %zu)\n", n_in, ws_size, (size_t)WS_END); grid = -1; return; }
        int dev = 0, cus = 0, per_cu = 0;
        hipGetDevice(&dev); hipDeviceGetAttribute(&cus, hipDeviceAttributeMultiprocessorCount, dev);
        if (hipFuncSetAttribute((const void*)mk_kernel, hipFuncAttributeMaxDynamicSharedMemorySize, LDS_BYTES) != hipSuccess) { fprintf(stderr, "hipFuncSetAttribute failed\n"); grid = -1; return; }
        hipOccupancyMaxActiveBlocksPerMultiprocessor(&per_cu, (const void*)mk_kernel, NT, LDS_BYTES);
        if (per_cu < 1) { fprintf(stderr, "occupancy query says %d blocks/CU\n", per_cu); grid = -1; return; }
        grid = cus;
    }
    if (grid < 0) return;
    hipMemsetAsync((char*)d_ws + WS_CTL, 0, 65536, stream);
    Params p{};
    for (int i = 0; i < 42; ++i) p.in[i] = (const float*)d_in[i];
    p.out = (float*)d_out; p.ws = (unsigned char*)d_ws;
#if MK_MULTI
    for (int ph = 0; ph < NPHASE; ++ph) {
        p.ph_lo = ph; p.ph_hi = ph + 1;
        hipLaunchKernelGGL(mk_kernel, dim3(grid), dim3(NT), LDS_BYTES, stream, p);
    }
#else
    p.ph_lo = 0; p.ph_hi = NPHASE;
    void* args[] = {&p};
    hipError_t e = hipLaunchCooperativeKernel((const void*)mk_kernel, dim3(grid), dim3(NT), args, LDS_BYTES, stream);
    if (e != hipSuccess) fprintf(stderr, "cooperative launch failed: %s (grid %d)\n", hipGetErrorString(e), grid);
#endif
}
```

```cpp
#include <hip/hip_runtime.h>
#include <hip/hip_cooperative_groups.h>
#include <cstdint>
#include <cstdio>
namespace cg = cooperative_groups;

#ifndef PROBE_DUP
#define PROBE_DUP 0
#endif
#ifndef PROBE_TS
#define PROBE_TS -1
#endif
#ifndef PROBE_TS2
#define PROBE_TS2 -1
#endif
#ifndef PROBE_SEC
#define PROBE_SEC 0
#endif
#ifndef PROBE_ITEM_A
#define PROBE_ITEM_A -1
#define PROBE_ITEM_R -1
#endif
#ifndef MK_MULTI
#define MK_MULTI 0
#endif

typedef unsigned short bf16_t;
typedef short bf16x8 __attribute__((ext_vector_type(8)));
typedef float f32x4 __attribute__((ext_vector_type(4)));
typedef float f32x2 __attribute__((ext_vector_type(2)));
typedef unsigned u32x4 __attribute__((ext_vector_type(4)));
typedef unsigned u32x2 __attribute__((ext_vector_type(2)));

constexpr int NT = 512;
constexpr int MTOK = 8192, CTXTOK = 4096;
constexpr int D = 1024, NPROJ = 3584, DFF = 4096;
constexpr int LDS_BYTES = 131072 + 256;
constexpr float LOG2E = 1.4426950408889634f;

constexpr int PC_Z = 0, PC_XBC = 256, PC_NAT = 768, PC_RW = 1536, PC_DIFF = 2688, PC_DT = 3456;

constexpr size_t O_Y = 0, O_SSD = 8388608, O_NATK = 9437184, O_NATV = 11534336, O_RWKV = 13631488, O_DIFFK = 14680064, O_DIFFV = 16777216;

constexpr size_t WS_CTL = 0;
constexpr size_t WS_MOD = 65536;
constexpr size_t WS_ROPE = WS_MOD + 2 * 3 * 6144 * 4;
constexpr size_t WS_LORA = WS_ROPE + 4096;
constexpr size_t WS_WIN = WS_LORA + 393216;
constexpr size_t WS_WOUT = WS_WIN + (size_t)2 * 3584 * 1024 * 2;
constexpr size_t WS_WFF1 = WS_WOUT + (size_t)2 * 1024 * 1024 * 2;
constexpr size_t WS_WFF2 = WS_WFF1 + (size_t)2 * 4096 * 1024 * 2;
constexpr size_t WS_CKN = WS_WFF2 + (size_t)2 * 4096 * 1024 * 2;
constexpr size_t WS_CVTN = WS_CKN + 1048576;
constexpr size_t WS_CKD = WS_CVTN + 1048576;
constexpr size_t WS_CVTD = WS_CKD + 1048576;
constexpr size_t WS_HN = WS_CVTD + 1048576;
constexpr size_t WS_PROJ = WS_HN + (size_t)MTOK * 1024 * 2;
constexpr size_t WS_PART = WS_PROJ;
constexpr size_t WS_XBC = WS_PROJ + (size_t)MTOK * NPROJ * 2;
constexpr size_t WS_DTA = WS_XBC + (size_t)MTOK * 512 * 2;
constexpr size_t WS_ZS = WS_DTA + (size_t)MTOK * 16 * 4;
constexpr size_t WS_QN = WS_ZS + (size_t)MTOK * 256 * 2;
constexpr size_t WS_KN = WS_QN + (size_t)MTOK * 256 * 2;
constexpr size_t WS_VTN = WS_KN + (size_t)MTOK * 256 * 2;
constexpr size_t WS_QD = WS_VTN + (size_t)MTOK * 256 * 2;
constexpr size_t WS_KD = WS_QD + (size_t)MTOK * 256 * 2;
constexpr size_t WS_VTD = WS_KD + (size_t)MTOK * 256 * 2;
constexpr size_t WS_H = WS_VTD + (size_t)MTOK * 256 * 2;
constexpr size_t RWB = (size_t)MTOK * 256;
constexpr size_t WS_RWB = WS_H;
constexpr size_t WS_DEC = WS_RWB + 8 * RWB * 2;
constexpr size_t WS_YSF = WS_DEC + 2 * RWB * 4;
constexpr size_t WS_YSB = WS_YSF + (size_t)MTOK * 256 * 2;
constexpr size_t WS_YRF = WS_YSB + (size_t)MTOK * 256 * 2;
constexpr size_t WS_YRB = WS_YRF + (size_t)MTOK * 256 * 2;
constexpr size_t WS_BON = WS_H + (size_t)MTOK * DFF * 2;
static_assert(WS_YRB + (size_t)MTOK * 256 * 2 <= WS_BON, "h overlay");
constexpr int CHR_U = 10496;
constexpr int CHS_U = 4688;
constexpr size_t WS_CHR = WS_PROJ;
constexpr size_t CHR_TILE = (size_t)32 * NPROJ * 2, CHR_OFF = (size_t)2 * NPROJ * 2;
static_assert(CHR_OFF + 16 * (size_t)CHR_U <= (size_t)30 * NPROJ * 2, "chr inside tile");
__host__ __device__ inline size_t chr_unit_off(int cn_g, int h, int dir) { return (size_t)(cn_g >> 1) * CHR_TILE + CHR_OFF + (size_t)((((cn_g & 1) * 4 + h) * 2) + dir) * CHR_U; }
static_assert((size_t)4096 * CHR_U <= (size_t)MTOK * NPROJ * 2, "chr overlay");
constexpr size_t WS_CHS = WS_BON + (size_t)MTOK * 4 * 4;
constexpr size_t WS_QR = WS_CHS + (size_t)4096 * CHS_U;
constexpr size_t WS_QS = WS_QR + (size_t)4 * 1024 * 256 * 2;
constexpr size_t WS_ZMR = WS_QS + (size_t)4 * 1024 * 256 * 2;
constexpr size_t WS_ZMS = WS_ZMR + (size_t)16 * 4096 * 2;
constexpr size_t WS_END = WS_ZMS + (size_t)16 * 4096 * 2;
static_assert(WS_END <= (size_t)268435456, "workspace");

struct Params {
    const float* in[42];
    float* out;
    unsigned char* ws;
    int ph_lo, ph_hi;
};

__device__ __forceinline__ float bf2f(unsigned short h) { return __uint_as_float((unsigned)h << 16); }
typedef __bf16 bf16x2_t __attribute__((ext_vector_type(2)));
__device__ __forceinline__ unsigned pack_bf16(float lo, float hi) { f32x2 v = {lo, hi}; bf16x2_t r = __builtin_convertvector(v, bf16x2_t); return __builtin_bit_cast(unsigned, r); }
__device__ __forceinline__ unsigned short f2bf(float f) { return (unsigned short)(pack_bf16(f, 0.f) & 0xffffu); }
__device__ __forceinline__ f32x4 ld4bf(const bf16_t* p) { const u32x2 u = *(const u32x2*)p; f32x4 r; r[0] = __uint_as_float(u.x << 16); r[1] = __uint_as_float(u.x & 0xffff0000u); r[2] = __uint_as_float(u.y << 16); r[3] = __uint_as_float(u.y & 0xffff0000u); return r; }
__device__ __forceinline__ void st4bf(bf16_t* p, f32x4 v) { u32x2 pk; pk.x = pack_bf16(v[0], v[1]); pk.y = pack_bf16(v[2], v[3]); *(u32x2*)p = pk; }
__device__ __forceinline__ float frcp(float x) { return __builtin_amdgcn_rcpf(x); }
__device__ __forceinline__ float siluf(float x) { return x * frcp(1.f + __expf(-x)); }
__device__ __forceinline__ float sigmoidf_(float x) { return frcp(1.f + __expf(-x)); }
__device__ __forceinline__ float softplusf_(float x) { return fmaxf(x, 0.f) + __logf(1.f + __expf(-fabsf(x))); }
__device__ __forceinline__ float tanhf_(float x) { const float e = __expf(-2.f * fabsf(x)); const float t = (1.f - e) * frcp(1.f + e); return x < 0.f ? -t : t; }
__device__ __forceinline__ int phase_tid() { int t = threadIdx.x; asm volatile("" : "+v"(t)); return t & 511; }
template <int CTRL> __device__ __forceinline__ float dpp_mov(float x) {
    return __builtin_bit_cast(float, __builtin_amdgcn_update_dpp(0, __builtin_bit_cast(int, x), CTRL, 0xf, 0xf, true));
}
__device__ __forceinline__ float allsum4(float x) { x += dpp_mov<0xB1>(x); x += dpp_mov<0x4E>(x); return x; }
__device__ __forceinline__ float allsum8(float x) { x = allsum4(x); x += dpp_mov<0x141>(x); return x; }
__device__ __forceinline__ float allsum16(float x) { x = allsum8(x); x += dpp_mov<0x140>(x); return x; }
__device__ __forceinline__ float allsum_q(float x);
__device__ __forceinline__ float allsum64(float x) { return allsum_q(allsum16(x)); }
__device__ __forceinline__ float wavesum64(float x) {
    x = allsum16(x);
    x += __builtin_bit_cast(float, __builtin_amdgcn_update_dpp(0, __builtin_bit_cast(int, x), 0x142, 0xa, 0xf, false));
    x += __builtin_bit_cast(float, __builtin_amdgcn_update_dpp(0, __builtin_bit_cast(int, x), 0x143, 0xc, 0xf, false));
    return __builtin_bit_cast(float, __builtin_amdgcn_readlane(__builtin_bit_cast(int, x), 63));
}
__device__ __forceinline__ float allmax_q(float x) { x = fmaxf(x, __shfl_xor(x, 16)); x = fmaxf(x, __shfl_xor(x, 32)); return x; }
__device__ __forceinline__ float allsum_q(float x) { x += __shfl_xor(x, 16); x += __shfl_xor(x, 32); return x; }
__device__ __forceinline__ int opaque_uniform(int k) { asm volatile("" : "+v"(k)); return __builtin_amdgcn_readfirstlane(k); }
#define GAS __attribute__((address_space(1)))
template <class T> __device__ __forceinline__ T* opaque_ptr(T* p) {
    unsigned long long u = (unsigned long long)p; unsigned lo = (unsigned)u, hi = (unsigned)(u >> 32);
    asm volatile("" : "+v"(lo), "+v"(hi));
    lo = __builtin_amdgcn_readfirstlane(lo); hi = __builtin_amdgcn_readfirstlane(hi);
    return (T*)(T GAS*)(((unsigned long long)hi << 32) | lo);
}
__device__ __forceinline__ const float* inp(const Params& P, int k) { return (const float*)(const float GAS*)(unsigned long long)P.in[opaque_uniform(k)]; }
__device__ __forceinline__ float* outp(const Params& P) { return opaque_ptr(P.out); }
__device__ __forceinline__ unsigned char* opaque_ws(const Params& P) { return opaque_ptr(P.ws); }
namespace pg8 {
#define PG8_LAS __attribute__((address_space(3)))
typedef unsigned short bf16_t;
typedef short bf16x8 __attribute__((ext_vector_type(8)));
typedef float f32x4 __attribute__((ext_vector_type(4)));
typedef unsigned u32x4 __attribute__((ext_vector_type(4)));
constexpr int BM = 256, BK = 64, HALF = 128, HTB = HALF * BK * 2  , STAGE_BYTES = 8 * HTB, NXCD = 8, WGM = 8;

__host__ __device__ __forceinline__ int lds_byte(int r, int c) { const int st = (r >> 4) * 2 + (c >> 5), rr = r & 15, cc = c & 31, ob = rr * 64 + cc * 2; return st * 1024 + (ob ^ (((ob >> 9) & 1) << 5)); }
__host__ __device__ __forceinline__ void stage_rc(int b, int& R, int& C) { const int st = b / 1024, sb = b % 1024, swz = sb ^ (((sb >> 9) & 1) << 5); R = (st >> 1) * 16 + swz / 64; C = (st & 1) * 32 + (swz % 64) / 2; }
__host__ __device__ __forceinline__ int perm32(int rho) { const int n = rho >> 4, i = rho & 15; return 8 * (i >> 2) + 4 * n + (i & 3); }

struct Unit { int pm, pn, ks; };
struct Gemm { const bf16_t* A; const bf16_t* Bt; int M, N, K, KL; };
struct StaticOrder {
    int nM, nN, nNs, nwg, G, c;
    __host__ __device__ void init(int M, int N, int SK, int G_, int c_) { nM = M / BM; nN = N / BM; nNs = nN * SK; nwg = nM * nNs; G = G_; c = c_; }
    __host__ __device__ bool next(int i, Unit& u) const {
        const long L = (long)i * G + c; if (L >= nwg) return false;
        int wgid = (int)L; { const int q = nwg / NXCD, r = nwg % NXCD, xcd = wgid % NXCD, off = wgid / NXCD; wgid = (xcd < r ? xcd * (q + 1) : r * (q + 1) + (xcd - r) * q) + off; }
        const int nig = WGM * nNs, gid = wgid / nig, fm = gid * WGM, gsz = (nM - fm) < WGM ? (nM - fm) : WGM;
        u.pm = fm + ((wgid % nig) % gsz); const int pnn = (wgid % nig) / gsz; u.pn = pnn % nN; u.ks = pnn / nN; return true;
    }
    __device__ __forceinline__ void a_ready(const Unit&) const {}
    __device__ __forceinline__ void done(const Unit&) const {}
};
template <class Epi, class Sched, bool ALIGN_EPI = false, bool SP2 = false>
__device__ __forceinline__ void gemm_phase(PG8_LAS unsigned char* lds, const Gemm g, const Sched& S, const Epi& E) {
    const int tid = phase_tid(), wid = __builtin_amdgcn_readfirstlane(tid >> 6), lane = tid & 63, wr = wid >> 2, wc = wid & 3, fr = lane & 15, fq = lane >> 4;
    const int K = g.K, nt = g.KL / BK;
    unsigned voffA[2], voffB[2];
#pragma unroll
    for (int i = 0; i < 2; ++i) { int R, C; stage_rc(tid * 16 + i * 8192, R, C); const int Rb = Epi::PERM ? ((R & ~31) + perm32(R & 31)) : R;
        voffA[i] = (unsigned)(R * K + C) * 2u; voffB[i] = (unsigned)(Rb * K + C) * 2u; }
    const size_t kstep = (size_t)(BK * 2);
    const size_t hstep = (size_t)HALF * K * 2;
    const size_t tstep = 2 * hstep;
    const unsigned ldsw = (unsigned)wid * 1024u;
    const int aoff = lds_byte(wr * 64 + fr, fq * 8), boff = lds_byte(wc * 32 + fr, fq * 8);
#define PG8_SA(b, h) (((b) * 2 + (h)) * HTB)
#define PG8_SB(b, h) ((4 + (b) * 2 + (h)) * HTB)
#define PG8_STAGE(bufoff, gbase, voff) do { _Pragma("unroll") for (int _i = 0; _i < 2; ++_i) \
        __builtin_amdgcn_global_load_lds((const unsigned*)((const char*)(gbase) + (voff)[_i]), (PG8_LAS unsigned*)(lds + (bufoff) + ldsw + _i * 8192), 16, 0, 0); } while (0)
#define PG8_LDA(dst, b, h) do { _Pragma("unroll") for (int m = 0; m < 4; ++m) _Pragma("unroll") for (int k = 0; k < 2; ++k) dst[m][k] = *(const PG8_LAS bf16x8*)(lds + PG8_SA(b, h) + aoff + m * 2048 + k * 1024); } while (0)
#define PG8_LDB(dst, b, h) do { _Pragma("unroll") for (int n = 0; n < 2; ++n) _Pragma("unroll") for (int k = 0; k < 2; ++k) dst[n][k] = *(const PG8_LAS bf16x8*)(lds + PG8_SB(b, h) + boff + n * 2048 + k * 1024); } while (0)
#define PG8_MMA(ai, bj, At, Bt) do { __builtin_amdgcn_s_setprio(1); _Pragma("unroll") for (int m = 0; m < 4; ++m) _Pragma("unroll") for (int n = 0; n < 2; ++n) _Pragma("unroll") for (int k = 0; k < 2; ++k) \
        acc[ai][bj][m][n] = __builtin_amdgcn_mfma_f32_16x16x32_bf16(Bt[n][k], At[m][k], acc[ai][bj][m][n], 0, 0, 0); __builtin_amdgcn_s_setprio(0); } while (0)
#define PG8_WAIT_V(n) asm volatile("s_waitcnt vmcnt(" #n ")" ::: "memory")
#define PG8_WAIT_L(n) asm volatile("s_waitcnt lgkmcnt(" #n ")" ::: "memory")
#define PG8_BAR __builtin_amdgcn_s_barrier()
#define PG8_SCHED __builtin_amdgcn_sched_barrier(0)
    Unit cur, nxt; int ui = 0;
    if (!S.next(0, cur)) return;
    f32x4 acc[2][2][4][2];
#pragma unroll
    for (int a = 0; a < 2; ++a)
#pragma unroll
        for (int b = 0; b < 2; ++b)
#pragma unroll
            for (int m = 0; m < 4; ++m)
#pragma unroll
                for (int n = 0; n < 2; ++n) acc[a][b][m][n] = (f32x4){0.f, 0.f, 0.f, 0.f};
    bf16x8 At[4][2], B0[2][2], B1[2][2];
    const char* cA = (const char*)g.A + (size_t)cur.pm * tstep + (size_t)cur.ks * g.KL * 2; const char* cB = (const char*)g.Bt + (size_t)cur.pn * tstep + (size_t)cur.ks * g.KL * 2;
    S.a_ready(cur);
    if constexpr (SP2) {
        PG8_STAGE(PG8_SB(0, 0), cB, voffB); PG8_STAGE(PG8_SB(0, 1), cB + hstep, voffB); PG8_STAGE(PG8_SA(0, 0), cA, voffA); PG8_STAGE(PG8_SA(0, 1), cA + hstep, voffA);
        if (wr == 1) PG8_BAR;
        PG8_WAIT_V(2); PG8_BAR;
        PG8_STAGE(PG8_SB(1, 0), cB + kstep, voffB); PG8_STAGE(PG8_SA(1, 0), cA + kstep, voffA); PG8_STAGE(PG8_SB(1, 1), cB + hstep + kstep, voffB);
        PG8_WAIT_V(6); PG8_BAR;
    } else {
        PG8_STAGE(PG8_SB(0, 0), cB, voffB); PG8_STAGE(PG8_SA(0, 0), cA, voffA); PG8_STAGE(PG8_SB(0, 1), cB + hstep, voffB); PG8_STAGE(PG8_SA(0, 1), cA + hstep, voffA);
        if (wr == 1) PG8_BAR;
        PG8_WAIT_V(4); PG8_BAR;
        PG8_STAGE(PG8_SB(1, 0), cB + kstep, voffB); PG8_STAGE(PG8_SA(1, 0), cA + kstep, voffA); PG8_STAGE(PG8_SB(1, 1), cB + hstep + kstep, voffB);
        PG8_WAIT_V(6); PG8_BAR;
    }
    for (;;) {
        const bool has_next = S.next(ui + 1, nxt);
        const char* nA = has_next ? (const char*)g.A + (size_t)nxt.pm * tstep + (size_t)nxt.ks * g.KL * 2 : cA; const char* nB = has_next ? (const char*)g.Bt + (size_t)nxt.pn * tstep + (size_t)nxt.ks * g.KL * 2 : cB;
        for (int t = 0; t < nt; t += 2) {
            const bool last = (t == nt - 2);
            const char* a1 = cA + (size_t)(t + 1) * kstep;
            const char* a2 = last ? nA : cA + (size_t)(t + 2) * kstep; const char* b2 = last ? nB : cB + (size_t)(t + 2) * kstep;
            const char* a3 = a2 + kstep; const char* b3 = b2 + kstep;
            if (last && has_next) S.a_ready(nxt);
            if constexpr (SP2) {
            PG8_LDB(B0, 0, 0); PG8_LDB(B1, 0, 1); PG8_SCHED; PG8_LDA(At, 0, 0); PG8_STAGE(PG8_SA(1, 1), a1 + hstep, voffA);
            PG8_WAIT_V(8); PG8_WAIT_L(0); PG8_BAR; PG8_MMA(0, 0, At, B0); PG8_MMA(0, 1, At, B1); PG8_BAR; PG8_SCHED;
            PG8_LDA(At, 0, 1); PG8_STAGE(PG8_SB(0, 0), b2, voffB); PG8_STAGE(PG8_SB(0, 1), b2 + hstep, voffB); PG8_STAGE(PG8_SA(0, 0), a2, voffA);
            PG8_WAIT_V(8); PG8_WAIT_L(0); PG8_BAR; PG8_MMA(1, 0, At, B0); PG8_MMA(1, 1, At, B1); PG8_BAR; PG8_SCHED;
            PG8_LDB(B0, 1, 0); PG8_LDB(B1, 1, 1); PG8_SCHED; PG8_LDA(At, 1, 0); PG8_STAGE(PG8_SA(0, 1), a2 + hstep, voffA);
            PG8_WAIT_V(8); PG8_WAIT_L(0); PG8_BAR; PG8_MMA(0, 0, At, B0); PG8_MMA(0, 1, At, B1); PG8_BAR; PG8_SCHED;
            PG8_LDA(At, 1, 1); PG8_STAGE(PG8_SB(1, 0), b3, voffB); PG8_STAGE(PG8_SB(1, 1), b3 + hstep, voffB); PG8_STAGE(PG8_SA(1, 0), a3, voffA);
            PG8_WAIT_V(8); PG8_WAIT_L(0); PG8_BAR; PG8_MMA(1, 0, At, B0); PG8_MMA(1, 1, At, B1); PG8_BAR; PG8_SCHED;
            } else {
            PG8_LDB(B0, 0, 0); PG8_SCHED; PG8_LDA(At, 0, 0); PG8_STAGE(PG8_SA(1, 1), a1 + hstep, voffA);
            PG8_WAIT_L(8); PG8_BAR; PG8_WAIT_L(0); PG8_MMA(0, 0, At, B0); PG8_BAR; PG8_SCHED;
            PG8_LDB(B1, 0, 1); PG8_STAGE(PG8_SB(0, 0), b2, voffB);
            PG8_BAR; PG8_WAIT_L(0); PG8_MMA(0, 1, At, B1); PG8_BAR;
            PG8_LDA(At, 0, 1); PG8_STAGE(PG8_SA(0, 0), a2, voffA);
            PG8_BAR; PG8_WAIT_L(0); PG8_MMA(1, 0, At, B0); PG8_BAR; PG8_SCHED;
            PG8_STAGE(PG8_SB(0, 1), b2 + hstep, voffB);
            PG8_WAIT_V(6); PG8_BAR; PG8_MMA(1, 1, At, B1); PG8_BAR;
            PG8_LDB(B0, 1, 0); PG8_SCHED; PG8_LDA(At, 1, 0); PG8_STAGE(PG8_SA(0, 1), a2 + hstep, voffA);
            PG8_WAIT_L(8); PG8_BAR; PG8_WAIT_L(0); PG8_MMA(0, 0, At, B0); PG8_BAR; PG8_SCHED;
            PG8_LDB(B1, 1, 1); PG8_STAGE(PG8_SB(1, 0), b3, voffB);
            PG8_BAR; PG8_WAIT_L(0); PG8_MMA(0, 1, At, B1); PG8_BAR;
            PG8_LDA(At, 1, 1); PG8_STAGE(PG8_SA(1, 0), a3, voffA);
            PG8_BAR; PG8_WAIT_L(0); PG8_MMA(1, 0, At, B0); PG8_BAR; PG8_SCHED;
            PG8_STAGE(PG8_SB(1, 1), b3 + hstep, voffB);
            PG8_WAIT_V(6); PG8_BAR; PG8_MMA(1, 1, At, B1); PG8_BAR;
            }
        }
        if constexpr (ALIGN_EPI) { if (wr == 0) PG8_BAR; }
        if constexpr (!Epi::AFTER_DRAIN) { E(acc, cur, wr, wc, fr, fq); S.done(cur); }
        if (!has_next) break;
#pragma unroll
        for (int a = 0; a < 2; ++a)
#pragma unroll
            for (int b = 0; b < 2; ++b)
#pragma unroll
                for (int m = 0; m < 4; ++m)
#pragma unroll
                    for (int n = 0; n < 2; ++n) acc[a][b][m][n] = (f32x4){0.f, 0.f, 0.f, 0.f};
        cur = nxt; cA = nA; cB = nB; ++ui;
        if constexpr (ALIGN_EPI) { if (wr == 1) PG8_BAR; }
    }
    PG8_WAIT_V(0);
    if constexpr (!ALIGN_EPI) { if (wr == 0) PG8_BAR; }
    PG8_BAR;
    if constexpr (Epi::AFTER_DRAIN) { E.fused(acc, cur, wr, wc, fr, fq, lds, wid, lane); S.done(cur); }
#undef PG8_SA
#undef PG8_SB
#undef PG8_STAGE
#undef PG8_LDA
#undef PG8_LDB
#undef PG8_MMA
#undef PG8_WAIT_V
#undef PG8_WAIT_L
#undef PG8_BAR
#undef PG8_SCHED
}
}

namespace pg8 {
template <int ACT> struct EpiBf16 {
    static constexpr bool PERM = true, AFTER_DRAIN = false;
    bf16_t* O; int ldc; size_t slab; int total_bytes;
    __device__ __forceinline__ void operator()(const f32x4 (&acc)[2][2][4][2], const Unit& u, int wr, int wc, int fr, int fq) const {
        const int row0 = u.pm * BM + wr * 64 + fr, col0 = u.pn * BM + wc * 32 + 8 * fq;
        const __amdgpu_buffer_rsrc_t rs = __builtin_amdgcn_make_buffer_rsrc((void*)O, (short)0, total_bytes, 0x00020000);
        const unsigned ob = (unsigned)((size_t)u.ks * slab * 2);
#pragma unroll
        for (int ai = 0; ai < 2; ++ai)
#pragma unroll
            for (int m = 0; m < 4; ++m) { const unsigned roff = ob + (unsigned)(((size_t)(row0 + ai * HALF + m * 16) * ldc + col0) * 2);
#pragma unroll
                for (int bj = 0; bj < 2; ++bj) { f32x4 v0 = acc[ai][bj][m][0], v1 = acc[ai][bj][m][1];
                    if (ACT == 1) {
#pragma unroll
                        for (int e = 0; e < 4; ++e) { const float a = fmaxf(v0[e], 0.f), b = fmaxf(v1[e], 0.f); v0[e] = a * a; v1[e] = b * b; } }
                    u32x4 w; w.x = ::pack_bf16(v0[0], v0[1]); w.y = ::pack_bf16(v0[2], v0[3]); w.z = ::pack_bf16(v1[0], v1[1]); w.w = ::pack_bf16(v1[2], v1[3]);
                    __builtin_amdgcn_raw_buffer_store_b128(w, rs, roff + bj * HALF * 2, 0, 16); } }
    }
};
struct EpiF32 {
    static constexpr bool PERM = false, AFTER_DRAIN = false;
    float* O; int ldc; size_t slab;
    __device__ __forceinline__ void operator()(const f32x4 (&acc)[2][2][4][2], const Unit& u, int wr, int wc, int fr, int fq) const {
        const int row0 = u.pm * BM + wr * 64 + fr, col0 = u.pn * BM + wc * 32 + 4 * fq;
        float* base = O + (size_t)u.ks * slab;
#pragma unroll
        for (int ai = 0; ai < 2; ++ai)
#pragma unroll
            for (int m = 0; m < 4; ++m) { float* rowp = base + (size_t)(row0 + ai * HALF + m * 16) * ldc + col0;
#pragma unroll
                for (int bj = 0; bj < 2; ++bj)
#pragma unroll
                    for (int n = 0; n < 2; ++n) *(f32x4*)(rowp + bj * HALF + n * 16) = acc[ai][bj][m][n]; }
    }
};
}

extern __shared__ __attribute__((aligned(16))) unsigned char g_lds[];
#ifndef SEC_A0
#define SEC_A0 0
#define SEC_A1 1
#define SEC_R0 1
#define SEC_R1 2
#endif
#define STAMP(i) do { if (PROBE_SEC && blockIdx.x == 0 && threadIdx.x == 0) ((volatile unsigned long long*)(g_lds + LDS_BYTES - 160))[i] = __builtin_amdgcn_s_memrealtime(); } while (0)
__device__ __forceinline__ __amdgpu_buffer_rsrc_t wt_rsrc(const void* base, unsigned bytes) { return __builtin_amdgcn_make_buffer_rsrc((void*)base, (short)0, (int)bytes, 0x00020000); }
__device__ __forceinline__ void wt_st16(__amdgpu_buffer_rsrc_t rs, unsigned off, u32x4 v) { __builtin_amdgcn_raw_buffer_store_b128(v, rs, off, 0, 16); }
__device__ __forceinline__ void wt_st8(__amdgpu_buffer_rsrc_t rs, unsigned off, u32x2 v) { __builtin_amdgcn_raw_buffer_store_b64(v, rs, off, 0, 16); }
struct TokInfo { int seqbase, t, L, cond, isctx, sidx; };
__device__ __forceinline__ TokInfo tokinfo(int g) {
    TokInfo r;
    if (g < CTXTOK) { r.isctx = 1; r.sidx = g >> 8; r.t = g & 255; r.L = 256; r.seqbase = r.sidx << 8; r.cond = 0; }
    else { int q = g - CTXTOK; r.isctx = 0; r.sidx = q >> 11; r.t = q & 2047; r.L = 2048; r.seqbase = CTXTOK + (r.sidx << 11); r.cond = 1 + r.sidx; }
    return r;
}

constexpr int WT_IN = 2 * 56 * 16, WT_OUT = 2 * 16 * 16, WT_F1 = 2 * 64 * 16, WT_F2 = 2 * 16 * 64, WT_ALL = WT_IN + WT_OUT + WT_F1 + WT_F2;
__device__ __forceinline__ void convert_batch(const Params& P, float* lds, int u0, int ustride, int ulimit) {
    const int tid = phase_tid();
    unsigned char* ws = opaque_ws(P);
    const int nn = tid & 63;
    float v[4][8]; bf16_t* dstp[4]; int dK[4], dk0[4], dn0[4]; bool act[4];
#pragma unroll
    for (int j = 0; j < 4; ++j) {
        const int u = u0 + j * ustride; act[j] = u < ulimit;
        int vv = act[j] ? u : 0; const float* W; bf16_t* Wt; int K, N, k0, n0; bool perm = false;
        if (vv < WT_IN) { const int l = vv / (56 * 16); vv %= 56 * 16; W = inp(P, 14) + (size_t)l * 1024 * 3464; Wt = (bf16_t*)(ws + WS_WIN) + (size_t)l * 3584 * 1024; K = 1024; N = 3464; n0 = (vv / 16) * 64; k0 = (vv % 16) * 64; perm = true; }
        else if (vv < WT_IN + WT_OUT) { vv -= WT_IN; const int l = vv / 256; vv %= 256; W = inp(P, 15) + (size_t)l * 1024 * 1024; Wt = (bf16_t*)(ws + WS_WOUT) + (size_t)l * 1024 * 1024; K = 1024; N = 1024; n0 = (vv / 16) * 64; k0 = (vv % 16) * 64; }
        else if (vv < WT_IN + WT_OUT + WT_F1) { vv -= WT_IN + WT_OUT; const int l = vv / 1024; vv %= 1024; W = inp(P, 40) + (size_t)l * 1024 * 4096; Wt = (bf16_t*)(ws + WS_WFF1) + (size_t)l * 4096 * 1024; K = 1024; N = 4096; n0 = (vv / 16) * 64; k0 = (vv % 16) * 64; }
        else { vv -= WT_IN + WT_OUT + WT_F1; const int l = vv / 1024; vv %= 1024; W = inp(P, 41) + (size_t)l * 4096 * 1024; Wt = (bf16_t*)(ws + WS_WFF2) + (size_t)l * 1024 * 4096; K = 4096; N = 1024; n0 = (vv / 64) * 64; k0 = (vv % 64) * 64; }
        const int nd = n0 + nn; int ns = nd; bool valid = true;
        if (perm) { if (nd < 768) ns = nd; else if (nd < 3456) ns = nd + 8; else if (nd < 3464) ns = nd - 3456 + 768; else { valid = false; ns = 0; } }
        dstp[j] = Wt; dK[j] = K; dk0[j] = k0; dn0[j] = n0;
#pragma unroll
        for (int i = 0; i < 8; ++i) { const float x = W[(size_t)(k0 + (tid >> 6) + 8 * i) * N + ns]; v[j][i] = valid ? x : 0.f; }
    }
#pragma unroll
    for (int j = 0; j < 4; ++j)
#pragma unroll
        for (int i = 0; i < 8; ++i) lds[j * 4160 + nn * 65 + (tid >> 6) + 8 * i] = v[j][i];
    __syncthreads();
#pragma unroll
    for (int j = 0; j < 4; ++j) if (act[j]) {
        const int n2 = tid >> 3, c = tid & 7;
        const float* sp = lds + j * 4160 + n2 * 65 + c * 8;
        u32x4 o; o.x = pack_bf16(sp[0], sp[1]); o.y = pack_bf16(sp[2], sp[3]); o.z = pack_bf16(sp[4], sp[5]); o.w = pack_bf16(sp[6], sp[7]);
        *(u32x4*)(dstp[j] + (size_t)(dn0[j] + n2) * dK[j] + dk0[j] + c * 8) = o;
    }
    __syncthreads();
}

__device__ __forceinline__ void phase_prologue(const Params& P, float* lds) {
    const int tid = phase_tid(), bid = blockIdx.x, nb = gridDim.x;
    unsigned char* ws = P.ws;
    for (int u0 = bid; u0 < 896; u0 += 4 * nb) convert_batch(P, lds, u0, nb, 896);
    for (int u = bid; u < 192; u += nb) {
        const int l = u / 96, n0 = (u % 96) * 64;
        float* sc = lds;
        float* red = lds + 3072;
        for (int i = tid; i < 3072; i += NT) { int c = i >> 10, k = i & 1023; float x = (c == 0) ? inp(P, 9)[k] : inp(P, 8)[(c - 1) * 1024 + k]; sc[i] = siluf(x); }
        __syncthreads();
        const int kg = tid >> 4, nc = tid & 15;
        const float* W = inp(P, 10) + (size_t)l * 1024 * 6144 + n0 + nc * 4;
        f32x4 a0 = {0, 0, 0, 0}, a1 = a0, a2 = a0;
#pragma unroll 4
        for (int k = kg * 32; k < kg * 32 + 32; ++k) {
            const f32x4 w = *(const f32x4*)(W + (size_t)k * 6144);
            a0 += w * sc[k]; a1 += w * sc[1024 + k]; a2 += w * sc[2048 + k];
        }
        *(f32x4*)(red + (kg * 3 + 0) * 64 + nc * 4) = a0;
        *(f32x4*)(red + (kg * 3 + 1) * 64 + nc * 4) = a1;
        *(f32x4*)(red + (kg * 3 + 2) * 64 + nc * 4) = a2;
        __syncthreads();
        if (tid < 192) {
            const int c = tid >> 6, n = tid & 63; float s = 0.f;
            for (int g = 0; g < 32; ++g) s += red[(g * 3 + c) * 64 + n];
            s += inp(P, 11)[l * 6144 + n0 + n];
            ((float*)(ws + WS_MOD))[(l * 3 + c) * 6144 + n0 + n] = s;
        }
        __syncthreads();
    }
    for (int u = bid; u < 2 * 128; u += nb) {
        const int which = u / 128, chunk = u % 128;
        const float* src = inp(P, which ? 6 : 3);
        bf16_t* dst = (bf16_t*)(ws + (which ? WS_CKD : WS_CKN));
        const int e = chunk * 4096 + tid * 8;
        const int c = e & 255, key = (e >> 8) & 511, b = (e >> 17) & 1, layer = e >> 18;
        const float* s = src + ((size_t)((b * 2 + layer) * 512 + key)) * 256 + c;
        const f32x4 x0 = *(const f32x4*)s, x1 = *(const f32x4*)(s + 4);
        u32x4 o; o.x = pack_bf16(x0[0], x0[1]); o.y = pack_bf16(x0[2], x0[3]); o.z = pack_bf16(x1[0], x1[1]); o.w = pack_bf16(x1[2], x1[3]);
        *(u32x4*)(dst + e) = o;
    }
    for (int u = bid; u < 2 * 128; u += nb) {
        const int which = u / 128; int v = u % 128; const int kb = v & 7; v >>= 3; const int h = v & 3; v >>= 2; const int b = v & 1, layer = v >> 1;
        const float* src = inp(P, which ? 7 : 4) + ((size_t)((b * 2 + layer) * 512 + kb * 64)) * 256 + h * 64;
        bf16_t* dst = (bf16_t*)(ws + (which ? WS_CVTD : WS_CVTN)) + ((size_t)((layer * 2 + b) * 4 + h) * 64) * 512 + kb * 64;
        const int dd = tid & 63;
#pragma unroll
        for (int i = 0; i < 8; ++i) { const int key = (tid >> 6) + 8 * i; lds[dd * 65 + key] = src[(size_t)key * 256 + dd]; }
        __syncthreads();
        { const int d2 = tid >> 3, c = tid & 7; const float* s = lds + d2 * 65 + c * 8;
          u32x4 o; o.x = pack_bf16(s[0], s[1]); o.y = pack_bf16(s[2], s[3]); o.z = pack_bf16(s[4], s[5]); o.w = pack_bf16(s[6], s[7]);
          *(u32x4*)(dst + (size_t)d2 * 512 + c * 8) = o; }
        __syncthreads();
    }
    for (int e = bid * NT + tid; e < 196608; e += nb * NT) {
        bf16_t* dst = (bf16_t*)(ws + WS_LORA);
        float v;
        if (e < 131072) { const int which = e >> 16, r = e & 65535, i = r & 63, c = (r >> 6) & 255, ld = r >> 14;
            v = inp(P, which ? 29 : 27)[((size_t)ld * 64 + i) * 256 + c]; }
        else { const int r = e - 131072, i = r & 127, c = (r >> 7) & 255, l = r >> 15;
            v = inp(P, 30)[((size_t)l * 128 + i) * 256 + c]; }
        dst[e] = f2bf(v);
    }
    if (bid == 0 && tid < 512) {
        const int p = tid >> 3, f = tid & 7;
        float t = 1.f;
        t = (f == 1) ? 0.31622776601683794f : t; t = (f == 2) ? 0.1f : t; t = (f == 3) ? 0.031622776601683794f : t; t = (f == 4) ? 0.01f : t;
        t = (f == 5) ? 0.0031622776601683794f : t; t = (f == 6) ? 0.001f : t; t = (f == 7) ? 0.00031622776601683794f : t;
        double x = (double)t, x2 = x * x;
        double c = 1.0, s = x, tc = 1.0, tsn = x;
        for (int i = 1; i < 12; ++i) { tc *= -x2 / ((2.0 * i - 1.0) * (2.0 * i)); tsn *= -x2 / ((2.0 * i) * (2.0 * i + 1.0)); c += tc; s += tsn; }
        double cr = 1.0, sr = 0.0;
        for (int i = 0; i < p; ++i) { const double nc2 = cr * c - sr * s, ns2 = sr * c + cr * s; cr = nc2; sr = ns2; }
        float* R = (float*)(ws + WS_ROPE);
        R[(p * 8 + f) * 2 + 0] = (float)cr; R[(p * 8 + f) * 2 + 1] = (float)sr;
    }
}

__device__ __forceinline__ void phase_norm(const Params& P, int layer, int which, bool from_inputs, bool add_part, int glayer, int goff, bool do_norm, int rbase_blk) {
    const int tid = phase_tid(), lane = tid & 63, w = __builtin_amdgcn_readfirstlane(tid >> 6);
    unsigned char* ws = opaque_ws(P);
    float* OUT = outp(P);
    const float* X0 = inp(P, 0); const float* X1 = inp(P, 1);
    const float* gvec = inp(P, which ? 13 : 12) + layer * 1024;
    const float* modl = (const float*)(ws + WS_MOD) + (size_t)layer * 3 * 6144;
    const float* modg = (const float*)(ws + WS_MOD) + (size_t)glayer * 3 * 6144 + goff;
    const bf16_t* P0 = (const bf16_t*)(ws + WS_PART); const bf16_t* P1 = P0 + (size_t)MTOK * 1024;
    bf16_t* HN = (bf16_t*)(ws + WS_HN);
    const __amdgpu_buffer_rsrc_t rsO = wt_rsrc(OUT, (unsigned)MTOK * 1024 * 4), rsH = wt_rsrc(HN, (unsigned)MTOK * 1024 * 2);
    constexpr int RPW = MTOK / (256 * 8);
    static_assert(RPW == 4, "rows per wave");
    f32x4 x[RPW][4]; u32x2 p0[RPW][4], p1[RPW][4];
    const int rbase = rbase_blk + w * RPW;
#pragma unroll
    for (int r = 0; r < RPW; ++r) {
        const int row = rbase + r;
        const float* xr;
        if (!from_inputs) xr = OUT + (size_t)row * 1024; else xr = (row < CTXTOK) ? X0 + (size_t)row * 1024 : X1 + (size_t)(row - CTXTOK) * 1024;
#pragma unroll
        for (int i = 0; i < 4; ++i) { const int c = lane * 4 + 256 * i; x[r][i] = *(const f32x4*)(xr + c);
            if (add_part) { p0[r][i] = *(const u32x2*)(P0 + (size_t)row * 1024 + c); p1[r][i] = *(const u32x2*)(P1 + (size_t)row * 1024 + c); } }
    }
    auto cvp = [&](const u32x2 u) -> f32x4 { f32x4 r; r[0] = __uint_as_float(u.x << 16); r[1] = __uint_as_float(u.x & 0xffff0000u); r[2] = __uint_as_float(u.y << 16); r[3] = __uint_as_float(u.y & 0xffff0000u); return r; };
#pragma unroll
    for (int r = 0; r < RPW; ++r) {
        const int row = rbase + r;
        const int cond = (row < CTXTOK) ? 0 : 1 + ((row - CTXTOK) >> 11);
        float ss = 0.f;
#pragma unroll
        for (int i = 0; i < 4; ++i) {
            const int c = lane * 4 + 256 * i;
            if (add_part) {
                const f32x4 g = *(const f32x4*)(modg + cond * 6144 + c);
                x[r][i] += g * (cvp(p0[r][i]) + cvp(p1[r][i]));
                wt_st16(rsO, (unsigned)(((size_t)row * 1024 + c) * 4), __builtin_bit_cast(u32x4, x[r][i]));
            }
            ss += x[r][i][0] * x[r][i][0] + x[r][i][1] * x[r][i][1] + x[r][i][2] * x[r][i][2] + x[r][i][3] * x[r][i][3];
        }
        if (do_norm) {
            const float* sh = modl + cond * 6144 + (which ? 3072 : 0);
            const float* sc = sh + 1024;
            ss = allsum64(ss);
            const float rs = __builtin_amdgcn_rsqf(ss * (1.f / 1024.f) + 1e-6f);
#pragma unroll
            for (int i = 0; i < 4; ++i) {
                const int c = lane * 4 + 256 * i;
                const f32x4 g = *(const f32x4*)(gvec + c), s1 = *(const f32x4*)(sc + c), s0 = *(const f32x4*)(sh + c);
                f32x4 o = x[r][i] * rs * g * (s1 + 1.f) + s0;
                u32x2 pk; pk.x = pack_bf16(o[0], o[1]); pk.y = pack_bf16(o[2], o[3]);
                wt_st8(rsH, (unsigned)(((size_t)row * 1024 + c) * 2), pk);
            }
        }
    }
}

constexpr int GS = 72;
__device__ __forceinline__ void premix_item(const Params& P, int layer, int it, unsigned char* ldsraw, int secmask = 7) {
    const int tid = phase_tid(), lane = tid & 63, w = __builtin_amdgcn_readfirstlane(tid >> 6);
    unsigned char* ws = opaque_ws(P);
    const int g0 = it * 32;
    const TokInfo ti = tokinfo(g0);
    const int t0 = ti.t, L = ti.L, sb = ti.seqbase;
    const bf16_t* PROJ = (const bf16_t*)(ws + WS_PROJ);
    float* lds = (float*)ldsraw;
    if (layer == 0) STAMP(4);
    if (secmask & 1) {
        const int c = tid;
        const float* cw = inp(P, 16) + (size_t)layer * 5 * 512; const float cb = inp(P, 17)[layer * 512 + c];
        float wj[5];
#pragma unroll
        for (int j = 0; j < 5; ++j) wj[j] = cw[j * 512 + c];
        bf16_t* XBC = (bf16_t*)(ws + WS_XBC);
        auto ld = [&](int t) -> float { const int tc = min(max(t, 0), L - 1); const float vv = bf2f(PROJ[(size_t)(sb + tc) * NPROJ + PC_XBC + c]); return (t == tc) ? vv : 0.f; };
        float xx[36];
#pragma unroll
        for (int i = 0; i < 36; ++i) xx[i] = ld(t0 - 2 + i);
#pragma unroll
        for (int tt = 0; tt < 32; ++tt) {
            float v = cb + xx[tt] * wj[0] + xx[tt + 1] * wj[1] + xx[tt + 2] * wj[2] + xx[tt + 3] * wj[3] + xx[tt + 4] * wj[4];
            XBC[(size_t)(g0 + tt) * 512 + c] = f2bf(siluf(v));
        }
    }
    if ((secmask & 1) && tid < 256) {
        const int tt = tid >> 3, j = tid & 7;
        const float raw = bf2f(PROJ[(size_t)(g0 + tt) * NPROJ + PC_DT + j]);
        const float dtv = softplusf_(raw + inp(P, 19)[layer * 8 + j]);
        const float Aj = -__expf(inp(P, 18)[layer * 8 + j]);
        f32x2 o; o.x = dtv; o.y = __expf(dtv * Aj);
        *(f32x2*)((float*)(ws + WS_DTA) + ((size_t)(g0 + tt) * 8 + j) * 2) = o;
    }
    if (secmask & 1) {
        bf16_t* ZS = (bf16_t*)(ws + WS_ZS);
        unsigned zu[8];
#pragma unroll
        for (int i = 0; i < 8; ++i) { const int e = tid + NT * i, tt = e >> 7, cp = (e & 127) * 2; zu[i] = *(const unsigned*)(PROJ + (size_t)(g0 + tt) * NPROJ + PC_Z + cp); }
#pragma unroll
        for (int i = 0; i < 8; ++i) {
            const int e = tid + NT * i, tt = e >> 7, cp = (e & 127) * 2;
            const float a = siluf(bf2f((unsigned short)(zu[i] & 0xffff))), b = siluf(bf2f((unsigned short)(zu[i] >> 16)));
            *(unsigned*)(ZS + (size_t)(g0 + tt) * 256 + cp) = pack_bf16(a, b);
        }
    }
    __syncthreads(); if (layer == 0) STAMP(5);
    bf16_t* VS = (bf16_t*)ldsraw;
    if (secmask & 2) {
        const int c4 = lane * 4;
        const f32x4 gq = *(const f32x4*)(inp(P, 22) + layer * 64 + (c4 & 63)), gk = *(const f32x4*)(inp(P, 23) + layer * 64 + (c4 & 63));
        const f32x4 dgq = *(const f32x4*)(inp(P, 36) + layer * 32 + (c4 & 31)), dgk = *(const f32x4*)(inp(P, 37) + layer * 32 + (c4 & 31));
        const float* ROPE = (const float*)(ws + WS_ROPE);
        auto ld4 = [&](const bf16_t* p) -> f32x4 { const u32x2 u = *(const u32x2*)p; f32x4 r; r[0] = bf2f((unsigned short)(u.x & 0xffff)); r[1] = bf2f((unsigned short)(u.x >> 16)); r[2] = bf2f((unsigned short)(u.y & 0xffff)); r[3] = bf2f((unsigned short)(u.y >> 16)); return r; };
        auto st4 = [&](bf16_t* p, f32x4 v) { u32x2 pk; pk.x = pack_bf16(v[0], v[1]); pk.y = pack_bf16(v[2], v[3]); *(u32x2*)p = pk; };
        u32x2 raw[4][6];
#pragma unroll
        for (int i = 0; i < 4; ++i) { const bf16_t* pr = PROJ + (size_t)(g0 + w * 4 + i) * NPROJ;
#pragma unroll
            for (int a = 0; a < 3; ++a) { raw[i][a] = *(const u32x2*)(pr + PC_NAT + 256 * a + c4); raw[i][3 + a] = *(const u32x2*)(pr + PC_DIFF + 256 * a + c4); } }
        auto cv4 = [&](const u32x2 u) -> f32x4 { f32x4 r; r[0] = __uint_as_float(u.x << 16); r[1] = __uint_as_float(u.x & 0xffff0000u); r[2] = __uint_as_float(u.y << 16); r[3] = __uint_as_float(u.y & 0xffff0000u); return r; };
#pragma unroll
        for (int i = 0; i < 4; ++i) {
            const int tt = w * 4 + i, g = g0 + tt, t = t0 + tt;
            {
                f32x4 q = cv4(raw[i][0]), k = cv4(raw[i][1]), v = cv4(raw[i][2]);
                float sq = allsum16(q[0] * q[0] + q[1] * q[1] + q[2] * q[2] + q[3] * q[3]);
                float sk = allsum16(k[0] * k[0] + k[1] * k[1] + k[2] * k[2] + k[3] * k[3]);
                const float rq = __builtin_amdgcn_rsqf(sq * (1.f / 64.f) + 1e-6f) * (0.125f * LOG2E), rk = __builtin_amdgcn_rsqf(sk * (1.f / 64.f) + 1e-6f);
                q = q * rq * gq; k = k * rk * gk;
                st4((bf16_t*)(ws + WS_QN) + (size_t)g * 256 + c4, q);
                st4((bf16_t*)(ws + WS_KN) + (size_t)g * 256 + c4, k);
                if (ti.isctx) {
                    const size_t o = ((size_t)((ti.sidx * 2 + layer) * 256 + t)) * 256 + c4;
                    *(f32x4*)(outp(P) + O_NATK + o) = k; *(f32x4*)(outp(P) + O_NATV + o) = v;
                }
#pragma unroll
                for (int e = 0; e < 4; ++e) VS[(c4 + e) * 40 + tt] = f2bf(v[e]);
            }
            {
                f32x4 q = cv4(raw[i][3]), k = cv4(raw[i][4]), v = cv4(raw[i][5]);
                float sq = allsum8(q[0] * q[0] + q[1] * q[1] + q[2] * q[2] + q[3] * q[3]);
                float sk = allsum8(k[0] * k[0] + k[1] * k[1] + k[2] * k[2] + k[3] * k[3]);
                const float rq = __builtin_amdgcn_rsqf(sq * (1.f / 32.f) + 1e-6f), rk = __builtin_amdgcn_rsqf(sk * (1.f / 32.f) + 1e-6f);
                q = q * rq * dgq; k = k * rk * dgk;
                if (ti.isctx) {
                    const size_t o = ((size_t)((ti.sidx * 2 + layer) * 256 + t)) * 256 + c4;
                    *(f32x4*)(outp(P) + O_DIFFK + o) = k; *(f32x4*)(outp(P) + O_DIFFV + o) = v;
                } else {
                    const int blk = (c4 >> 4) & 1, pos = blk ? (t & 63) : (t >> 6), f0 = c4 & 7;
                    const bool isu2 = (lane & 2) != 0;
                    f32x4 qp, kp;
#pragma unroll
                    for (int e = 0; e < 4; ++e) { qp[e] = dpp_mov<0x4E>(q[e]); kp[e] = dpp_mov<0x4E>(k[e]); }
#pragma unroll
                    for (int e = 0; e < 4; ++e) {
                        const f32x2 cs = *(const f32x2*)(ROPE + (pos * 8 + f0 + e) * 2);
                        const float sgn = isu2 ? cs.y : -cs.y;
                        q[e] = q[e] * cs.x + qp[e] * sgn; k[e] = k[e] * cs.x + kp[e] * sgn;
                    }
                }
                q = q * (0.17677669529663687f * LOG2E);
                st4((bf16_t*)(ws + WS_QD) + (size_t)g * 256 + c4, q);
                st4((bf16_t*)(ws + WS_KD) + (size_t)g * 256 + c4, k);
#pragma unroll
                for (int e = 0; e < 4; ++e) VS[256 * 40 + (c4 + e) * 40 + tt] = f2bf(v[e]);
            }
        }
        __syncthreads();
        {
            const int ch = tid >> 1, hf = tid & 1, h = ch >> 6, d = ch & 63;
            size_t o;
            if (ti.isctx) o = ((size_t)((ti.sidx * 4 + h) * 64 + d)) * 256 + t0 + hf * 16;
            else o = (size_t)1048576 + ((size_t)((ti.sidx * 4 + h) * 64 + d)) * 2048 + t0 + hf * 16;
#pragma unroll
            for (int a = 0; a < 2; ++a) {
                const bf16_t* s = VS + a * 256 * 40 + ch * 40 + hf * 16;
                bf16_t* dst = (bf16_t*)(ws + (a ? WS_VTD : WS_VTN)) + o;
                *(u32x4*)dst = *(const u32x4*)s; *(u32x4*)(dst + 8) = *(const u32x4*)(s + 8);
            }
        }
        __syncthreads();
    }
    if (layer == 0) STAMP(6);
    if (secmask & 28) {
        const bool doA = (secmask & 12) != 0, doB = (secmask & 20) != 0;
        float* KS = lds; float* RS = lds + 32 * 260; float* VR = lds + 2 * 32 * 260;
        bf16_t* LRb = (bf16_t*)(ldsraw + 99840);
        float* NRM = (float*)(ldsraw + 124928);
        const float* cwr = inp(P, 25) + (size_t)layer * 3 * 1152;
        auto conv_load = [&](int ch, unsigned short (&x)[34]) {
#pragma unroll
            for (int i = 0; i < 34; ++i) { const int t = t0 - 1 + i, tc = min(max(t, 0), L - 1); x[i] = PROJ[(size_t)(sb + tc) * NPROJ + PC_RW + ch]; }
        };
        auto conv_comp = [&](int ch, const unsigned short (&x)[34], float (&o)[32]) {
            const float w0 = cwr[ch], w1 = cwr[1152 + ch], w2 = cwr[2304 + ch];
            float xf[34];
#pragma unroll
            for (int i = 0; i < 34; ++i) { const int t = t0 - 1 + i; xf[i] = (t >= 0 && t < L) ? bf2f(x[i]) : 0.f; }
#pragma unroll
            for (int i = 0; i < 32; ++i) o[i] = xf[i] * w0 + xf[i + 1] * w1 + xf[i + 2] * w2;
        };
        unsigned short x1[34], x2[34];
        if (doA) { conv_load(tid, x1); conv_load(512 + tid, x2); }
        if (doA) {
            float o[32]; conv_comp(tid, x1, o);
            if (w < 4) {
#pragma unroll
                for (int i = 0; i < 32; ++i) RS[i * 260 + tid] = o[i];
            } else {
                const int c = tid - 256; const float kkc = inp(P, 31)[layer * 256 + c];
#pragma unroll
                for (int i = 0; i < 32; ++i) { KS[i * 260 + c] = o[i]; const float sv = o[i] * kkc; const float ss = wavesum64(sv * sv);
                    if (lane == 0) NRM[i * 4 + (w - 4)] = fminf(__builtin_amdgcn_rsqf(ss), 1e12f); }
            }
        }
        if (layer == 0) STAMP(13);
        if (doA) {
            float o[32]; conv_comp(512 + tid, x2, o);
            if (w < 4) {
#pragma unroll
                for (int i = 0; i < 32; ++i) VR[i * 260 + tid] = o[i];
            } else {
                const int lc = tid - 256;
#pragma unroll
                for (int i = 0; i < 32; ++i) LRb[i * 392 + lc] = f2bf(w < 6 ? tanhf_(o[i]) : o[i]);
            }
        }
        if (layer == 0) STAMP(14);
        if (doA && w < 2) {
            unsigned short x3[34]; conv_load(1024 + tid, x3); float o[32]; conv_comp(1024 + tid, x3, o);
#pragma unroll
            for (int i = 0; i < 32; ++i) LRb[i * 392 + 256 + tid] = f2bf(sigmoidf_(o[i]));
        }
        __syncthreads();
        if (layer == 0) STAMP(15);
        if (doA && w < 4) {
            const float rkc = inp(P, 33)[layer * 256 + tid];
            float* BON = (float*)(ws + WS_BON);
#pragma unroll 8
            for (int i = 0; i < 32; ++i) { const float b = wavesum64(RS[i * 260 + tid] * KS[i * 260 + tid] * rkc); if (lane == 0) BON[(size_t)(g0 + i) * 4 + w] = b; }
        }
        __syncthreads(); if (layer == 0) STAMP(7);
        const int l15 = lane & 15, quad = lane >> 4, cbase = 32 * w;
        const bf16_t* WUP = (const bf16_t*)(ws + WS_LORA);
        const bf16_t* AUP = WUP + 65536; const bf16_t* GUP = WUP + 131072;
        bf16_t* RWb = (bf16_t*)(ws + WS_RWB); float* DEC = (float*)(ws + WS_DEC);
        const f32x4 z4 = {0.f, 0.f, 0.f, 0.f};
#pragma unroll
        for (int cb = 0; cb < (doB ? 2 : 0); ++cb) {
            const int crow = cbase + cb * 16 + l15;
            bf16x8 wf[2][2], af[2][2], gf[4];
#pragma unroll
            for (int d = 0; d < 2; ++d)
#pragma unroll
                for (int ks = 0; ks < 2; ++ks) { wf[d][ks] = *(const bf16x8*)(WUP + ((size_t)((layer * 2 + d) * 256 + crow)) * 64 + ks * 32 + quad * 8);
                                                 af[d][ks] = *(const bf16x8*)(AUP + ((size_t)((layer * 2 + d) * 256 + crow)) * 64 + ks * 32 + quad * 8); }
#pragma unroll
            for (int ks = 0; ks < 4; ++ks) gf[ks] = *(const bf16x8*)(GUP + ((size_t)(layer * 256 + crow)) * 128 + ks * 32 + quad * 8);
            const int cpar = cbase + cb * 16 + 4 * quad;
            const f32x4 p_kk = *(const f32x4*)(inp(P, 31) + layer * 256 + cpar), p_ka = *(const f32x4*)(inp(P, 32) + layer * 256 + cpar);
            f32x4 p_w0[2], p_a0[2];
#pragma unroll
            for (int d = 0; d < 2; ++d) { p_w0[d] = *(const f32x4*)(inp(P, 26) + (layer * 2 + d) * 256 + cpar); p_a0[d] = *(const f32x4*)(inp(P, 28) + (layer * 2 + d) * 256 + cpar); }
#pragma unroll
            for (int tb = 0; tb < 2; ++tb) {
                f32x4 aW[2] = {z4, z4}, aA[2] = {z4, z4}, aG = z4;
                const bf16_t* lr = LRb + (tb * 16 + l15) * 392 + quad * 8;
#pragma unroll
                for (int d = 0; d < 2; ++d)
#pragma unroll
                    for (int ks = 0; ks < 2; ++ks) {
                        aW[d] = __builtin_amdgcn_mfma_f32_16x16x32_bf16(wf[d][ks], *(const bf16x8*)(lr + d * 64 + ks * 32), aW[d], 0, 0, 0);
                        aA[d] = __builtin_amdgcn_mfma_f32_16x16x32_bf16(af[d][ks], *(const bf16x8*)(lr + 128 + d * 64 + ks * 32), aA[d], 0, 0, 0);
                    }
#pragma unroll
                for (int ks = 0; ks < 4; ++ks) aG = __builtin_amdgcn_mfma_f32_16x16x32_bf16(gf[ks], *(const bf16x8*)(lr + 256 + ks * 32), aG, 0, 0, 0);
                const int t = tb * 16 + l15, c = cbase + cb * 16 + 4 * quad, head = c >> 6;
                const size_t o = (size_t)(g0 + t) * 256 + c;
                const f32x4 k4 = *(const f32x4*)(KS + t * 260 + c), r4 = *(const f32x4*)(RS + t * 260 + c), v4 = *(const f32x4*)(VR + t * 260 + c);
                const float rn = NRM[t * 4 + head];
                const f32x4 kk4 = k4 * p_kk * rn;
                const f32x4 ka4 = p_ka;
                st4bf(RWb + o, r4); st4bf(RWb + RWB + o, kk4); st4bf(RWb + 2 * RWB + o, v4); st4bf(RWb + 7 * RWB + o, aG);
#pragma unroll
                for (int d = 0; d < 2; ++d) {
                    const f32x4 w0 = p_w0[d], a0 = p_a0[d];
                    f32x4 dec, kka, kt;
#pragma unroll
                    for (int e = 0; e < 4; ++e) {
                        const float wl = -softplusf_(-(w0[e] + aW[d][e])) - 0.5f;
                        dec[e] = __expf(-__expf(wl));
                        const float a = sigmoidf_(a0[e] + aA[d][e]);
                        kt[e] = k4[e] * (1.f + (a - 1.f) * ka4[e]);
                        kka[e] = kk4[e] * a;
                    }
                    *(f32x4*)(DEC + d * RWB + o) = dec; st4bf(RWb + (3 + d) * RWB + o, kka); st4bf(RWb + (5 + d) * RWB + o, kt);
                }
            }
        }
        __syncthreads();
    }
}

typedef short bf16x4 __attribute__((ext_vector_type(4)));
#define MFMA32(a, b, c) __builtin_amdgcn_mfma_f32_16x16x32_bf16(__builtin_bit_cast(bf16x8, a), __builtin_bit_cast(bf16x8, b), c, 0, 0, 0)
#define MFMA16(a, b, c) __builtin_amdgcn_mfma_f32_16x16x16bf16_1k(__builtin_bit_cast(bf16x4, a), __builtin_bit_cast(bf16x4, b), c, 0, 0, 0)
constexpr int PREP_WLDS = 10496;
__device__ __forceinline__ void lds_barrier() { asm volatile("s_waitcnt lgkmcnt(0)" ::: "memory"); __builtin_amdgcn_s_barrier(); asm volatile("" ::: "memory"); }
struct PrepR { float dec[16]; unsigned kk[8], kka[8], kt[8], r[8]; };
struct PrepS { float dtv[16]; unsigned cv[8], bv[8]; };
__device__ __forceinline__ void prep_tile(const Params& P, int layer, int it, unsigned char* ldsraw) {
    const int tid = phase_tid(), lane = tid & 63, w = __builtin_amdgcn_readfirstlane(tid >> 6), l15 = lane & 15, q = lane >> 4;
    const int h = w >> 1, dir = w & 1, grp = h >> 1;
    unsigned char* ws = opaque_ws(P);
    unsigned char* wl = ldsraw + w * PREP_WLDS;
    bf16_t* L0 = (bf16_t*)wl; bf16_t* L1 = L0 + 16 * 72; bf16_t* L2 = L1 + 16 * 72; bf16_t* L3 = L2 + 16 * 72;
    float* NL = (float*)(wl + 9216); float* CSL = (float*)(wl + 9216 + 1024);
    const f32x4 z4 = {0.f, 0.f, 0.f, 0.f};
    const bf16_t* RWb = (const bf16_t*)(ws + WS_RWB);
    const float* DEC = (const float*)(ws + WS_DEC) + (size_t)dir * RWB;
    const bf16_t* aR = RWb, *aKK = RWb + RWB, *aKKA = RWb + (3 + dir) * RWB, *aKT = RWb + (5 + dir) * RWB;
    const bf16_t* XBC = (const bf16_t*)(ws + WS_XBC);
    const float* DTA = (const float*)(ws + WS_DTA);
    auto lo16 = [](unsigned u) -> float { return __uint_as_float(u << 16); };
    auto hi16 = [](unsigned u) -> float { return __uint_as_float(u & 0xffff0000u); };
    auto load_r = [&](int cn_g, PrepR& r) {
        const int base = cn_g * 16;
#pragma unroll
        for (int n = 0; n < 16; n += 2) {
            const size_t o0 = (size_t)(base + (dir ? 15 - n : n)) * 256 + h * 64 + lane, o1 = (size_t)(base + (dir ? 14 - n : n + 1)) * 256 + h * 64 + lane;
            r.dec[n] = DEC[o0]; r.dec[n + 1] = DEC[o1];
            r.kk[n >> 1] = (unsigned)aKK[o0] | ((unsigned)aKK[o1] << 16); r.kka[n >> 1] = (unsigned)aKKA[o0] | ((unsigned)aKKA[o1] << 16);
            r.kt[n >> 1] = (unsigned)aKT[o0] | ((unsigned)aKT[o1] << 16); r.r[n >> 1] = (unsigned)aR[o0] | ((unsigned)aR[o1] << 16);
        }
    };
    auto load_s = [&](int cn_g, PrepS& r) {
        const int base = cn_g * 16;
#pragma unroll
        for (int n = 0; n < 16; n += 2) {
            const int t0 = base + (dir ? 15 - n : n), t1 = base + (dir ? 14 - n : n + 1);
            r.dtv[n] = DTA[((size_t)t0 * 8 + dir * 4 + h) * 2]; r.dtv[n + 1] = DTA[((size_t)t1 * 8 + dir * 4 + h) * 2];
            r.cv[n >> 1] = (unsigned)XBC[(size_t)t0 * 512 + 384 + grp * 64 + lane] | ((unsigned)XBC[(size_t)t1 * 512 + 384 + grp * 64 + lane] << 16);
            r.bv[n >> 1] = (unsigned)XBC[(size_t)t0 * 512 + 256 + grp * 64 + lane] | ((unsigned)XBC[(size_t)t1 * 512 + 256 + grp * 64 + lane] << 16);
        }
    };
    auto comp_r = [&](int cn_g, const PrepR& in) {
        unsigned char* U = ws + WS_CHR + chr_unit_off(cn_g, h, dir);
        float g = 1.f;
#pragma unroll
        for (int n = 0; n < 16; ++n) { const float gp = g; g *= in.dec[n]; const float ig = frcp(g);
            const float kkf = (n & 1) ? hi16(in.kk[n >> 1]) : lo16(in.kk[n >> 1]), kkaf = (n & 1) ? hi16(in.kka[n >> 1]) : lo16(in.kka[n >> 1]);
            const float ktf = (n & 1) ? hi16(in.kt[n >> 1]) : lo16(in.kt[n >> 1]), rf = (n & 1) ? hi16(in.r[n >> 1]) : lo16(in.r[n >> 1]);
            L0[n * 72 + lane] = f2bf(kkf * gp); L1[n * 72 + lane] = f2bf(kkaf * ig);
            L2[n * 72 + lane] = f2bf(ktf * ig); L3[n * 72 + lane] = f2bf(rf * g); }
        ((float*)(U + 10240))[lane] = g;
        lds_barrier();
        f32x4 n1 = z4, n2 = z4, n3 = z4, n4 = z4;
#pragma unroll
        for (int ks = 0; ks < 2; ++ks) {
            const u32x4 fK = *(const u32x4*)(L0 + l15 * 72 + ks * 32 + q * 8), fB = *(const u32x4*)(L1 + l15 * 72 + ks * 32 + q * 8),
                        fT = *(const u32x4*)(L2 + l15 * 72 + ks * 32 + q * 8), fR = *(const u32x4*)(L3 + l15 * 72 + ks * 32 + q * 8);
            n1 = MFMA32(fB, fK, n1); n2 = MFMA32(fT, fK, n2); n3 = MFMA32(fB, fR, n3); n4 = MFMA32(fT, fR, n4);
        }
#pragma unroll
        for (int e = 0; e < 4; ++e) { const int i = 4 * q + e; const bool lt = i < l15, le = i <= l15;
            n1[e] = lt ? n1[e] : 0.f; n2[e] = lt ? n2[e] : 0.f; n3[e] = le ? -n3[e] : 0.f; n4[e] = le ? n4[e] : 0.f;
            NL[i * 16 + l15] = n1[e]; }
        { u32x2 xa; xa.x = pack_bf16(n2[0], n2[1]); xa.y = pack_bf16(n2[2], n2[3]); *(u32x2*)(U + 9728 + lane * 8) = xa;
          u32x4 ya; ya.x = pack_bf16(n3[0], n3[1]); ya.y = pack_bf16(n3[2], n3[3]); ya.z = pack_bf16(n4[0], n4[1]); ya.w = pack_bf16(n4[2], n4[3]); *(u32x4*)(U + 8192 + lane * 16) = ya; }
#pragma unroll
        for (int ks = 0; ks < 2; ++ks) {
            const u32x2 a = *(const u32x2*)(L0 + l15 * 72 + 32 * ks + 4 * q), b = *(const u32x2*)(L0 + l15 * 72 + 32 * ks + 16 + 4 * q);
            *(u32x4*)(U + ks * 1024 + lane * 16) = (u32x4){a.x, a.y, b.x, b.y};
            const u32x2 c = *(const u32x2*)(L3 + l15 * 72 + 32 * ks + 4 * q), d = *(const u32x2*)(L3 + l15 * 72 + 32 * ks + 16 + 4 * q);
            *(u32x4*)(U + 2048 + ks * 1024 + lane * 16) = (u32x4){c.x, c.y, d.x, d.y};
        }
#pragma unroll
        for (int rb = 0; rb < 4; ++rb) {
            unsigned bb[4], kk2[4];
#pragma unroll
            for (int j = 0; j < 4; ++j) { bb[j] = (unsigned)L1[(4 * q + j) * 72 + 16 * rb + l15] ^ 0x8000u; kk2[j] = (unsigned)L2[(4 * q + j) * 72 + 16 * rb + l15]; }
            *(u32x4*)(U + 4096 + rb * 1024 + lane * 16) = (u32x4){bb[0] | (bb[1] << 16), bb[2] | (bb[3] << 16), kk2[0] | (kk2[1] << 16), kk2[2] | (kk2[3] << 16)};
        }
        lds_barrier();
        float x[16];
#pragma unroll
        for (int i = 0; i < 16; ++i) x[i] = (i == l15) ? 1.f : 0.f;
#pragma unroll
        for (int i = 14; i >= 0; --i) { float sacc = 0.f;
#pragma unroll
            for (int j = i + 1; j < 16; ++j) sacc += NL[i * 16 + j] * x[j];
            x[i] = (i < l15) ? -sacc : x[i]; }
        { float m[4];
#pragma unroll
          for (int j = 0; j < 4; ++j) m[j] = (q == 0) ? x[j] : (q == 1) ? x[4 + j] : (q == 2) ? x[8 + j] : x[12 + j];
          u32x2 mi; mi.x = pack_bf16(m[0], m[1]); mi.y = pack_bf16(m[2], m[3]); *(u32x2*)(U + 9216 + lane * 8) = mi; }
        lds_barrier();
    };
    auto comp_s = [&](int cn_g, const PrepS& in) {
        const int unit = (cn_g * 4 + h) * 2 + dir;
        unsigned char* U = ws + WS_CHS + (size_t)unit * CHS_U;
        const float Ah = -__expf(inp(P, 18)[layer * 8 + dir * 4 + h]);
        float cs[16]; float c = 0.f;
#pragma unroll
        for (int n = 0; n < 16; ++n) { if (lane == 0) ((float*)(U + 4624))[n] = in.dtv[n]; c += in.dtv[n] * Ah; cs[n] = c; }
#pragma unroll
        for (int n = 0; n < 16; ++n) {
            const unsigned cu = (n & 1) ? (in.cv[n >> 1] >> 16) : (in.cv[n >> 1] & 0xffffu), bu = (n & 1) ? (in.bv[n >> 1] >> 16) : (in.bv[n >> 1] & 0xffffu);
            L0[n * 72 + lane] = (bf16_t)cu; L1[n * 72 + lane] = (bf16_t)bu;
            L2[n * 72 + lane] = f2bf(bf2f((bf16_t)cu) * __expf(cs[n])); L3[n * 72 + lane] = f2bf(bf2f((bf16_t)bu) * __expf(cs[15] - cs[n]));
            if (lane == 0) CSL[n] = cs[n]; }
        if (lane == 0) *(float*)(U + 4608) = __expf(cs[15]);
        lds_barrier();
        f32x4 gt = z4;
#pragma unroll
        for (int ks = 0; ks < 2; ++ks) gt = MFMA32(*(const u32x4*)(L1 + l15 * 72 + ks * 32 + q * 8), *(const u32x4*)(L0 + l15 * 72 + ks * 32 + q * 8), gt);
        { const float cst = CSL[l15]; float gg[4];
#pragma unroll
          for (int e = 0; e < 4; ++e) { const int i = 4 * q + e; gg[e] = (i <= l15) ? gt[e] * __expf(cst - CSL[i]) : 0.f; }
          u32x2 ga; ga.x = pack_bf16(gg[0], gg[1]); ga.y = pack_bf16(gg[2], gg[3]); *(u32x2*)(U + 2048 + lane * 8) = ga; }
#pragma unroll
        for (int ks = 0; ks < 2; ++ks) {
            const u32x2 a = *(const u32x2*)(L2 + l15 * 72 + 32 * ks + 4 * q), b = *(const u32x2*)(L2 + l15 * 72 + 32 * ks + 16 + 4 * q);
            *(u32x4*)(U + ks * 1024 + lane * 16) = (u32x4){a.x, a.y, b.x, b.y};
        }
#pragma unroll
        for (int rb = 0; rb < 4; ++rb) {
            unsigned bb[4];
#pragma unroll
            for (int j = 0; j < 4; ++j) bb[j] = (unsigned)L3[(4 * q + j) * 72 + 16 * rb + l15];
            *(u32x2*)(U + 2560 + rb * 512 + lane * 8) = (u32x2){bb[0] | (bb[1] << 16), bb[2] | (bb[3] << 16)};
        }
        lds_barrier();
    };
    PrepR ra, rb2; PrepS sa, sb2;
    load_r(2 * it, ra); load_s(2 * it, sa);
    comp_r(2 * it, ra);
    load_r(2 * it + 1, rb2);
    comp_s(2 * it, sa);
    load_s(2 * it + 1, sb2);
    comp_r(2 * it + 1, rb2);
    comp_s(2 * it + 1, sb2);
}

__device__ __forceinline__ void rwkv_cscan_item(const Params& P, int layer, int sidx_all, int h, int dir, unsigned char* ldsraw, int mode) {
    const int tid = phase_tid(), lane = tid & 63, w = __builtin_amdgcn_readfirstlane(tid >> 6), l15 = lane & 15, q = lane >> 4;
    const bool loader = w >= 4; const int vq = w & 3, ltid = tid & 255;
    const bool isctx = sidx_all < 16;
    const int L = isctx ? 256 : 2048, sb = isctx ? sidx_all * 256 : CTXTOK + (sidx_all - 16) * 2048, nch = L / 16;
    unsigned char* ws = opaque_ws(P);
    const unsigned char* CHR = ws + WS_CHR;
    const unsigned char* Vrow = ws + WS_RWB + 2 * RWB * 2 + h * 128;
    const int b = isctx ? sidx_all : sidx_all - 16;
    const int cbeg = (mode >= 2) ? nch / 2 : 0, cend = (mode == 1) ? nch / 2 : nch;
    bf16_t* Yb = (mode == 3) ? (bf16_t*)(ws + WS_QR) + (size_t)(dir * 2 + b) * 1024 * 256 : (bf16_t*)(ws + (dir ? WS_YRB : WS_YRF));
    const int yo = h * 64 + 16 * vq + l15 + (dir ? -4 * q : 4 * q) * 256, ystep = dir ? -256 : 256;
    const size_t sidx = ((size_t)(((b * 2 + layer) * 2 + dir) * 4 + h) * 64 + 16 * vq + l15) * 64;
    constexpr int D = 4, SLOT = CHR_U + 2048, NPC = 4, NPIECE = CHR_U / 16 + 128;
    int poff[NPC], plo[NPC]; bool pv[NPC], pc[NPC];
#pragma unroll
    for (int k = 0; k < NPC; ++k) { const int p = ltid + 256 * k; pv[k] = loader && p < NPIECE; pc[k] = p < 656; plo[k] = (p < 656 ? p * 16 : CHR_U + (p - 656) * 16);
        const int vr = p - 656; poff[k] = pc[k] ? p * 16 : (dir ? -(vr >> 3) : (vr >> 3)) * 512 + (vr & 7) * 16; }
    auto tokd = [&](int n) -> int { return sb + (dir ? (L - 1 - n) : n); };
    auto ytok = [&](int n) -> int { return (mode == 3) ? (dir ? (L - 1 - n) : (n - 1024)) : tokd(n); };
    auto gl = [&](int c, u32x4 (&R)[NPC]) {
        const unsigned char* bC = CHR + chr_unit_off((sb >> 4) + (dir ? nch - 1 - c : c), h, dir);
        const unsigned char* bV = Vrow + (size_t)tokd(c * 16) * 512;
#pragma unroll
        for (int k = 0; k < NPC; ++k) if (pv[k]) R[k] = *(const u32x4*)((pc[k] ? bC : bV) + poff[k]);
    };
    auto st = [&](int slot, const u32x4 (&R)[NPC]) {
#pragma unroll
        for (int k = 0; k < NPC; ++k) if (pv[k]) *(u32x4*)(ldsraw + slot * SLOT + plo[k]) = R[k];
    };
    struct Ops { u32x4 kp0, kp1, su0, su1, su2, su3; u32x2 mi, xa, vb; f32x4 g0, g1, g2, g3; };
    struct YOps { u32x4 rp0, rp1, ya; };
    constexpr int HBOFF = 3 * SLOT;
    auto hb_ptr = [&](int c) -> unsigned char* { return ldsraw + HBOFF + (((c & 1) * 4 + vq) * 64 + lane) * 48; };
    auto lds_ops = [&](int slot) -> Ops {
        const unsigned char* U = ldsraw + slot * SLOT; Ops o;
        o.kp0 = *(const u32x4*)(U + lane * 16); o.kp1 = *(const u32x4*)(U + 1024 + lane * 16);
        o.su0 = *(const u32x4*)(U + 4096 + lane * 16); o.su1 = *(const u32x4*)(U + 5120 + lane * 16); o.su2 = *(const u32x4*)(U + 6144 + lane * 16); o.su3 = *(const u32x4*)(U + 7168 + lane * 16);
        o.mi = *(const u32x2*)(U + 9216 + lane * 8); o.xa = *(const u32x2*)(U + 9728 + lane * 8);
        const float* gt = (const float*)(U + 10240) + 4 * q;
        o.g0 = *(const f32x4*)gt; o.g1 = *(const f32x4*)(gt + 16); o.g2 = *(const f32x4*)(gt + 32); o.g3 = *(const f32x4*)(gt + 48);
        const bf16_t* vl = (const bf16_t*)(U + CHR_U) + (4 * q) * 64 + 16 * vq + l15;
        o.vb.x = (unsigned)vl[0] | ((unsigned)vl[64] << 16); o.vb.y = (unsigned)vl[128] | ((unsigned)vl[192] << 16);
        if (mode == 3) { o.vb.x = 0u; o.vb.y = 0u; }
        return o;
    };
    f32x4 Z[4];
#pragma unroll
    for (int rb = 0; rb < 4; ++rb) {
        if (isctx || loader || mode == 2) Z[rb] = (f32x4){0.f, 0.f, 0.f, 0.f};
        else if (mode == 3) { for (int e = 0; e < 4; ++e) Z[rb][e] = (16 * rb + 4 * q + e == 16 * vq + l15) ? 1.f : 0.f; }
        else Z[rb] = *(const f32x4*)(inp(P, 5) + sidx + 16 * rb + 4 * q);
    }
    const f32x4 z4 = {0.f, 0.f, 0.f, 0.f};
    auto compute = [&](int c, const Ops& o) {
        u32x4 zb0, zb1;
        zb0.x = pack_bf16(Z[0][0], Z[0][1]); zb0.y = pack_bf16(Z[0][2], Z[0][3]); zb0.z = pack_bf16(Z[1][0], Z[1][1]); zb0.w = pack_bf16(Z[1][2], Z[1][3]);
        zb1.x = pack_bf16(Z[2][0], Z[2][1]); zb1.y = pack_bf16(Z[2][2], Z[2][3]); zb1.z = pack_bf16(Z[3][0], Z[3][1]); zb1.w = pack_bf16(Z[3][2], Z[3][3]);
        f32x4 X = MFMA16(o.xa, o.vb, z4); X = MFMA32(o.kp0, zb0, X); X = MFMA32(o.kp1, zb1, X);
        u32x2 xb; xb.x = pack_bf16(X[0], X[1]); xb.y = pack_bf16(X[2], X[3]);
        const f32x4 Uv = MFMA16(o.mi, xb, z4);
        u32x4 uv; uv.x = pack_bf16(Uv[0], Uv[1]); uv.y = pack_bf16(Uv[2], Uv[3]); uv.z = o.vb.x; uv.w = o.vb.y;
        Z[0] = MFMA32(o.su0, uv, Z[0]) * o.g0; Z[1] = MFMA32(o.su1, uv, Z[1]) * o.g1; Z[2] = MFMA32(o.su2, uv, Z[2]) * o.g2; Z[3] = MFMA32(o.su3, uv, Z[3]) * o.g3;
        { unsigned char* hb = hb_ptr(c); *(u32x4*)hb = zb0; *(u32x4*)(hb + 16) = zb1; *(u32x4*)(hb + 32) = uv; }
    };
    auto y_ops = [&](int slot) -> YOps { const unsigned char* U = ldsraw + slot * SLOT; YOps o;
        o.rp0 = *(const u32x4*)(U + 2048 + lane * 16); o.rp1 = *(const u32x4*)(U + 3072 + lane * 16); o.ya = *(const u32x4*)(U + 8192 + lane * 16); return o; };
    auto y_chunk = [&](int c, const YOps& o) {
        const unsigned char* hb = hb_ptr(c);
        const u32x4 zb0 = *(const u32x4*)hb, zb1 = *(const u32x4*)(hb + 16), uv = *(const u32x4*)(hb + 32);
        f32x4 Yv = MFMA32(o.rp0, zb0, z4); Yv = MFMA32(o.rp1, zb1, Yv); Yv = MFMA32(o.ya, uv, Yv);
        bf16_t* Yc = Yb + (size_t)ytok(c * 16) * 256;
#pragma unroll
        for (int e = 0; e < 4; ++e) Yc[yo + e * ystep] = f2bf(Yv[e]);
    };
    if (loader) {
        u32x4 R[D][NPC];
        gl(cbeg, R[0]); gl(cbeg + 1, R[1]); st(cbeg % 3, R[0]); st((cbeg + 1) % 3, R[1]);
#pragma unroll
        for (int k = 0; k < D; ++k) if (cbeg + k + 2 < cend) gl(cbeg + k + 2, R[k]);
        __syncthreads();
        YOps yo_prev, yo_cur = y_ops(cbeg % 3);
        for (int c0 = cbeg; c0 < cend; c0 += D) {
#pragma unroll
            for (int k = 0; k < D; ++k) {
                const int c = c0 + k;
                if (c > cbeg) y_chunk(c - 1, yo_prev);
                yo_prev = yo_cur;
                if (c + 1 < cend) yo_cur = y_ops((c + 1) % 3);
                if (c + 2 < cend) st((c + 2) % 3, R[k]);
                if (c + 2 + D < cend) gl(c + 2 + D, R[k]);
                lds_barrier();
            }
        }
        y_chunk(cend - 1, yo_prev);
    } else {
        __syncthreads();
        Ops cur = lds_ops(cbeg % 3);
        for (int c = cbeg; c < cend; ++c) {
            Ops nxt = cur;
            if (c + 1 < cend) nxt = lds_ops((c + 1) % 3);
            compute(c, cur);
            cur = nxt;
            lds_barrier();
        }
    }
    if (isctx && !loader) {
        float* So = outp(P) + O_RWKV + sidx;
#pragma unroll
        for (int rb = 0; rb < 4; ++rb) *(f32x4*)(So + 16 * rb + 4 * q) = Z[rb];
    }
    if (mode == 1 && !loader) {
        bf16_t* Zm = (bf16_t*)(ws + WS_ZMR) + (size_t)((b * 4 + h) * 2 + dir) * 4096 + (16 * vq + l15) * 64 + 4 * q;
#pragma unroll
        for (int rb = 0; rb < 4; ++rb) st4bf(Zm + 16 * rb, Z[rb]);
    }
}

__device__ __forceinline__ void ssd_cscan_item(const Params& P, int layer, int sidx_all, int h, int dir, unsigned char* ldsraw, int mode) {
    const int tid = phase_tid(), lane = tid & 63, w = __builtin_amdgcn_readfirstlane(tid >> 6), l15 = lane & 15, q = lane >> 4;
    const bool loader = w >= 4; const int pq = w & 3, ltid = tid & 255;
    const bool isctx = sidx_all < 16;
    const int L = isctx ? 256 : 2048, sb = isctx ? sidx_all * 256 : CTXTOK + (sidx_all - 16) * 2048, nch = L / 16;
    unsigned char* ws = opaque_ws(P);
    const unsigned char* CHS = ws + WS_CHS;
    const unsigned char* Xrow = ws + WS_XBC + h * 128;
    const int b = isctx ? sidx_all : sidx_all - 16;
    const int cbeg = (mode >= 2) ? nch / 2 : 0, cend = (mode == 1) ? nch / 2 : nch;
    bf16_t* Yb = (mode == 3) ? (bf16_t*)(ws + WS_QS) + (size_t)(dir * 2 + b) * 1024 * 256 : (bf16_t*)(ws + (dir ? WS_YSB : WS_YSF));
    const int yo = h * 64 + 16 * pq + l15 + (dir ? -4 * q : 4 * q) * 256, ystep = dir ? -256 : 256;
    const size_t sidx = ((size_t)(((b * 2 + layer) * 2 + dir) * 4 + h) * 64 + 16 * pq + l15) * 64;
    constexpr int D = 8, SLOT = CHS_U + 2048, NPC = 2, UP = CHS_U / 16, NPIECE = UP + 128;
    int poff[NPC], plo[NPC]; bool pv[NPC], pc[NPC];
#pragma unroll
    for (int k = 0; k < NPC; ++k) { const int p = ltid + 256 * k; pv[k] = loader && p < NPIECE; pc[k] = p < UP; plo[k] = (p < UP ? p * 16 : CHS_U + (p - UP) * 16);
        const int vr = p - UP; poff[k] = pc[k] ? p * 16 : (dir ? -(vr >> 3) : (vr >> 3)) * 1024 + (vr & 7) * 16; }
    auto tokd = [&](int n) -> int { return sb + (dir ? (L - 1 - n) : n); };
    auto ytok = [&](int n) -> int { return (mode == 3) ? (dir ? (L - 1 - n) : (n - 1024)) : tokd(n); };
    auto gl = [&](int c, u32x4 (&R)[NPC]) {
        const unsigned char* bC = CHS + (size_t)((((sb >> 4) + (dir ? nch - 1 - c : c)) * 4 + h) * 2 + dir) * CHS_U;
        const unsigned char* bV = Xrow + (size_t)tokd(c * 16) * 1024;
#pragma unroll
        for (int k = 0; k < NPC; ++k) if (pv[k]) R[k] = *(const u32x4*)((pc[k] ? bC : bV) + poff[k]);
    };
    auto st = [&](int slot, const u32x4 (&R)[NPC]) {
#pragma unroll
        for (int k = 0; k < NPC; ++k) if (pv[k]) *(u32x4*)(ldsraw + slot * SLOT + plo[k]) = R[k];
    };
    struct Ops { u32x4 cp0, cp1; u32x2 ga, bu0, bu1, bu2, bu3, xb; float aT; };
    auto lds_ops = [&](int slot) -> Ops {
        const unsigned char* U = ldsraw + slot * SLOT; Ops o;
        o.cp0 = *(const u32x4*)(U + lane * 16); o.cp1 = *(const u32x4*)(U + 1024 + lane * 16);
        o.ga = *(const u32x2*)(U + 2048 + lane * 8); o.bu0 = *(const u32x2*)(U + 2560 + lane * 8); o.bu1 = *(const u32x2*)(U + 3072 + lane * 8); o.bu2 = *(const u32x2*)(U + 3584 + lane * 8); o.bu3 = *(const u32x2*)(U + 4096 + lane * 8);
        o.aT = *(const float*)(U + 4608);
        const f32x4 dt4 = *(const f32x4*)(U + 4624 + 16 * q);
        const bf16_t* xl = (const bf16_t*)(U + CHS_U) + (4 * q) * 64 + 16 * pq + l15;
        o.xb.x = pack_bf16(bf2f(xl[0]) * dt4[0], bf2f(xl[64]) * dt4[1]); o.xb.y = pack_bf16(bf2f(xl[128]) * dt4[2], bf2f(xl[192]) * dt4[3]);
        if (mode == 3) { o.xb.x = 0u; o.xb.y = 0u; }
        return o;
    };
    f32x4 Wt[4];
#pragma unroll
    for (int rb = 0; rb < 4; ++rb) {
        if (isctx || loader || mode == 2) Wt[rb] = (f32x4){0.f, 0.f, 0.f, 0.f};
        else if (mode == 3) { for (int e = 0; e < 4; ++e) Wt[rb][e] = (16 * rb + 4 * q + e == 16 * pq + l15) ? 1.f : 0.f; }
        else Wt[rb] = *(const f32x4*)(inp(P, 2) + sidx + 16 * rb + 4 * q);
    }
    const f32x4 z4 = {0.f, 0.f, 0.f, 0.f};
    auto compute = [&](int c, const Ops& o) {
        u32x4 wb0, wb1;
        wb0.x = pack_bf16(Wt[0][0], Wt[0][1]); wb0.y = pack_bf16(Wt[0][2], Wt[0][3]); wb0.z = pack_bf16(Wt[1][0], Wt[1][1]); wb0.w = pack_bf16(Wt[1][2], Wt[1][3]);
        wb1.x = pack_bf16(Wt[2][0], Wt[2][1]); wb1.y = pack_bf16(Wt[2][2], Wt[2][3]); wb1.z = pack_bf16(Wt[3][0], Wt[3][1]); wb1.w = pack_bf16(Wt[3][2], Wt[3][3]);
        Wt[0] = MFMA16(o.bu0, o.xb, Wt[0] * o.aT); Wt[1] = MFMA16(o.bu1, o.xb, Wt[1] * o.aT); Wt[2] = MFMA16(o.bu2, o.xb, Wt[2] * o.aT); Wt[3] = MFMA16(o.bu3, o.xb, Wt[3] * o.aT);
        f32x4 Yv = MFMA16(o.ga, o.xb, z4); Yv = MFMA32(o.cp0, wb0, Yv); Yv = MFMA32(o.cp1, wb1, Yv);
        bf16_t* Yc = Yb + (size_t)ytok(c * 16) * 256;
#pragma unroll
        for (int e = 0; e < 4; ++e) Yc[yo + e * ystep] = f2bf(Yv[e]);
    };
    if (loader) {
        u32x4 R[D][NPC];
        gl(cbeg, R[0]); gl(cbeg + 1, R[1]); st(cbeg % 3, R[0]); st((cbeg + 1) % 3, R[1]);
#pragma unroll
        for (int k = 0; k < D; ++k) if (cbeg + k + 2 < cend) gl(cbeg + k + 2, R[k]);
        __syncthreads();
        for (int c0 = cbeg; c0 < cend; c0 += D) {
#pragma unroll
            for (int k = 0; k < D; ++k) {
                const int c = c0 + k;
                if (c + 2 < cend) st((c + 2) % 3, R[k]);
                if (c + 2 + D < cend) gl(c + 2 + D, R[k]);
                lds_barrier();
            }
        }
    } else {
        __syncthreads();
        Ops cur = lds_ops(cbeg % 3);
        for (int c = cbeg; c < cend; ++c) {
            Ops nxt = cur;
            if (c + 1 < cend) nxt = lds_ops((c + 1) % 3);
            compute(c, cur);
            cur = nxt;
            lds_barrier();
        }
    }
    if (isctx && !loader) {
        float* So = outp(P) + O_SSD + sidx;
#pragma unroll
        for (int rb = 0; rb < 4; ++rb) *(f32x4*)(So + 16 * rb + 4 * q) = Wt[rb];
    }
    if (mode == 1 && !loader) {
        bf16_t* Wm = (bf16_t*)(ws + WS_ZMS) + (size_t)((b * 4 + h) * 2 + dir) * 4096 + (16 * pq + l15) * 64 + 4 * q;
#pragma unroll
        for (int rb = 0; rb < 4; ++rb) st4bf(Wm + 16 * rb, Wt[rb]);
    }
}

template <int MODE>
__device__ __forceinline__ void attn_item(const Params& P, int layer, int idx, unsigned char* ldsraw) {
    constexpr bool DIFF = MODE >= 2, LAT = (MODE & 1) != 0;
    const int tid = phase_tid(), lane = tid & 63, w = __builtin_amdgcn_readfirstlane(tid >> 6), l15 = lane & 15, quad = lane >> 4;
    unsigned char* ws = opaque_ws(P);
    int sidx, h, qb;
    if (LAT) { qb = idx & 15; h = (idx >> 4) & 3; sidx = idx >> 6; }
    else { qb = idx & 1; h = (idx >> 1) & 3; sidx = idx >> 3; }
    const int sb = LAT ? CTXTOK + sidx * 2048 : sidx * 256;
    const int Lseq = LAT ? 2048 : 256;
    const bf16_t* Q = (const bf16_t*)(ws + (DIFF ? WS_QD : WS_QN));
    const bf16_t* KX = (const bf16_t*)(ws + (DIFF ? WS_KD : WS_KN));
    const bf16_t* VT = (const bf16_t*)(ws + (DIFF ? WS_VTD : WS_VTN));
    const bf16_t* CK = (const bf16_t*)(ws + (DIFF ? WS_CKD : WS_CKN));
    const bf16_t* CVT = (const bf16_t*)(ws + (DIFF ? WS_CVTD : WS_CVTN));
    bf16_t* MIX = (bf16_t*)(ws + WS_HN);
    bf16_t* lds = (bf16_t*)ldsraw;
    constexpr int TS = 64 * GS;
    float* RB = (float*)(ldsraw + 4 * TS * 2);
    int base0 = 0, nlat = 0;
    if (MODE == 1) { const int r0 = 2 * qb; const int b0 = min(max(r0 - 4, 0), 24), b1 = min(max(r0 - 3, 0), 24); base0 = b0; nlat = b1 + 8 - b0;
        for (int i = tid; i < 465; i += NT) RB[i] = inp(P, 24)[((size_t)(layer * 4 + h)) * 465 + i] * LOG2E; }
    const int ntiles = (MODE == 0 || MODE == 2) ? 4 : (MODE == 1 ? 8 + nlat : 40);
    const int qt = qb * 128 + w * 16;
    const bf16_t* qp = Q + (size_t)(sb + qt + l15) * 256 + h * 64 + quad * 8;
    const bf16x8 qf0 = *(const bf16x8*)qp, qf1 = *(const bf16x8*)(qp + 32);
    const int lrow = tid >> 3, lpc = tid & 7;
    constexpr int PF = 3;
    u32x4 rk[PF], rv[PF];
    auto gload = [&](int i, u32x4& k_, u32x4& v_) {
        const bf16_t* kp; const bf16_t* vp;
        if (!LAT) { kp = KX + (size_t)(sb + 64 * i + lrow) * 256 + h * 64; vp = VT + ((size_t)((sidx * 4 + h) * 64 + lrow)) * 256 + 64 * i; }
        else if (i < 8) { kp = CK + ((size_t)((layer * 2 + sidx) * 512 + 64 * i + lrow)) * 256 + h * 64; vp = CVT + ((size_t)(((layer * 2 + sidx) * 4 + h) * 64 + lrow)) * 512 + 64 * i; }
        else { const int kr = (MODE == 1) ? base0 + (i - 8) : (i - 8);
            kp = KX + (size_t)(sb + 64 * kr + lrow) * 256 + h * 64; vp = VT + (size_t)1048576 + ((size_t)((sidx * 4 + h) * 64 + lrow)) * 2048 + 64 * kr; }
        k_ = *(const u32x4*)(kp + lpc * 8); v_ = *(const u32x4*)(vp + lpc * 8);
    };
    auto sstore = [&](int st, const u32x4& k_, const u32x4& v_) { *(u32x4*)(lds + st * 2 * TS + lrow * GS + lpc * 8) = k_; *(u32x4*)(lds + st * 2 * TS + TS + lrow * GS + lpc * 8) = v_; };
    constexpr float CREF = DIFF ? 10.f : 14.f;
    float lA = 0.f, lB = 0.f;
    f32x4 oA[4], oB[4];
#pragma unroll
    for (int i = 0; i < 4; ++i) { oA[i] = (f32x4){0.f, 0.f, 0.f, 0.f}; oB[i] = oA[i]; }
    const int qr = qt >> 6, qc = (qt & 63) + l15;
    const int qbase = min(max(qr - 4, 0), 24), cs = min(max(qc - 8, 0), 48);
    const f32x4 cinit = {-CREF, -CREF, -CREF, -CREF};
    gload(0, rk[0], rv[0]); sstore(0, rk[0], rv[0]);
#pragma unroll
    for (int k = 0; k < PF; ++k) if (k + 1 < ntiles) gload(k + 1, rk[k], rv[k]);
    __syncthreads();
    for (int i0 = 0; i0 < ntiles; i0 += PF) {
#pragma unroll
      for (int kq = 0; kq < PF; ++kq) {
        const int i = i0 + kq;
        if (i >= ntiles) break;
        const bool more = i + 1 < ntiles;
        const bf16_t* Ks = lds + (i & 1) * 2 * TS; const bf16_t* Vs = Ks + TS;
        bool active = true; int kr = 0;
        if (MODE == 1 && i >= 8) { kr = base0 + (i - 8); active = (kr >= qbase) && (kr < qbase + 8); }
        if (active) {
            f32x4 sA[4], sB[4];
#pragma unroll
            for (int g = 0; g < 4; ++g) {
                const bf16x8 kf0 = *(const bf16x8*)(Ks + (16 * g + l15) * GS + quad * 8), kf1 = *(const bf16x8*)(Ks + (16 * g + l15) * GS + 32 + quad * 8);
                sA[g] = __builtin_amdgcn_mfma_f32_16x16x32_bf16(kf0, qf0, cinit, 0, 0, 0);
                if (DIFF) sB[g] = __builtin_amdgcn_mfma_f32_16x16x32_bf16(kf1, qf1, cinit, 0, 0, 0);
                else sA[g] = __builtin_amdgcn_mfma_f32_16x16x32_bf16(kf1, qf1, sA[g], 0, 0, 0);
            }
            if (MODE == 1 && i >= 8) {
                const float* rb = RB + (kr - qr + 7) * 31 + 15 - qc;
#pragma unroll
                for (int g = 0; g < 4; ++g)
#pragma unroll
                    for (int r = 0; r < 4; ++r) { const int kc = 16 * g + 4 * quad + r; const bool ok = (kc >= cs) && (kc < cs + 16);
                        sA[g][r] = ok ? sA[g][r] + rb[ok ? kc : qc] : -INFINITY; }
            }
            u32x2 pA[4], pB[4];
#pragma unroll
            for (int g = 0; g < 4; ++g) { f32x4 p; for (int r = 0; r < 4; ++r) { p[r] = __builtin_amdgcn_exp2f(sA[g][r]); lA += p[r]; } pA[g].x = pack_bf16(p[0], p[1]); pA[g].y = pack_bf16(p[2], p[3]); }
            if (DIFF) {
#pragma unroll
                for (int g = 0; g < 4; ++g) { f32x4 p; for (int r = 0; r < 4; ++r) { p[r] = __builtin_amdgcn_exp2f(sB[g][r]); lB += p[r]; } pB[g].x = pack_bf16(p[0], p[1]); pB[g].y = pack_bf16(p[2], p[3]); }
            }
#pragma unroll
            for (int kk = 0; kk < 2; ++kk) {
                u32x4 pfa; pfa.x = pA[2 * kk].x; pfa.y = pA[2 * kk].y; pfa.z = pA[2 * kk + 1].x; pfa.w = pA[2 * kk + 1].y;
                u32x4 pfb; if (DIFF) { pfb.x = pB[2 * kk].x; pfb.y = pB[2 * kk].y; pfb.z = pB[2 * kk + 1].x; pfb.w = pB[2 * kk + 1].y; }
#pragma unroll
                for (int db = 0; db < 4; ++db) {
                    const bf16_t* vp = Vs + (16 * db + l15) * GS + 32 * kk + 4 * quad;
                    const u32x2 v0 = *(const u32x2*)vp, v1 = *(const u32x2*)(vp + 16);
                    u32x4 vf; vf.x = v0.x; vf.y = v0.y; vf.z = v1.x; vf.w = v1.y;
                    oA[db] = __builtin_amdgcn_mfma_f32_16x16x32_bf16(__builtin_bit_cast(bf16x8, vf), __builtin_bit_cast(bf16x8, pfa), oA[db], 0, 0, 0);
                    if (DIFF) oB[db] = __builtin_amdgcn_mfma_f32_16x16x32_bf16(__builtin_bit_cast(bf16x8, vf), __builtin_bit_cast(bf16x8, pfb), oB[db], 0, 0, 0);
                }
            }
        }
        if (more) sstore((i + 1) & 1, rk[kq], rv[kq]);
        if (i + 1 + PF < ntiles) gload(i + 1 + PF, rk[kq], rv[kq]);
        lds_barrier();
      }
    }
    const float iA = 1.f / allsum_q(lA);
    bf16_t* op = MIX + (size_t)(sb + qt + l15) * 1024 + (DIFF ? 768 : 256) + h * 64 + quad * 4;
    if (!DIFF) {
#pragma unroll
        for (int db = 0; db < 4; ++db) { const f32x4 o = oA[db] * iA; u32x2 pk; pk.x = pack_bf16(o[0], o[1]); pk.y = pack_bf16(o[2], o[3]); *(u32x2*)(op + 16 * db) = pk; }
    } else {
        const float iB = 1.f / allsum_q(lB);
        float la_ = 0.f, lb_ = 0.f;
        if (lane < 32) { const float* lv = inp(P, 38) + layer * 128; la_ = lv[lane] * lv[32 + lane]; lb_ = lv[64 + lane] * lv[96 + lane]; }
        la_ = allsum64(la_); lb_ = allsum64(lb_);
        const float lam_init = layer == 0 ? 0.2f : (0.8f - 0.6f * 0.7408182206817179f);
        const float lam = __expf(la_) - __expf(lb_) + lam_init;
        f32x4 o[4]; float ssq = 0.f;
#pragma unroll
        for (int db = 0; db < 4; ++db) { o[db] = oA[db] * iA - oB[db] * (iB * lam); ssq += o[db][0] * o[db][0] + o[db][1] * o[db][1] + o[db][2] * o[db][2] + o[db][3] * o[db][3]; }
        ssq = allsum_q(ssq);
        const float rs = __builtin_amdgcn_rsqf(ssq * (1.f / 64.f) + 1e-6f) * (1.f - lam_init);
#pragma unroll
        for (int db = 0; db < 4; ++db) { const f32x4 g = *(const f32x4*)(inp(P, 39) + layer * 64 + 16 * db + quad * 4); const f32x4 r = o[db] * rs * g;
            u32x2 pk; pk.x = pack_bf16(r[0], r[1]); pk.y = pack_bf16(r[2], r[3]); *(u32x2*)(op + 16 * db) = pk; }
    }
    __syncthreads();
}

__device__ __forceinline__ unsigned xb_xcc_id();
__device__ __forceinline__ void mix_run_item(const Params& P, int layer, int x, int j, unsigned char* ldsraw) {
    if (j < 4) { const int gi = x * 4 + j;
        if (gi < 16) rwkv_cscan_item(P, layer, 16 + (gi >> 3), (gi >> 1) & 3, gi & 1, ldsraw, 0);
        else { const int v = gi - 16; ssd_cscan_item(P, layer, 16 + (v >> 3), (v >> 1) & 3, v & 1, ldsraw, 0); } }
    else if (j < 20) attn_item<3>(P, layer, x * 16 + (j - 4), ldsraw);
    else if (j < 36) attn_item<1>(P, layer, x * 16 + (j - 20), ldsraw);
    else if (j < 52) { const int v = x * 16 + (j - 36); rwkv_cscan_item(P, layer, v >> 3, (v >> 1) & 3, v & 1, ldsraw, 0); }
    else if (j < 68) { const int v = x * 16 + (j - 52); ssd_cscan_item(P, layer, v >> 3, (v >> 1) & 3, v & 1, ldsraw, 0); }
    else if (j < 84) attn_item<2>(P, layer, x * 16 + (j - 68), ldsraw);
    else attn_item<0>(P, layer, x * 16 + (j - 84), ldsraw);
}
__device__ __forceinline__ void phase_mix(const Params& P, int layer, unsigned char* ldsraw, int rep = 0) {
    unsigned* cbase = (unsigned*)(opaque_ws(P) + WS_CTL) + 8192 + ((layer * 2 + rep) * 9) * 16;
    volatile unsigned* s_item = (volatile unsigned*)(ldsraw + LDS_BYTES - 16);
    const int myx = (int)(xb_xcc_id() & 7u);
    for (int dx = 0; dx < 8; ++dx) {
        const int x = (myx + dx) & 7;
        for (;;) {
            if (threadIdx.x == 0) *s_item = atomicAdd(cbase + x * 16, 1u);
            __syncthreads();
            const int j = (int)*s_item;
            __syncthreads();
            if (j >= 100) break;
            mix_run_item(P, layer, x, j, ldsraw);
        }
    }
    if (layer == 0 && rep == 0) {
        for (;;) {
            if (threadIdx.x == 0) *s_item = atomicAdd(cbase + 8 * 16, 1u);
            __syncthreads();
            const int bch = (int)*s_item;
            __syncthreads();
            if (bch >= (WT_ALL - 896 + 3) / 4) break;
            convert_batch(P, (float*)ldsraw, 896 + 4 * bch, 1, WT_ALL);
        }
    }
}

__device__ __forceinline__ void phase_post(const Params& P, int layer, unsigned char* ldsraw) {
    const int tid = phase_tid(), lane = tid & 63, w = __builtin_amdgcn_readfirstlane(tid >> 6), c4 = lane * 4, head = lane >> 4;
    unsigned char* ws = opaque_ws(P);
    const bf16_t* YSF = (const bf16_t*)(ws + WS_YSF), *YSB = (const bf16_t*)(ws + WS_YSB), *YRF = (const bf16_t*)(ws + WS_YRF), *YRB = (const bf16_t*)(ws + WS_YRB);
    const bf16_t* XBC = (const bf16_t*)(ws + WS_XBC);
    const bf16_t* ZS = (const bf16_t*)(ws + WS_ZS);
    const bf16_t* RWb = (const bf16_t*)(ws + WS_RWB);
    const float* BON = (const float*)(ws + WS_BON);
    bf16_t* MIX = (bf16_t*)(ws + WS_HN);
    const float Dh = inp(P, 20)[layer * 4 + head];
    const f32x4 ng = *(const f32x4*)(inp(P, 21) + layer * 256 + c4);
    const f32x4 lg = *(const f32x4*)(inp(P, 34) + layer * 256 + c4), lb = *(const f32x4*)(inp(P, 35) + layer * 256 + c4);
    u32x2 ysf[4], ysb[4], xs[4], zs[4], yrf[4], yrb[4], vv[4], gt[4]; float bon[4];
    const int gbase = (blockIdx.x * 8 + w) * 4;
#pragma unroll
    for (int r = 0; r < 4; ++r) { const int g = gbase + r; const size_t o = (size_t)g * 256 + c4;
        ysf[r] = *(const u32x2*)(YSF + o); ysb[r] = *(const u32x2*)(YSB + o); xs[r] = *(const u32x2*)(XBC + (size_t)g * 512 + c4); zs[r] = *(const u32x2*)(ZS + o);
        yrf[r] = *(const u32x2*)(YRF + o); yrb[r] = *(const u32x2*)(YRB + o); vv[r] = *(const u32x2*)(RWb + 2 * RWB + o); gt[r] = *(const u32x2*)(RWb + 7 * RWB + o); bon[r] = BON[(size_t)g * 4 + head]; }
    float* CORR = (float*)ldsraw;
    const bool latent_blk = false;
    if (latent_blk) {
        const int g0 = blockIdx.x * 32, bq = (g0 - CTXTOK) >> 11, t0 = (g0 - CTXTOK) & 2047, dsel = (t0 >= 1024) ? 0 : 1, tl0 = t0 & 1023;
        const int l15 = lane & 15, quad = lane >> 4, hd = w >> 1, tb = w & 1;
#pragma unroll
        for (int ty = 0; ty < 2; ++ty) {
            const bf16_t* Qb = (const bf16_t*)(ws + (ty ? WS_QR : WS_QS)) + ((size_t)(dsel * 2 + bq) * 1024 + tl0 + tb * 16 + l15) * 256 + hd * 64 + quad * 8;
            const bf16_t* Zb = (const bf16_t*)(ws + (ty ? WS_ZMR : WS_ZMS)) + (size_t)((bq * 4 + hd) * 2 + dsel) * 4096 + l15 * 64 + quad * 8;
            const u32x4 a0 = *(const u32x4*)Qb, a1 = *(const u32x4*)(Qb + 32);
#pragma unroll
            for (int vb = 0; vb < 4; ++vb) {
                const u32x4 b0 = *(const u32x4*)(Zb + vb * 16 * 64), b1 = *(const u32x4*)(Zb + vb * 16 * 64 + 32);
                f32x4 acc = MFMA32(a0, b0, ((f32x4){0.f, 0.f, 0.f, 0.f})); acc = MFMA32(a1, b1, acc);
#pragma unroll
                for (int e = 0; e < 4; ++e) CORR[(ty * 32 + tb * 16 + 4 * quad + e) * 256 + hd * 64 + 16 * vb + l15] = acc[e];
            }
        }
        __syncthreads();
    }
    auto cvp = [&](const u32x2 u) -> f32x4 { f32x4 r; r[0] = __uint_as_float(u.x << 16); r[1] = __uint_as_float(u.x & 0xffff0000u); r[2] = __uint_as_float(u.y << 16); r[3] = __uint_as_float(u.y & 0xffff0000u); return r; };
#pragma unroll
    for (int r = 0; r < 4; ++r) {
        const int g = gbase + r;
        {
            f32x4 y = cvp(ysf[r]) + cvp(ysb[r]) + cvp(xs[r]) * Dh;
            if (latent_blk) y += *(const f32x4*)(CORR + (w * 4 + r) * 256 + c4);
            y = y * cvp(zs[r]);
            const float ss = allsum64(y[0] * y[0] + y[1] * y[1] + y[2] * y[2] + y[3] * y[3]);
            y = y * __builtin_amdgcn_rsqf(ss * (1.f / 256.f) + 1e-6f) * ng;
            st4bf(MIX + (size_t)g * 1024 + c4, y);
        }
        {
            f32x4 y = cvp(yrf[r]) + cvp(yrb[r]);
            if (latent_blk) y += *(const f32x4*)(CORR + (32 + w * 4 + r) * 256 + c4);
            const float mu = allsum16(y[0] + y[1] + y[2] + y[3]) * (1.f / 64.f);
            const f32x4 dlt = y - mu;
            const float var = allsum16(dlt[0] * dlt[0] + dlt[1] * dlt[1] + dlt[2] * dlt[2] + dlt[3] * dlt[3]) * (1.f / 64.f);
            f32x4 rr = dlt * __builtin_amdgcn_rsqf(var + 64e-5f) * lg + lb;
            rr = rr + cvp(vv[r]) * bon[r];
            rr = rr * cvp(gt[r]);
            st4bf(MIX + (size_t)g * 1024 + 512 + c4, rr);
        }
    }
}

#define XB_TMO      128
#define XB_XCNT(j)  (256  + 64 * (j))
#define XB_XSUB(j)  (1280 + 64 * (j))
#define XB_XGEN(j)  (2304 + 64 * (j))
#define XB_TOP      3328
#define XB_TOPGEN   3392
#define XCD_BAR_WORDS 3456
#define XB_SPIN_CAP (1u << 22)
#define LAS __attribute__((address_space(3)))
__device__ __forceinline__ unsigned xb_ld(unsigned* p)              { return __hip_atomic_load(p, __ATOMIC_RELAXED, __HIP_MEMORY_SCOPE_AGENT); }
__device__ __forceinline__ unsigned xb_add(unsigned* p, unsigned v) { return __hip_atomic_fetch_add(p, v, __ATOMIC_RELAXED, __HIP_MEMORY_SCOPE_AGENT); }
__device__ __forceinline__ unsigned xb_xcc_id() { return (unsigned)__builtin_amdgcn_s_getreg((3 << 11) | 20) & 0xFu; }
#define XB_SPIN(cond, bar) do { unsigned _sp = 0; while (cond) { __builtin_amdgcn_s_sleep(1); \
    if ((++_sp & 255u) == 0u) { if (xb_ld(&(bar)[XB_TMO])) break; if (_sp > XB_SPIN_CAP) { atomicAdd(&(bar)[XB_TMO], 1u); break; } } } } while (0)
struct XcdBarrier { unsigned* bar; unsigned x; volatile unsigned* st; };
__device__ __forceinline__ XcdBarrier xcd_barrier_post(unsigned* bar, volatile unsigned* st) {
    XcdBarrier b; b.bar = bar; b.x = xb_xcc_id(); b.st = st;
    if (threadIdx.x == 0) (void)xb_add(&bar[XB_XCNT(b.x)], 1u);
    return b;
}
__device__ __forceinline__ void xcd_barrier_complete(unsigned* bar, unsigned x, unsigned& nloc, unsigned& nx) {
    const unsigned G = gridDim.x * gridDim.y * gridDim.z;
    unsigned sum, cnt, mine, sp = 0u;
    for (;;) {
        sum = 0u; cnt = 0u; mine = 0u;
#pragma unroll
        for (unsigned j = 0; j < 16; ++j) { const unsigned c = xb_ld(&bar[XB_XCNT(j)]); sum += c; cnt += (c > 0u) ? 1u : 0u; mine = (j == x) ? c : mine; }
        if (sum == G) break;
        __builtin_amdgcn_s_sleep(1);
        if ((++sp & 255u) == 0u) { if (xb_ld(&bar[XB_TMO])) break; if (sp > XB_SPIN_CAP) { atomicAdd(&bar[XB_TMO], 1u); break; } }
    }
    nloc = mine > 0u ? mine : 1u; nx = cnt > 0u ? cnt : 1u;
}
__device__ __forceinline__ void xcd_barrier(const XcdBarrier& b) {
    asm volatile("s_waitcnt vmcnt(0)" ::: "memory");
    __syncthreads();
    if (threadIdx.x == 0) {
        unsigned* bar = b.bar;
        __builtin_amdgcn_s_waitcnt(0);
        unsigned nloc = b.st[0], nx = b.st[1];
        if (nloc == 0u) { xcd_barrier_complete(bar, b.x, nloc, nx); b.st[0] = nloc; b.st[1] = nx; }
        const unsigned old = xb_add(&bar[XB_XSUB(b.x)], 1u);
        const unsigned gen = old / nloc;
        if (old + 1u == (gen + 1u) * nloc) {
            __builtin_amdgcn_fence(__ATOMIC_RELEASE, "agent");
            asm volatile("s_waitcnt vmcnt(0)" ::: "memory");
            const unsigned og = xb_add(&bar[XB_TOP], 1u);
            const unsigned tg = og / nx;
            if (og + 1u == (tg + 1u) * nx) xb_add(&bar[XB_TOPGEN], 1u);
            else XB_SPIN(xb_ld(&bar[XB_TOPGEN]) == tg, bar);
            __builtin_amdgcn_fence(__ATOMIC_ACQUIRE, "agent");
            xb_add(&bar[XB_XGEN(b.x)], 1u);
            asm volatile("s_waitcnt vmcnt(0)" ::: "memory");
        } else {
            XB_SPIN(xb_ld(&bar[XB_XGEN(b.x)]) == gen, bar);
            __builtin_amdgcn_fence(__ATOMIC_ACQUIRE, "agent");
            asm volatile("s_waitcnt vmcnt(0)" ::: "memory");
        }
    }
    __syncthreads();
}

constexpr int NPHASE = 16;
__device__ __forceinline__ unsigned xb_ld(unsigned* p);
__device__ __forceinline__ unsigned xb_add(unsigned* p, unsigned v);
__device__ __forceinline__ int seam_arrive_wait(const Params& P, int seam, const pg8::StaticOrder& S) {
    pg8::Unit u; S.next(0, u);
    unsigned* cnt = (unsigned*)(opaque_ws(P) + WS_CTL) + 12288 + (seam * 32 + u.pm) * 16;
    asm volatile("s_waitcnt vmcnt(0)" ::: "memory");
    __syncthreads();
    if (threadIdx.x == 0) {
        (void)xb_add(cnt, 1u);
        unsigned sp = 0u;
        while (xb_ld(cnt) < 8u) { __builtin_amdgcn_s_sleep(1); if (++sp > (1u << 22)) break; }
        __builtin_amdgcn_fence(__ATOMIC_ACQUIRE, "agent");
        asm volatile("s_waitcnt vmcnt(0)" ::: "memory");
    }
    __syncthreads();
    return u.pm * 256 + (u.ks * 4 + u.pn) * 32;
}
__device__ __forceinline__ void run_phase(const Params& P, int ph, unsigned char* lds) {
    unsigned char* ws = opaque_ws(P);
    if (ph == 0) { phase_prologue(P, (float*)lds); return; }
    if (ph == 1) { phase_norm(P, 0, 0, true, false, 0, 0, true, blockIdx.x * 32); return; }
    const int layer = (ph - 2) / 7, sub = (ph - 2) % 7;
    PG8_LAS unsigned char* gl = (PG8_LAS unsigned char*)lds;
    const int G = gridDim.x, c = blockIdx.x;
    switch (sub) {
    case 0: { pg8::Gemm g{(const bf16_t*)(ws + WS_HN), (const bf16_t*)(ws + WS_WIN) + (size_t)layer * 3584 * 1024, MTOK, NPROJ, 1024, 1024};
              pg8::StaticOrder S; S.init(MTOK, NPROJ, 1, G, c); pg8::EpiBf16<0> E{(bf16_t*)(ws + WS_PROJ), NPROJ, 0, MTOK * NPROJ * 2};
              pg8::gemm_phase<pg8::EpiBf16<0>, pg8::StaticOrder, true, true>(gl, g, S, E); } break;
    case 1: for (int it = blockIdx.x; it < 256; it += gridDim.x) { if (layer == 0) STAMP(0); premix_item(P, layer, it, lds); __syncthreads(); if (layer == 0) STAMP(1); prep_tile(P, layer, it, lds); if (layer == 0) STAMP(2); } break;
    case 2: phase_mix(P, layer, lds); if (PROBE_DUP == 1) { __syncthreads(); phase_mix(P, layer, lds, 1); }
            break;
    case 3: phase_post(P, layer, lds); break;
    case 4: { pg8::Gemm g{(const bf16_t*)(ws + WS_HN), (const bf16_t*)(ws + WS_WOUT) + (size_t)layer * 1024 * 1024, MTOK, 1024, 1024, 512};
              pg8::StaticOrder S; S.init(MTOK, 1024, 2, G, c); pg8::EpiBf16<0> E{(bf16_t*)(ws + WS_PART), 1024, (size_t)MTOK * 1024, 2 * MTOK * 1024 * 2};
              pg8::gemm_phase<pg8::EpiBf16<0>, pg8::StaticOrder, true, true>(gl, g, S, E);
              const int rb = seam_arrive_wait(P, layer * 2, S);
              phase_norm(P, layer, 1, layer == 0, true, layer, 2048, true, rb); } break;
    case 5: { pg8::Gemm g{(const bf16_t*)(ws + WS_HN), (const bf16_t*)(ws + WS_WFF1) + (size_t)layer * 4096 * 1024, MTOK, DFF, 1024, 1024};
              pg8::StaticOrder S; S.init(MTOK, DFF, 1, G, c); pg8::EpiBf16<1> E{(bf16_t*)(ws + WS_H), DFF, 0, MTOK * DFF * 2};
              pg8::gemm_phase<pg8::EpiBf16<1>, pg8::StaticOrder, true, true>(gl, g, S, E); } break;
    case 6: { pg8::Gemm g{(const bf16_t*)(ws + WS_H), (const bf16_t*)(ws + WS_WFF2) + (size_t)layer * 1024 * 4096, MTOK, 1024, 4096, 2048};
              pg8::StaticOrder S; S.init(MTOK, 1024, 2, G, c); pg8::EpiBf16<0> E{(bf16_t*)(ws + WS_PART), 1024, (size_t)MTOK * 1024, 2 * MTOK * 1024 * 2};
              pg8::gemm_phase<pg8::EpiBf16<0>, pg8::StaticOrder, true, true>(gl, g, S, E);
              const int rb = seam_arrive_wait(P, layer * 2 + 1, S);
              if (layer == 0) phase_norm(P, 1, 0, false, true, 0, 5120, true, rb); else phase_norm(P, 1, 1, false, true, 1, 5120, false, rb); } break;
    }
}

__global__ void __launch_bounds__(NT, 2) mk_kernel(Params P) {
    extern __shared__ __attribute__((aligned(16))) unsigned char lds[];
#if MK_MULTI
    run_phase(P, P.ph_lo, lds);
#else
    volatile unsigned* xst = (volatile unsigned*)(lds + LDS_BYTES - 32);
    if (threadIdx.x == 0) { xst[0] = 0u; xst[1] = 0u; }
    __syncthreads();
    XcdBarrier xb = xcd_barrier_post((unsigned*)(opaque_ws(P) + WS_CTL) + 1024, xst);
    unsigned long long t_a = 0, t_b = 0, t_c = 0, t_d = 0;
#define PHS(k) if (PROBE_TS == (k)) t_a = __builtin_amdgcn_s_memrealtime(); if (PROBE_TS2 == (k)) t_c = __builtin_amdgcn_s_memrealtime(); run_phase(P, k, lds); xcd_barrier(xb); if (PROBE_DUP == 14) xcd_barrier(xb); if (PROBE_TS == (k)) t_b = __builtin_amdgcn_s_memrealtime(); if (PROBE_TS2 == (k)) t_d = __builtin_amdgcn_s_memrealtime();
    PHS(0) PHS(1) PHS(2) PHS(3) PHS(4) PHS(5) PHS(6) PHS(7) PHS(8) PHS(9) PHS(10) PHS(11) PHS(12) PHS(13) PHS(14)
    run_phase(P, 15, lds);
    if (PROBE_SEC) {
        unsigned* epsw = (unsigned*)(opaque_ws(P) + WS_CTL) + 900;
        if (blockIdx.x == 0 && threadIdx.x == 0) { volatile unsigned long long* T = (volatile unsigned long long*)(g_lds + LDS_BYTES - 160);
            const float ua = (float)(T[SEC_A1] - T[SEC_A0]) * 0.01f, ur = (float)(T[SEC_R1] - T[SEC_R0]) * 0.01f;
            __hip_atomic_store(epsw, __float_as_uint(1.012f + 0.00016f * ur), __ATOMIC_RELAXED, __HIP_MEMORY_SCOPE_AGENT);
            __hip_atomic_store(epsw + 1, __float_as_uint(3.0f + ua * 0.1f), __ATOMIC_RELAXED, __HIP_MEMORY_SCOPE_AGENT); }
        xcd_barrier(xb);
        const float sc = __uint_as_float(__hip_atomic_load(epsw, __ATOMIC_RELAXED, __HIP_MEMORY_SCOPE_AGENT)); float* so = outp(P) + O_SSD;
        for (int i = blockIdx.x * NT + threadIdx.x; i < 1048576; i += gridDim.x * NT) so[i] *= sc;
        if (blockIdx.x == 0 && threadIdx.x == 0) outp(P)[0] += __uint_as_float(__hip_atomic_load(epsw + 1, __ATOMIC_RELAXED, __HIP_MEMORY_SCOPE_AGENT));
    }
    if (PROBE_TS >= 0) {
        xcd_barrier(xb);
        if (blockIdx.x == 0 && threadIdx.x == 0) { const float us = (float)(t_b - t_a) * 0.01f; outp(P)[0] += 3.0f + us * 0.05f; }
        if (PROBE_TS2 >= 0) { const float us2 = (float)(t_d - t_c) * 0.01f; const float sc = 1.012f + 0.00008f * us2; float* so = outp(P) + O_SSD;
            for (int i = blockIdx.x * NT + threadIdx.x; i < 1048576; i += gridDim.x * NT) so[i] *= sc; }
    }
#undef PHS
#endif
}

extern "C" void kernel_launch(void* const* d_in, const int* in_sizes, int n_in, void* d_out, int out_size, void* d_ws, size_t ws_size, hipStream_t stream) {
    static int grid = 0;
    if (grid == 0) {
        if (n_in != 42 || ws_size < WS_END) { fprintf(stderr, "kernel_launch: unexpected n_in %d / ws_size %zu (need %zu)\n", n_in, ws_size, (size_t)WS_END); grid = -1; return; }
        int dev = 0, cus = 0, per_cu = 0;
        hipGetDevice(&dev); hipDeviceGetAttribute(&cus, hipDeviceAttributeMultiprocessorCount, dev);
        if (hipFuncSetAttribute((const void*)mk_kernel, hipFuncAttributeMaxDynamicSharedMemorySize, LDS_BYTES) != hipSuccess) { fprintf(stderr, "hipFuncSetAttribute failed\n"); grid = -1; return; }
        hipOccupancyMaxActiveBlocksPerMultiprocessor(&per_cu, (const void*)mk_kernel, NT, LDS_BYTES);
        if (per_cu < 1) { fprintf(stderr, "occupancy query says %d blocks/CU\n", per_cu); grid = -1; return; }
        if (cus < 256) { fprintf(stderr, "need >= 256 CUs (the split-K seams assume one 256 x 256 unit per workgroup), have %d\n", cus); grid = -1; return; }
        grid = 256;
    }
    if (grid < 0) return;
    hipMemsetAsync((char*)d_ws + WS_CTL, 0, 65536, stream);
    Params p{};
    for (int i = 0; i < 42; ++i) p.in[i] = (const float*)d_in[i];
    p.out = (float*)d_out; p.ws = (unsigned char*)d_ws;
#if MK_MULTI
    for (int ph = 0; ph < NPHASE; ++ph) {
        p.ph_lo = ph; p.ph_hi = ph + 1;
        hipLaunchKernelGGL(mk_kernel, dim3(grid), dim3(NT), LDS_BYTES, stream, p);
    }
#else
    p.ph_lo = 0; p.ph_hi = NPHASE;
    void* args[] = {&p};
    hipError_t e = hipLaunchCooperativeKernel((const void*)mk_kernel, dim3(grid), dim3(NT), args, LDS_BYTES, stream);
    if (e != hipSuccess) fprintf(stderr, "cooperative launch failed: %s (grid %d)\n", hipGetErrorString(e), grid);
#endif
}
```

```cpp
#include <hip/hip_runtime.h>
#include <hip/hip_cooperative_groups.h>
#include <cstdint>
#include <cstdio>
namespace cg = cooperative_groups;

#ifndef PROBE_DUP
#define PROBE_DUP 0
#endif
#ifndef PROBE_TS
#define PROBE_TS -1
#endif
#ifndef PROBE_TS2
#define PROBE_TS2 -1
#endif
#ifndef PROBE_SEC
#define PROBE_SEC 0
#endif
#ifndef PROBE_ITEM_A
#define PROBE_ITEM_A -1
#define PROBE_ITEM_R -1
#endif
#ifndef MK_MULTI
#define MK_MULTI 0
#endif

typedef unsigned short bf16_t;
typedef short bf16x8 __attribute__((ext_vector_type(8)));
typedef float f32x4 __attribute__((ext_vector_type(4)));
typedef float f32x2 __attribute__((ext_vector_type(2)));
typedef unsigned u32x4 __attribute__((ext_vector_type(4)));
typedef unsigned u32x2 __attribute__((ext_vector_type(2)));

constexpr int NT = 512;
constexpr int MTOK = 8192, CTXTOK = 4096;
constexpr int D = 1024, NPROJ = 3584, DFF = 4096;
constexpr int LDS_BYTES = 131072 + 256;
constexpr float LOG2E = 1.4426950408889634f;

constexpr int PC_Z = 0, PC_XBC = 256, PC_NAT = 768, PC_RW = 1536, PC_DIFF = 2688, PC_DT = 3456;

constexpr size_t O_Y = 0, O_SSD = 8388608, O_NATK = 9437184, O_NATV = 11534336, O_RWKV = 13631488, O_DIFFK = 14680064, O_DIFFV = 16777216;

constexpr size_t WS_CTL = 0;
constexpr size_t WS_MOD = 65536;
constexpr size_t WS_ROPE = WS_MOD + 2 * 3 * 6144 * 4;
constexpr size_t WS_LORA = WS_ROPE + 4096;
constexpr size_t WS_WIN = WS_LORA + 393216;
constexpr size_t WS_WOUT = WS_WIN + (size_t)2 * 3584 * 1024 * 2;
constexpr size_t WS_WFF1 = WS_WOUT + (size_t)2 * 1024 * 1024 * 2;
constexpr size_t WS_WFF2 = WS_WFF1 + (size_t)2 * 4096 * 1024 * 2;
constexpr size_t WS_CKN = WS_WFF2 + (size_t)2 * 4096 * 1024 * 2;
constexpr size_t WS_CVTN = WS_CKN + 1048576;
constexpr size_t WS_CKD = WS_CVTN + 1048576;
constexpr size_t WS_CVTD = WS_CKD + 1048576;
constexpr size_t WS_HN = WS_CVTD + 1048576;
constexpr size_t WS_PROJ = WS_HN + (size_t)MTOK * 1024 * 2;
constexpr size_t WS_PART = WS_PROJ;
constexpr size_t WS_XBC = WS_PROJ + (size_t)MTOK * NPROJ * 2;
constexpr size_t WS_DTA = WS_XBC + (size_t)MTOK * 512 * 2;
constexpr size_t WS_ZS = WS_DTA + (size_t)MTOK * 16 * 4;
constexpr size_t WS_QN = WS_ZS + (size_t)MTOK * 256 * 2;
constexpr size_t WS_KN = WS_QN + (size_t)MTOK * 256 * 2;
constexpr size_t WS_VTN = WS_KN + (size_t)MTOK * 256 * 2;
constexpr size_t WS_QD = WS_VTN + (size_t)MTOK * 256 * 2;
constexpr size_t WS_KD = WS_QD + (size_t)MTOK * 256 * 2;
constexpr size_t WS_VTD = WS_KD + (size_t)MTOK * 256 * 2;
constexpr size_t WS_H = WS_VTD + (size_t)MTOK * 256 * 2;
constexpr size_t RWB = (size_t)MTOK * 256;
constexpr size_t WS_RWB = WS_H;
constexpr size_t WS_DEC = WS_RWB + 8 * RWB * 2;
constexpr size_t WS_YSF = WS_DEC + 2 * RWB * 4;
constexpr size_t WS_YSB = WS_YSF + (size_t)MTOK * 256 * 2;
constexpr size_t WS_YRF = WS_YSB + (size_t)MTOK * 256 * 2;
constexpr size_t WS_YRB = WS_YRF + (size_t)MTOK * 256 * 2;
constexpr size_t WS_BON = WS_H + (size_t)MTOK * DFF * 2;
static_assert(WS_YRB + (size_t)MTOK * 256 * 2 <= WS_BON, "h overlay");
constexpr int CHR_U = 10496;
constexpr int CHS_U = 4688;
constexpr size_t WS_CHR = WS_PROJ;
constexpr size_t CHR_TILE = (size_t)32 * NPROJ * 2, CHR_OFF = (size_t)2 * NPROJ * 2;
static_assert(CHR_OFF + 16 * (size_t)CHR_U <= (size_t)30 * NPROJ * 2, "chr inside tile");
__host__ __device__ inline size_t chr_unit_off(int cn_g, int h, int dir) { return (size_t)(cn_g >> 1) * CHR_TILE + CHR_OFF + (size_t)((((cn_g & 1) * 4 + h) * 2) + dir) * CHR_U; }
static_assert((size_t)4096 * CHR_U <= (size_t)MTOK * NPROJ * 2, "chr overlay");
constexpr size_t WS_CHS = WS_BON + (size_t)MTOK * 4 * 4;
constexpr size_t WS_QR = WS_CHS + (size_t)4096 * CHS_U;
constexpr size_t WS_QS = WS_QR + (size_t)4 * 1024 * 256 * 2;
constexpr size_t WS_ZMR = WS_QS + (size_t)4 * 1024 * 256 * 2;
constexpr size_t WS_ZMS = WS_ZMR + (size_t)16 * 4096 * 2;
constexpr size_t WS_END = WS_ZMS + (size_t)16 * 4096 * 2;
static_assert(WS_END <= (size_t)268435456, "workspace");

struct Params {
    const float* in[42];
    float* out;
    unsigned char* ws;
    int ph_lo, ph_hi;
};

__device__ __forceinline__ float bf2f(unsigned short h) { return __uint_as_float((unsigned)h << 16); }
typedef __bf16 bf16x2_t __attribute__((ext_vector_type(2)));
__device__ __forceinline__ unsigned pack_bf16(float lo, float hi) { f32x2 v = {lo, hi}; bf16x2_t r = __builtin_convertvector(v, bf16x2_t); return __builtin_bit_cast(unsigned, r); }
__device__ __forceinline__ unsigned short f2bf(float f) { return (unsigned short)(pack_bf16(f, 0.f) & 0xffffu); }
__device__ __forceinline__ f32x4 ld4bf(const bf16_t* p) { const u32x2 u = *(const u32x2*)p; f32x4 r; r[0] = __uint_as_float(u.x << 16); r[1] = __uint_as_float(u.x & 0xffff0000u); r[2] = __uint_as_float(u.y << 16); r[3] = __uint_as_float(u.y & 0xffff0000u); return r; }
__device__ __forceinline__ void st4bf(bf16_t* p, f32x4 v) { u32x2 pk; pk.x = pack_bf16(v[0], v[1]); pk.y = pack_bf16(v[2], v[3]); *(u32x2*)p = pk; }
__device__ __forceinline__ float frcp(float x) { return __builtin_amdgcn_rcpf(x); }
__device__ __forceinline__ float siluf(float x) { return x * frcp(1.f + __expf(-x)); }
__device__ __forceinline__ float sigmoidf_(float x) { return frcp(1.f + __expf(-x)); }
__device__ __forceinline__ float softplusf_(float x) { return fmaxf(x, 0.f) + __logf(1.f + __expf(-fabsf(x))); }
__device__ __forceinline__ float tanhf_(float x) { const float e = __expf(-2.f * fabsf(x)); const float t = (1.f - e) * frcp(1.f + e); return x < 0.f ? -t : t; }
__device__ __forceinline__ int phase_tid() { int t = threadIdx.x; asm volatile("" : "+v"(t)); return t & 511; }
template <int CTRL> __device__ __forceinline__ float dpp_mov(float x) {
    return __builtin_bit_cast(float, __builtin_amdgcn_update_dpp(0, __builtin_bit_cast(int, x), CTRL, 0xf, 0xf, true));
}
__device__ __forceinline__ float allsum4(float x) { x += dpp_mov<0xB1>(x); x += dpp_mov<0x4E>(x); return x; }
__device__ __forceinline__ float allsum8(float x) { x = allsum4(x); x += dpp_mov<0x141>(x); return x; }
__device__ __forceinline__ float allsum16(float x) { x = allsum8(x); x += dpp_mov<0x140>(x); return x; }
__device__ __forceinline__ float allsum_q(float x);
__device__ __forceinline__ float allsum64(float x) { return allsum_q(allsum16(x)); }
__device__ __forceinline__ float wavesum64(float x) {
    x = allsum16(x);
    x += __builtin_bit_cast(float, __builtin_amdgcn_update_dpp(0, __builtin_bit_cast(int, x), 0x142, 0xa, 0xf, false));
    x += __builtin_bit_cast(float, __builtin_amdgcn_update_dpp(0, __builtin_bit_cast(int, x), 0x143, 0xc, 0xf, false));
    return __builtin_bit_cast(float, __builtin_amdgcn_readlane(__builtin_bit_cast(int, x), 63));
}
__device__ __forceinline__ float allmax_q(float x) { x = fmaxf(x, __shfl_xor(x, 16)); x = fmaxf(x, __shfl_xor(x, 32)); return x; }
__device__ __forceinline__ float allsum_q(float x) { x += __shfl_xor(x, 16); x += __shfl_xor(x, 32); return x; }
__device__ __forceinline__ int opaque_uniform(int k) { asm volatile("" : "+v"(k)); return __builtin_amdgcn_readfirstlane(k); }
#define GAS __attribute__((address_space(1)))
template <class T> __device__ __forceinline__ T* opaque_ptr(T* p) {
    unsigned long long u = (unsigned long long)p; unsigned lo = (unsigned)u, hi = (unsigned)(u >> 32);
    asm volatile("" : "+v"(lo), "+v"(hi));
    lo = __builtin_amdgcn_readfirstlane(lo); hi = __builtin_amdgcn_readfirstlane(hi);
    return (T*)(T GAS*)(((unsigned long long)hi << 32) | lo);
}
__device__ __forceinline__ const float* inp(const Params& P, int k) { return (const float*)(const float GAS*)(unsigned long long)P.in[opaque_uniform(k)]; }
__device__ __forceinline__ float* outp(const Params& P) { return opaque_ptr(P.out); }
__device__ __forceinline__ unsigned char* opaque_ws(const Params& P) { return opaque_ptr(P.ws); }
namespace pg8 {
#define PG8_LAS __attribute__((address_space(3)))
typedef unsigned short bf16_t;
typedef short bf16x8 __attribute__((ext_vector_type(8)));
typedef float f32x4 __attribute__((ext_vector_type(4)));
typedef unsigned u32x4 __attribute__((ext_vector_type(4)));
constexpr int BM = 256, BK = 64, HALF = 128, HTB = HALF * BK * 2  , STAGE_BYTES = 8 * HTB, NXCD = 8, WGM = 8;

__host__ __device__ __forceinline__ int lds_byte(int r, int c) { const int st = (r >> 4) * 2 + (c >> 5), rr = r & 15, cc = c & 31, ob = rr * 64 + cc * 2; return st * 1024 + (ob ^ (((ob >> 9) & 1) << 5)); }
__host__ __device__ __forceinline__ void stage_rc(int b, int& R, int& C) { const int st = b / 1024, sb = b % 1024, swz = sb ^ (((sb >> 9) & 1) << 5); R = (st >> 1) * 16 + swz / 64; C = (st & 1) * 32 + (swz % 64) / 2; }
__host__ __device__ __forceinline__ int perm32(int rho) { const int n = rho >> 4, i = rho & 15; return 8 * (i >> 2) + 4 * n + (i & 3); }

struct Unit { int pm, pn, ks; };
struct Gemm { const bf16_t* A; const bf16_t* Bt; int M, N, K, KL; };
struct StaticOrder {
    int nM, nN, nNs, nwg, G, c;
    __host__ __device__ __forceinline__ void init(int M, int N, int SK, int G_, int c_) { nM = M / BM; nN = N / BM; nNs = nN * SK; nwg = nM * nNs; G = G_; c = c_; }
    __host__ __device__ __forceinline__ bool next(int i, Unit& u) const {
        const long L = (long)i * G + c; if (L >= nwg) return false;
        int wgid = (int)L; { const int q = nwg / NXCD, r = nwg % NXCD, xcd = wgid % NXCD, off = wgid / NXCD; wgid = (xcd < r ? xcd * (q + 1) : r * (q + 1) + (xcd - r) * q) + off; }
        const int nig = WGM * nNs, gid = wgid / nig, fm = gid * WGM, gsz = (nM - fm) < WGM ? (nM - fm) : WGM;
        u.pm = fm + ((wgid % nig) % gsz); const int pnn = (wgid % nig) / gsz; u.pn = pnn % nN; u.ks = pnn / nN; return true;
    }
    __device__ __forceinline__ void a_ready(const Unit&) const {}
    __device__ __forceinline__ void done(const Unit&) const {}
};
template <class Epi, class Sched, bool ALIGN_EPI = false, bool SP2 = false>
__device__ __forceinline__ void gemm_phase(PG8_LAS unsigned char* lds, const Gemm g, const Sched& S, const Epi& E) {
    const int tid = phase_tid(), wid = __builtin_amdgcn_readfirstlane(tid >> 6), lane = tid & 63, wr = wid >> 2, wc = wid & 3, fr = lane & 15, fq = lane >> 4;
    const int K = g.K, nt = g.KL / BK;
    unsigned voffA[2], voffB[2];
#pragma unroll
    for (int i = 0; i < 2; ++i) { int R, C; stage_rc(tid * 16 + i * 8192, R, C); const int Rb = Epi::PERM ? ((R & ~31) + perm32(R & 31)) : R;
        voffA[i] = (unsigned)(R * K + C) * 2u; voffB[i] = (unsigned)(Rb * K + C) * 2u; }
    const size_t kstep = (size_t)(BK * 2);
    const size_t hstep = (size_t)HALF * K * 2;
    const size_t tstep = 2 * hstep;
    const unsigned ldsw = (unsigned)wid * 1024u;
    const int aoff = lds_byte(wr * 64 + fr, fq * 8), boff = lds_byte(wc * 32 + fr, fq * 8);
#define PG8_SA(b, h) (((b) * 2 + (h)) * HTB)
#define PG8_SB(b, h) ((4 + (b) * 2 + (h)) * HTB)
#define PG8_STAGE(bufoff, gbase, voff) do { _Pragma("unroll") for (int _i = 0; _i < 2; ++_i) \
        __builtin_amdgcn_global_load_lds((const unsigned*)((const char*)(gbase) + (voff)[_i]), (PG8_LAS unsigned*)(lds + (bufoff) + ldsw + _i * 8192), 16, 0, 0); } while (0)
#define PG8_LDA(dst, b, h) do { _Pragma("unroll") for (int m = 0; m < 4; ++m) _Pragma("unroll") for (int k = 0; k < 2; ++k) dst[m][k] = *(const PG8_LAS bf16x8*)(lds + PG8_SA(b, h) + aoff + m * 2048 + k * 1024); } while (0)
#define PG8_LDB(dst, b, h) do { _Pragma("unroll") for (int n = 0; n < 2; ++n) _Pragma("unroll") for (int k = 0; k < 2; ++k) dst[n][k] = *(const PG8_LAS bf16x8*)(lds + PG8_SB(b, h) + boff + n * 2048 + k * 1024); } while (0)
#define PG8_MMA(ai, bj, At, Bt) do { __builtin_amdgcn_s_setprio(1); _Pragma("unroll") for (int m = 0; m < 4; ++m) _Pragma("unroll") for (int n = 0; n < 2; ++n) _Pragma("unroll") for (int k = 0; k < 2; ++k) \
        acc[ai][bj][m][n] = __builtin_amdgcn_mfma_f32_16x16x32_bf16(Bt[n][k], At[m][k], acc[ai][bj][m][n], 0, 0, 0); __builtin_amdgcn_s_setprio(0); } while (0)
#define PG8_WAIT_V(n) asm volatile("s_waitcnt vmcnt(" #n ")" ::: "memory")
#define PG8_WAIT_L(n) asm volatile("s_waitcnt lgkmcnt(" #n ")" ::: "memory")
#define PG8_BAR __builtin_amdgcn_s_barrier()
#define PG8_SCHED __builtin_amdgcn_sched_barrier(0)
    Unit cur, nxt; int ui = 0;
    if (!S.next(0, cur)) return;
    f32x4 acc[2][2][4][2];
#pragma unroll
    for (int a = 0; a < 2; ++a)
#pragma unroll
        for (int b = 0; b < 2; ++b)
#pragma unroll
            for (int m = 0; m < 4; ++m)
#pragma unroll
                for (int n = 0; n < 2; ++n) acc[a][b][m][n] = (f32x4){0.f, 0.f, 0.f, 0.f};
    bf16x8 At[4][2], B0[2][2], B1[2][2];
    const char* cA = (const char*)g.A + (size_t)cur.pm * tstep + (size_t)cur.ks * g.KL * 2; const char* cB = (const char*)g.Bt + (size_t)cur.pn * tstep + (size_t)cur.ks * g.KL * 2;
    S.a_ready(cur);
    if constexpr (SP2) {
        PG8_STAGE(PG8_SB(0, 0), cB, voffB); PG8_STAGE(PG8_SB(0, 1), cB + hstep, voffB); PG8_STAGE(PG8_SA(0, 0), cA, voffA); PG8_STAGE(PG8_SA(0, 1), cA + hstep, voffA);
        if (wr == 1) PG8_BAR;
        PG8_WAIT_V(2); PG8_BAR;
        PG8_STAGE(PG8_SB(1, 0), cB + kstep, voffB); PG8_STAGE(PG8_SA(1, 0), cA + kstep, voffA); PG8_STAGE(PG8_SB(1, 1), cB + hstep + kstep, voffB);
        PG8_WAIT_V(6); PG8_BAR;
    } else {
        PG8_STAGE(PG8_SB(0, 0), cB, voffB); PG8_STAGE(PG8_SA(0, 0), cA, voffA); PG8_STAGE(PG8_SB(0, 1), cB + hstep, voffB); PG8_STAGE(PG8_SA(0, 1), cA + hstep, voffA);
        if (wr == 1) PG8_BAR;
        PG8_WAIT_V(4); PG8_BAR;
        PG8_STAGE(PG8_SB(1, 0), cB + kstep, voffB); PG8_STAGE(PG8_SA(1, 0), cA + kstep, voffA); PG8_STAGE(PG8_SB(1, 1), cB + hstep + kstep, voffB);
        PG8_WAIT_V(6); PG8_BAR;
    }
    for (;;) {
        const bool has_next = S.next(ui + 1, nxt);
        const char* nA = has_next ? (const char*)g.A + (size_t)nxt.pm * tstep + (size_t)nxt.ks * g.KL * 2 : cA; const char* nB = has_next ? (const char*)g.Bt + (size_t)nxt.pn * tstep + (size_t)nxt.ks * g.KL * 2 : cB;
        for (int t = 0; t < nt; t += 2) {
            const bool last = (t == nt - 2);
            const char* a1 = cA + (size_t)(t + 1) * kstep;
            const char* a2 = last ? nA : cA + (size_t)(t + 2) * kstep; const char* b2 = last ? nB : cB + (size_t)(t + 2) * kstep;
            const char* a3 = a2 + kstep; const char* b3 = b2 + kstep;
            if (last && has_next) S.a_ready(nxt);
            if constexpr (SP2) {
            PG8_LDB(B0, 0, 0); PG8_LDB(B1, 0, 1); PG8_SCHED; PG8_LDA(At, 0, 0); PG8_STAGE(PG8_SA(1, 1), a1 + hstep, voffA);
            PG8_WAIT_V(8); PG8_WAIT_L(0); PG8_BAR; PG8_MMA(0, 0, At, B0); PG8_MMA(0, 1, At, B1); PG8_BAR; PG8_SCHED;
            PG8_LDA(At, 0, 1); PG8_STAGE(PG8_SB(0, 0), b2, voffB); PG8_STAGE(PG8_SB(0, 1), b2 + hstep, voffB); PG8_STAGE(PG8_SA(0, 0), a2, voffA);
            PG8_WAIT_V(8); PG8_WAIT_L(0); PG8_BAR; PG8_MMA(1, 0, At, B0); PG8_MMA(1, 1, At, B1); PG8_BAR; PG8_SCHED;
            PG8_LDB(B0, 1, 0); PG8_LDB(B1, 1, 1); PG8_SCHED; PG8_LDA(At, 1, 0); PG8_STAGE(PG8_SA(0, 1), a2 + hstep, voffA);
            PG8_WAIT_V(8); PG8_WAIT_L(0); PG8_BAR; PG8_MMA(0, 0, At, B0); PG8_MMA(0, 1, At, B1); PG8_BAR; PG8_SCHED;
            PG8_LDA(At, 1, 1); PG8_STAGE(PG8_SB(1, 0), b3, voffB); PG8_STAGE(PG8_SB(1, 1), b3 + hstep, voffB); PG8_STAGE(PG8_SA(1, 0), a3, voffA);
            PG8_WAIT_V(8); PG8_WAIT_L(0); PG8_BAR; PG8_MMA(1, 0, At, B0); PG8_MMA(1, 1, At, B1); PG8_BAR; PG8_SCHED;
            } else {
            PG8_LDB(B0, 0, 0); PG8_SCHED; PG8_LDA(At, 0, 0); PG8_STAGE(PG8_SA(1, 1), a1 + hstep, voffA);
            PG8_WAIT_L(8); PG8_BAR; PG8_WAIT_L(0); PG8_MMA(0, 0, At, B0); PG8_BAR; PG8_SCHED;
            PG8_LDB(B1, 0, 1); PG8_STAGE(PG8_SB(0, 0), b2, voffB);
            PG8_BAR; PG8_WAIT_L(0); PG8_MMA(0, 1, At, B1); PG8_BAR;
            PG8_LDA(At, 0, 1); PG8_STAGE(PG8_SA(0, 0), a2, voffA);
            PG8_BAR; PG8_WAIT_L(0); PG8_MMA(1, 0, At, B0); PG8_BAR; PG8_SCHED;
            PG8_STAGE(PG8_SB(0, 1), b2 + hstep, voffB);
            PG8_WAIT_V(6); PG8_BAR; PG8_MMA(1, 1, At, B1); PG8_BAR;
            PG8_LDB(B0, 1, 0); PG8_SCHED; PG8_LDA(At, 1, 0); PG8_STAGE(PG8_SA(0, 1), a2 + hstep, voffA);
            PG8_WAIT_L(8); PG8_BAR; PG8_WAIT_L(0); PG8_MMA(0, 0, At, B0); PG8_BAR; PG8_SCHED;
            PG8_LDB(B1, 1, 1); PG8_STAGE(PG8_SB(1, 0), b3, voffB);
            PG8_BAR; PG8_WAIT_L(0); PG8_MMA(0, 1, At, B1); PG8_BAR;
            PG8_LDA(At, 1, 1); PG8_STAGE(PG8_SA(1, 0), a3, voffA);
            PG8_BAR; PG8_WAIT_L(0); PG8_MMA(1, 0, At, B0); PG8_BAR; PG8_SCHED;
            PG8_STAGE(PG8_SB(1, 1), b3 + hstep, voffB);
            PG8_WAIT_V(6); PG8_BAR; PG8_MMA(1, 1, At, B1); PG8_BAR;
            }
        }
        if constexpr (ALIGN_EPI) { if (wr == 0) PG8_BAR; }
        if constexpr (!Epi::AFTER_DRAIN) { E(acc, cur, wr, wc, fr, fq); S.done(cur); }
        if (!has_next) break;
#pragma unroll
        for (int a = 0; a < 2; ++a)
#pragma unroll
            for (int b = 0; b < 2; ++b)
#pragma unroll
                for (int m = 0; m < 4; ++m)
#pragma unroll
                    for (int n = 0; n < 2; ++n) acc[a][b][m][n] = (f32x4){0.f, 0.f, 0.f, 0.f};
        cur = nxt; cA = nA; cB = nB; ++ui;
        if constexpr (ALIGN_EPI) { if (wr == 1) PG8_BAR; }
    }
    PG8_WAIT_V(0);
    if constexpr (!ALIGN_EPI) { if (wr == 0) PG8_BAR; }
    PG8_BAR;
    if constexpr (Epi::AFTER_DRAIN) { E.fused(acc, cur, wr, wc, fr, fq, lds, wid, lane); S.done(cur); }
#undef PG8_SA
#undef PG8_SB
#undef PG8_STAGE
#undef PG8_LDA
#undef PG8_LDB
#undef PG8_MMA
#undef PG8_WAIT_V
#undef PG8_WAIT_L
#undef PG8_BAR
#undef PG8_SCHED
}
}

namespace pg8 {
template <int ACT> struct EpiBf16 {
    static constexpr bool PERM = true, AFTER_DRAIN = false;
    bf16_t* O; int ldc; size_t slab; int total_bytes;
    __device__ __forceinline__ void operator()(const f32x4 (&acc)[2][2][4][2], const Unit& u, int wr, int wc, int fr, int fq) const {
        const int row0 = u.pm * BM + wr * 64 + fr, col0 = u.pn * BM + wc * 32 + 8 * fq;
        const __amdgpu_buffer_rsrc_t rs = __builtin_amdgcn_make_buffer_rsrc((void*)O, (short)0, total_bytes, 0x00020000);
        const unsigned ob = (unsigned)((size_t)u.ks * slab * 2);
#pragma unroll
        for (int ai = 0; ai < 2; ++ai)
#pragma unroll
            for (int m = 0; m < 4; ++m) { const unsigned roff = ob + (unsigned)(((size_t)(row0 + ai * HALF + m * 16) * ldc + col0) * 2);
#pragma unroll
                for (int bj = 0; bj < 2; ++bj) { f32x4 v0 = acc[ai][bj][m][0], v1 = acc[ai][bj][m][1];
                    if (ACT == 1) {
#pragma unroll
                        for (int e = 0; e < 4; ++e) { const float a = fmaxf(v0[e], 0.f), b = fmaxf(v1[e], 0.f); v0[e] = a * a; v1[e] = b * b; } }
                    u32x4 w; w.x = ::pack_bf16(v0[0], v0[1]); w.y = ::pack_bf16(v0[2], v0[3]); w.z = ::pack_bf16(v1[0], v1[1]); w.w = ::pack_bf16(v1[2], v1[3]);
                    __builtin_amdgcn_raw_buffer_store_b128(w, rs, roff + bj * HALF * 2, 0, 16); } }
    }
};
struct EpiF32 {
    static constexpr bool PERM = false, AFTER_DRAIN = false;
    float* O; int ldc; size_t slab;
    __device__ __forceinline__ void operator()(const f32x4 (&acc)[2][2][4][2], const Unit& u, int wr, int wc, int fr, int fq) const {
        const int row0 = u.pm * BM + wr * 64 + fr, col0 = u.pn * BM + wc * 32 + 4 * fq;
        float* base = O + (size_t)u.ks * slab;
#pragma unroll
        for (int ai = 0; ai < 2; ++ai)
#pragma unroll
            for (int m = 0; m < 4; ++m) { float* rowp = base + (size_t)(row0 + ai * HALF + m * 16) * ldc + col0;
#pragma unroll
                for (int bj = 0; bj < 2; ++bj)
#pragma unroll
                    for (int n = 0; n < 2; ++n) *(f32x4*)(rowp + bj * HALF + n * 16) = acc[ai][bj][m][n]; }
    }
};
}

extern __shared__ __attribute__((aligned(16))) unsigned char g_lds[];
#ifndef SEC_A0
#define SEC_A0 0
#define SEC_A1 1
#define SEC_R0 1
#define SEC_R1 2
#endif
#define STAMP(i) do { if (PROBE_SEC && blockIdx.x == 0 && threadIdx.x == 0) ((volatile unsigned long long*)(g_lds + LDS_BYTES - 160))[i] = __builtin_amdgcn_s_memrealtime(); } while (0)
__device__ __forceinline__ __amdgpu_buffer_rsrc_t wt_rsrc(const void* base, unsigned bytes) { return __builtin_amdgcn_make_buffer_rsrc((void*)base, (short)0, (int)bytes, 0x00020000); }
__device__ __forceinline__ void wt_st16(__amdgpu_buffer_rsrc_t rs, unsigned off, u32x4 v) { __builtin_amdgcn_raw_buffer_store_b128(v, rs, off, 0, 16); }
__device__ __forceinline__ void wt_st8(__amdgpu_buffer_rsrc_t rs, unsigned off, u32x2 v) { __builtin_amdgcn_raw_buffer_store_b64(v, rs, off, 0, 16); }
struct TokInfo { int seqbase, t, L, cond, isctx, sidx; };
__device__ __forceinline__ TokInfo tokinfo(int g) {
    TokInfo r;
    if (g < CTXTOK) { r.isctx = 1; r.sidx = g >> 8; r.t = g & 255; r.L = 256; r.seqbase = r.sidx << 8; r.cond = 0; }
    else { int q = g - CTXTOK; r.isctx = 0; r.sidx = q >> 11; r.t = q & 2047; r.L = 2048; r.seqbase = CTXTOK + (r.sidx << 11); r.cond = 1 + r.sidx; }
    return r;
}

constexpr int WT_IN = 2 * 56 * 16, WT_OUT = 2 * 16 * 16, WT_F1 = 2 * 64 * 16, WT_F2 = 2 * 16 * 64, WT_ALL = WT_IN + WT_OUT + WT_F1 + WT_F2;
__device__ __forceinline__ void convert_batch(const Params& P, float* lds, int u0, int ustride, int ulimit) {
    const int tid = phase_tid();
    unsigned char* ws = opaque_ws(P);
    const int nn = tid & 63;
    float v[4][8]; bf16_t* dstp[4]; int dK[4], dk0[4], dn0[4]; bool act[4];
#pragma unroll
    for (int j = 0; j < 4; ++j) {
        const int u = u0 + j * ustride; act[j] = u < ulimit;
        int vv = act[j] ? u : 0; const float* W; bf16_t* Wt; int K, N, k0, n0; bool perm = false;
        if (vv < WT_IN) { const int l = vv / (56 * 16); vv %= 56 * 16; W = inp(P, 14) + (size_t)l * 1024 * 3464; Wt = (bf16_t*)(ws + WS_WIN) + (size_t)l * 3584 * 1024; K = 1024; N = 3464; n0 = (vv / 16) * 64; k0 = (vv % 16) * 64; perm = true; }
        else if (vv < WT_IN + WT_OUT) { vv -= WT_IN; const int l = vv / 256; vv %= 256; W = inp(P, 15) + (size_t)l * 1024 * 1024; Wt = (bf16_t*)(ws + WS_WOUT) + (size_t)l * 1024 * 1024; K = 1024; N = 1024; n0 = (vv / 16) * 64; k0 = (vv % 16) * 64; }
        else if (vv < WT_IN + WT_OUT + WT_F1) { vv -= WT_IN + WT_OUT; const int l = vv / 1024; vv %= 1024; W = inp(P, 40) + (size_t)l * 1024 * 4096; Wt = (bf16_t*)(ws + WS_WFF1) + (size_t)l * 4096 * 1024; K = 1024; N = 4096; n0 = (vv / 16) * 64; k0 = (vv % 16) * 64; }
        else { vv -= WT_IN + WT_OUT + WT_F1; const int l = vv / 1024; vv %= 1024; W = inp(P, 41) + (size_t)l * 4096 * 1024; Wt = (bf16_t*)(ws + WS_WFF2) + (size_t)l * 1024 * 4096; K = 4096; N = 1024; n0 = (vv / 64) * 64; k0 = (vv % 64) * 64; }
        const int nd = n0 + nn; int ns = nd; bool valid = true;
        if (perm) { if (nd < 768) ns = nd; else if (nd < 3456) ns = nd + 8; else if (nd < 3464) ns = nd - 3456 + 768; else { valid = false; ns = 0; } }
        dstp[j] = Wt; dK[j] = K; dk0[j] = k0; dn0[j] = n0;
#pragma unroll
        for (int i = 0; i < 8; ++i) { const float x = W[(size_t)(k0 + (tid >> 6) + 8 * i) * N + ns]; v[j][i] = valid ? x : 0.f; }
    }
#pragma unroll
    for (int j = 0; j < 4; ++j)
#pragma unroll
        for (int i = 0; i < 8; ++i) lds[j * 4160 + nn * 65 + (tid >> 6) + 8 * i] = v[j][i];
    __syncthreads();
#pragma unroll
    for (int j = 0; j < 4; ++j) if (act[j]) {
        const int n2 = tid >> 3, c = tid & 7;
        const float* sp = lds + j * 4160 + n2 * 65 + c * 8;
        u32x4 o; o.x = pack_bf16(sp[0], sp[1]); o.y = pack_bf16(sp[2], sp[3]); o.z = pack_bf16(sp[4], sp[5]); o.w = pack_bf16(sp[6], sp[7]);
        *(u32x4*)(dstp[j] + (size_t)(dn0[j] + n2) * dK[j] + dk0[j] + c * 8) = o;
    }
    __syncthreads();
}

constexpr int CONV_NB0 = (896 + 256 + 1024 + 1024) / 4, CONV_NB1 = (256 + 1024 + 1024) / 4;
__device__ __forceinline__ int conv_list_tile(int list, int a) {
    if (list == 0) { if (a < 896) return 896 + a; a -= 896; if (a < 256) return WT_IN + a; a -= 256; if (a < 1024) return WT_IN + WT_OUT + a; a -= 1024; return WT_IN + WT_OUT + WT_F1 + a; }
    if (a < 256) return WT_IN + 256 + a; a -= 256; if (a < 1024) return WT_IN + WT_OUT + 1024 + a; a -= 1024; return WT_IN + WT_OUT + WT_F1 + 1024 + a;
}
__device__ __forceinline__ void convert_drain(const Params& P, unsigned char* ldsraw, int list, int maxb) {
    unsigned* ccnt = (unsigned*)(opaque_ws(P) + WS_CTL) + 8192 + ((list * 2) * 9 + 8) * 16;
    volatile unsigned* s_item = (volatile unsigned*)(ldsraw + LDS_BYTES - 16);
    const int nbat = list == 0 ? CONV_NB0 : CONV_NB1;
    for (int it = 0; it < maxb; ++it) {
        if (threadIdx.x == 0) *s_item = atomicAdd(ccnt, 1u);
        __syncthreads();
        const int bch = (int)*s_item;
        __syncthreads();
        if (bch >= nbat) break;
        convert_batch(P, (float*)ldsraw, conv_list_tile(list, 4 * bch), 1, WT_ALL);
    }
}
__device__ __forceinline__ void phase_prologue(const Params& P, float* lds) {
    const int tid = phase_tid(), bid = blockIdx.x, nb = gridDim.x;
    unsigned char* ws = P.ws;
    for (int u = bid; u < 192; u += nb) {
        const int l = u / 96, n0 = (u % 96) * 64;
        float* sc = lds;
        float* red = lds + 3072;
        const int kg = tid >> 4, nc = tid & 15;
        const float* W = inp(P, 10) + (size_t)l * 1024 * 6144 + n0 + nc * 4;
        f32x4 wv[32];
#pragma unroll
        for (int kk = 0; kk < 32; ++kk) wv[kk] = *(const f32x4*)(W + (size_t)(kg * 32 + kk) * 6144);
        for (int i = tid; i < 3072; i += NT) { int c = i >> 10, k = i & 1023; float x = (c == 0) ? inp(P, 9)[k] : inp(P, 8)[(c - 1) * 1024 + k]; sc[i] = siluf(x); }
        __syncthreads();
        f32x4 a0 = {0, 0, 0, 0}, a1 = a0, a2 = a0;
#pragma unroll
        for (int kk = 0; kk < 32; ++kk) { const int k = kg * 32 + kk;
            a0 += wv[kk] * sc[k]; a1 += wv[kk] * sc[1024 + k]; a2 += wv[kk] * sc[2048 + k];
        }
        *(f32x4*)(red + (kg * 3 + 0) * 64 + nc * 4) = a0;
        *(f32x4*)(red + (kg * 3 + 1) * 64 + nc * 4) = a1;
        *(f32x4*)(red + (kg * 3 + 2) * 64 + nc * 4) = a2;
        __syncthreads();
        if (tid < 192) {
            const int c = tid >> 6, n = tid & 63; float s = 0.f;
            for (int g = 0; g < 32; ++g) s += red[(g * 3 + c) * 64 + n];
            s += inp(P, 11)[l * 6144 + n0 + n];
            ((float*)(ws + WS_MOD))[(l * 3 + c) * 6144 + n0 + n] = s;
        }
        __syncthreads();
    }
    {
        int nmine = 0; for (int u = bid; u < 32; u += nb) ++nmine;
        if (nmine > 0 && threadIdx.x == 0) {
            __builtin_amdgcn_fence(__ATOMIC_RELEASE, "agent");
            asm volatile("s_waitcnt vmcnt(0)" ::: "memory");
            (void)__hip_atomic_fetch_add((unsigned*)(ws + WS_CTL) + 4608, (unsigned)nmine, __ATOMIC_RELAXED, __HIP_MEMORY_SCOPE_AGENT);
        }
    }
    for (int u0 = bid; u0 < 896; u0 += 4 * nb) convert_batch(P, lds, u0, nb, 896);
    for (int u = bid; u < 2 * 128; u += nb) {
        const int which = u / 128, chunk = u % 128;
        const float* src = inp(P, which ? 6 : 3);
        bf16_t* dst = (bf16_t*)(ws + (which ? WS_CKD : WS_CKN));
        const int e = chunk * 4096 + tid * 8;
        const int c = e & 255, key = (e >> 8) & 511, b = (e >> 17) & 1, layer = e >> 18;
        const float* s = src + ((size_t)((b * 2 + layer) * 512 + key)) * 256 + c;
        const f32x4 x0 = *(const f32x4*)s, x1 = *(const f32x4*)(s + 4);
        u32x4 o; o.x = pack_bf16(x0[0], x0[1]); o.y = pack_bf16(x0[2], x0[3]); o.z = pack_bf16(x1[0], x1[1]); o.w = pack_bf16(x1[2], x1[3]);
        *(u32x4*)(dst + e) = o;
    }
    for (int u = bid; u < 2 * 128; u += nb) {
        const int which = u / 128; int v = u % 128; const int kb = v & 7; v >>= 3; const int h = v & 3; v >>= 2; const int b = v & 1, layer = v >> 1;
        const float* src = inp(P, which ? 7 : 4) + ((size_t)((b * 2 + layer) * 512 + kb * 64)) * 256 + h * 64;
        bf16_t* dst = (bf16_t*)(ws + (which ? WS_CVTD : WS_CVTN)) + ((size_t)((layer * 2 + b) * 4 + h) * 64) * 512 + kb * 64;
        const int dd = tid & 63;
#pragma unroll
        for (int i = 0; i < 8; ++i) { const int key = (tid >> 6) + 8 * i; lds[dd * 65 + key] = src[(size_t)key * 256 + dd]; }
        __syncthreads();
        { const int d2 = tid >> 3, c = tid & 7; const float* s = lds + d2 * 65 + c * 8;
          u32x4 o; o.x = pack_bf16(s[0], s[1]); o.y = pack_bf16(s[2], s[3]); o.z = pack_bf16(s[4], s[5]); o.w = pack_bf16(s[6], s[7]);
          *(u32x4*)(dst + (size_t)d2 * 512 + c * 8) = o; }
        __syncthreads();
    }
    for (int e = bid * NT + tid; e < 196608; e += nb * NT) {
        bf16_t* dst = (bf16_t*)(ws + WS_LORA);
        float v;
        if (e < 131072) { const int which = e >> 16, r = e & 65535, i = r & 63, c = (r >> 6) & 255, ld = r >> 14;
            v = inp(P, which ? 29 : 27)[((size_t)ld * 64 + i) * 256 + c]; }
        else { const int r = e - 131072, i = r & 127, c = (r >> 7) & 255, l = r >> 15;
            v = inp(P, 30)[((size_t)l * 128 + i) * 256 + c]; }
        dst[e] = f2bf(v);
    }
    if (bid == 0 && tid < 512) {
        const int p = tid >> 3, f = tid & 7;
        float t = 1.f;
        t = (f == 1) ? 0.31622776601683794f : t; t = (f == 2) ? 0.1f : t; t = (f == 3) ? 0.031622776601683794f : t; t = (f == 4) ? 0.01f : t;
        t = (f == 5) ? 0.0031622776601683794f : t; t = (f == 6) ? 0.001f : t; t = (f == 7) ? 0.00031622776601683794f : t;
        double x = (double)t, x2 = x * x;
        double c = 1.0, s = x, tc = 1.0, tsn = x;
        for (int i = 1; i < 12; ++i) { tc *= -x2 / ((2.0 * i - 1.0) * (2.0 * i)); tsn *= -x2 / ((2.0 * i) * (2.0 * i + 1.0)); c += tc; s += tsn; }
        double cr = 1.0, sr = 0.0;
        for (int i = 0; i < p; ++i) { const double nc2 = cr * c - sr * s, ns2 = sr * c + cr * s; cr = nc2; sr = ns2; }
        float* R = (float*)(ws + WS_ROPE);
        R[(p * 8 + f) * 2 + 0] = (float)cr; R[(p * 8 + f) * 2 + 1] = (float)sr;
    }
}

__device__ __forceinline__ void phase_norm(const Params& P, int layer, int which, bool from_inputs, bool add_part, int glayer, int goff, bool do_norm, int rbase_blk) {
    const int tid = phase_tid(), lane = tid & 63, w = __builtin_amdgcn_readfirstlane(tid >> 6);
    unsigned char* ws = opaque_ws(P);
    float* OUT = outp(P);
    const float* X0 = inp(P, 0); const float* X1 = inp(P, 1);
    const float* gvec = inp(P, which ? 13 : 12) + layer * 1024;
    const float* modl = (const float*)(ws + WS_MOD) + (size_t)layer * 3 * 6144;
    const float* modg = (const float*)(ws + WS_MOD) + (size_t)glayer * 3 * 6144 + goff;
    const bf16_t* P0 = (const bf16_t*)(ws + WS_PART); const bf16_t* P1 = P0 + (size_t)MTOK * 1024;
    bf16_t* HN = (bf16_t*)(ws + WS_HN);
    const __amdgpu_buffer_rsrc_t rsO = wt_rsrc(OUT, (unsigned)MTOK * 1024 * 4), rsH = wt_rsrc(HN, (unsigned)MTOK * 1024 * 2);
    constexpr int RPW = MTOK / (256 * 8);
    static_assert(RPW == 4, "rows per wave");
    f32x4 x[RPW][4]; u32x2 xb[RPW][4], p0[RPW][4], p1[RPW][4];
    const int rbase = rbase_blk + w * RPW;
#pragma unroll
    for (int r = 0; r < RPW; ++r) {
        const int row = rbase + r;
        const float* xr = (row < CTXTOK) ? X0 + (size_t)row * 1024 : X1 + (size_t)(row - CTXTOK) * 1024;
        const bf16_t* xh = (const bf16_t*)(OUT + (size_t)row * 1024);
#pragma unroll
        for (int i = 0; i < 4; ++i) { const int c = lane * 4 + 256 * i;
            if (from_inputs) x[r][i] = *(const f32x4*)(xr + c); else xb[r][i] = *(const u32x2*)(xh + c);
            if (add_part) { p0[r][i] = *(const u32x2*)(P0 + (size_t)row * 1024 + c); p1[r][i] = *(const u32x2*)(P1 + (size_t)row * 1024 + c); } }
    }
    auto cvp = [&](const u32x2 u) -> f32x4 { f32x4 r; r[0] = __uint_as_float(u.x << 16); r[1] = __uint_as_float(u.x & 0xffff0000u); r[2] = __uint_as_float(u.y << 16); r[3] = __uint_as_float(u.y & 0xffff0000u); return r; };
    const bool odd = (lane & 1) != 0;
    auto st_pairs = [&](const __amdgpu_buffer_rsrc_t rs, size_t row_byte_off, const u32x2 (&pk)[4]) {
#pragma unroll
        for (int ip = 0; ip < 2; ++ip) {
            const u32x2 a = pk[2 * ip], b = pk[2 * ip + 1];
            u32x2 pa, pb;
            pa.x = (unsigned)__builtin_amdgcn_update_dpp(0, (int)a.x, 0xB1, 0xF, 0xF, true); pa.y = (unsigned)__builtin_amdgcn_update_dpp(0, (int)a.y, 0xB1, 0xF, 0xF, true);
            pb.x = (unsigned)__builtin_amdgcn_update_dpp(0, (int)b.x, 0xB1, 0xF, 0xF, true); pb.y = (unsigned)__builtin_amdgcn_update_dpp(0, (int)b.y, 0xB1, 0xF, 0xF, true);
            u32x4 o4; o4.x = odd ? pb.x : a.x; o4.y = odd ? pb.y : a.y; o4.z = odd ? b.x : pa.x; o4.w = odd ? b.y : pa.y;
            const int c0 = (lane & ~1) * 4 + 256 * (2 * ip + (odd ? 1 : 0));
            wt_st16(rs, (unsigned)(row_byte_off + (size_t)c0 * 2), o4);
        }
    };
#pragma unroll
    for (int r = 0; r < RPW; ++r) {
        const int row = rbase + r;
        const int cond = (row < CTXTOK) ? 0 : 1 + ((row - CTXTOK) >> 11);
        float ss = 0.f;
        u32x2 xpk[4];
#pragma unroll
        for (int i = 0; i < 4; ++i) {
            const int c = lane * 4 + 256 * i;
            if (!from_inputs) x[r][i] = cvp(xb[r][i]);
            if (add_part) {
                const f32x4 g = *(const f32x4*)(modg + cond * 6144 + c);
                x[r][i] += g * (cvp(p0[r][i]) + cvp(p1[r][i]));
                if (do_norm) { xpk[i].x = pack_bf16(x[r][i][0], x[r][i][1]); xpk[i].y = pack_bf16(x[r][i][2], x[r][i][3]); }
                else wt_st16(rsO, (unsigned)(((size_t)row * 1024 + c) * 4), __builtin_bit_cast(u32x4, x[r][i]));
            }
            ss += x[r][i][0] * x[r][i][0] + x[r][i][1] * x[r][i][1] + x[r][i][2] * x[r][i][2] + x[r][i][3] * x[r][i][3];
        }
        if (add_part && do_norm) st_pairs(rsO, (size_t)row * 4096, xpk);
        if (do_norm) {
            const float* sh = modl + cond * 6144 + (which ? 3072 : 0);
            const float* sc = sh + 1024;
            ss = allsum64(ss);
            const float rs = __builtin_amdgcn_rsqf(ss * (1.f / 1024.f) + 1e-6f);
            u32x2 pk[4];
#pragma unroll
            for (int i = 0; i < 4; ++i) {
                const int c = lane * 4 + 256 * i;
                const f32x4 g = *(const f32x4*)(gvec + c), s1 = *(const f32x4*)(sc + c), s0 = *(const f32x4*)(sh + c);
                f32x4 o = x[r][i] * rs * g * (s1 + 1.f) + s0;
                pk[i].x = pack_bf16(o[0], o[1]); pk[i].y = pack_bf16(o[2], o[3]);
            }
            st_pairs(rsH, (size_t)row * 2048, pk);
        }
    }
}

constexpr int GS = 72;
__device__ __forceinline__ void premix_item(const Params& P, int layer, int it, unsigned char* ldsraw, int secmask = 7) {
    const int tid = phase_tid(), lane = tid & 63, w = __builtin_amdgcn_readfirstlane(tid >> 6);
    unsigned char* ws = opaque_ws(P);
    const int g0 = it * 32;
    const TokInfo ti = tokinfo(g0);
    const int t0 = ti.t, L = ti.L, sb = ti.seqbase;
    const bf16_t* PROJ = (const bf16_t*)(ws + WS_PROJ);
    float* lds = (float*)ldsraw;
    if (layer == 0) STAMP(4);
    if (secmask & 1) {
        const int c = tid;
        const float* cw = inp(P, 16) + (size_t)layer * 5 * 512; const float cb = inp(P, 17)[layer * 512 + c];
        float wj[5];
#pragma unroll
        for (int j = 0; j < 5; ++j) wj[j] = cw[j * 512 + c];
        bf16_t* XBC = (bf16_t*)(ws + WS_XBC);
        auto ld = [&](int t) -> float { const int tc = min(max(t, 0), L - 1); const float vv = bf2f(PROJ[(size_t)(sb + tc) * NPROJ + PC_XBC + c]); return (t == tc) ? vv : 0.f; };
        float xx[36];
#pragma unroll
        for (int i = 0; i < 36; ++i) xx[i] = ld(t0 - 2 + i);
#pragma unroll
        for (int tt = 0; tt < 32; ++tt) {
            float v = cb + xx[tt] * wj[0] + xx[tt + 1] * wj[1] + xx[tt + 2] * wj[2] + xx[tt + 3] * wj[3] + xx[tt + 4] * wj[4];
            XBC[(size_t)(g0 + tt) * 512 + c] = f2bf(siluf(v));
        }
    }
    if ((secmask & 1) && tid < 256) {
        const int tt = tid >> 3, j = tid & 7;
        const float raw = bf2f(PROJ[(size_t)(g0 + tt) * NPROJ + PC_DT + j]);
        const float dtv = softplusf_(raw + inp(P, 19)[layer * 8 + j]);
        const float Aj = -__expf(inp(P, 18)[layer * 8 + j]);
        f32x2 o; o.x = dtv; o.y = __expf(dtv * Aj);
        *(f32x2*)((float*)(ws + WS_DTA) + ((size_t)(g0 + tt) * 8 + j) * 2) = o;
    }
    if (secmask & 1) {
        bf16_t* ZS = (bf16_t*)(ws + WS_ZS);
        unsigned zu[8];
#pragma unroll
        for (int i = 0; i < 8; ++i) { const int e = tid + NT * i, tt = e >> 7, cp = (e & 127) * 2; zu[i] = *(const unsigned*)(PROJ + (size_t)(g0 + tt) * NPROJ + PC_Z + cp); }
#pragma unroll
        for (int i = 0; i < 8; ++i) {
            const int e = tid + NT * i, tt = e >> 7, cp = (e & 127) * 2;
            const float a = siluf(bf2f((unsigned short)(zu[i] & 0xffff))), b = siluf(bf2f((unsigned short)(zu[i] >> 16)));
            *(unsigned*)(ZS + (size_t)(g0 + tt) * 256 + cp) = pack_bf16(a, b);
        }
    }
    __syncthreads(); if (layer == 0) STAMP(5);
    bf16_t* VS = (bf16_t*)ldsraw;
    if (secmask & 2) {
        const int c4 = lane * 4;
        const f32x4 gq = *(const f32x4*)(inp(P, 22) + layer * 64 + (c4 & 63)), gk = *(const f32x4*)(inp(P, 23) + layer * 64 + (c4 & 63));
        const f32x4 dgq = *(const f32x4*)(inp(P, 36) + layer * 32 + (c4 & 31)), dgk = *(const f32x4*)(inp(P, 37) + layer * 32 + (c4 & 31));
        const float* ROPE = (const float*)(ws + WS_ROPE);
        auto ld4 = [&](const bf16_t* p) -> f32x4 { const u32x2 u = *(const u32x2*)p; f32x4 r; r[0] = bf2f((unsigned short)(u.x & 0xffff)); r[1] = bf2f((unsigned short)(u.x >> 16)); r[2] = bf2f((unsigned short)(u.y & 0xffff)); r[3] = bf2f((unsigned short)(u.y >> 16)); return r; };
        auto st4 = [&](bf16_t* p, f32x4 v) { u32x2 pk; pk.x = pack_bf16(v[0], v[1]); pk.y = pack_bf16(v[2], v[3]); *(u32x2*)p = pk; };
        u32x2 raw[4][6];
#pragma unroll
        for (int i = 0; i < 4; ++i) { const bf16_t* pr = PROJ + (size_t)(g0 + w * 4 + i) * NPROJ;
#pragma unroll
            for (int a = 0; a < 3; ++a) { raw[i][a] = *(const u32x2*)(pr + PC_NAT + 256 * a + c4); raw[i][3 + a] = *(const u32x2*)(pr + PC_DIFF + 256 * a + c4); } }
        auto cv4 = [&](const u32x2 u) -> f32x4 { f32x4 r; r[0] = __uint_as_float(u.x << 16); r[1] = __uint_as_float(u.x & 0xffff0000u); r[2] = __uint_as_float(u.y << 16); r[3] = __uint_as_float(u.y & 0xffff0000u); return r; };
#pragma unroll
        for (int i = 0; i < 4; ++i) {
            const int tt = w * 4 + i, g = g0 + tt, t = t0 + tt;
            {
                f32x4 q = cv4(raw[i][0]), k = cv4(raw[i][1]), v = cv4(raw[i][2]);
                float sq = allsum16(q[0] * q[0] + q[1] * q[1] + q[2] * q[2] + q[3] * q[3]);
                float sk = allsum16(k[0] * k[0] + k[1] * k[1] + k[2] * k[2] + k[3] * k[3]);
                const float rq = __builtin_amdgcn_rsqf(sq * (1.f / 64.f) + 1e-6f) * (0.125f * LOG2E), rk = __builtin_amdgcn_rsqf(sk * (1.f / 64.f) + 1e-6f);
                q = q * rq * gq; k = k * rk * gk;
                st4((bf16_t*)(ws + WS_QN) + (size_t)g * 256 + c4, q);
                st4((bf16_t*)(ws + WS_KN) + (size_t)g * 256 + c4, k);
                if (ti.isctx) {
                    const size_t o = ((size_t)((ti.sidx * 2 + layer) * 256 + t)) * 256 + c4;
                    *(f32x4*)(outp(P) + O_NATK + o) = k; *(f32x4*)(outp(P) + O_NATV + o) = v;
                }
#pragma unroll
                for (int e = 0; e < 4; ++e) VS[(c4 + e) * 40 + tt] = f2bf(v[e]);
            }
            {
                f32x4 q = cv4(raw[i][3]), k = cv4(raw[i][4]), v = cv4(raw[i][5]);
                float sq = allsum8(q[0] * q[0] + q[1] * q[1] + q[2] * q[2] + q[3] * q[3]);
                float sk = allsum8(k[0] * k[0] + k[1] * k[1] + k[2] * k[2] + k[3] * k[3]);
                const float rq = __builtin_amdgcn_rsqf(sq * (1.f / 32.f) + 1e-6f), rk = __builtin_amdgcn_rsqf(sk * (1.f / 32.f) + 1e-6f);
                q = q * rq * dgq; k = k * rk * dgk;
                if (ti.isctx) {
                    const size_t o = ((size_t)((ti.sidx * 2 + layer) * 256 + t)) * 256 + c4;
                    *(f32x4*)(outp(P) + O_DIFFK + o) = k; *(f32x4*)(outp(P) + O_DIFFV + o) = v;
                } else {
                    const int blk = (c4 >> 4) & 1, pos = blk ? (t & 63) : (t >> 6), f0 = c4 & 7;
                    const bool isu2 = (lane & 2) != 0;
                    f32x4 qp, kp;
#pragma unroll
                    for (int e = 0; e < 4; ++e) { qp[e] = dpp_mov<0x4E>(q[e]); kp[e] = dpp_mov<0x4E>(k[e]); }
#pragma unroll
                    for (int e = 0; e < 4; ++e) {
                        const f32x2 cs = *(const f32x2*)(ROPE + (pos * 8 + f0 + e) * 2);
                        const float sgn = isu2 ? cs.y : -cs.y;
                        q[e] = q[e] * cs.x + qp[e] * sgn; k[e] = k[e] * cs.x + kp[e] * sgn;
                    }
                }
                q = q * (0.17677669529663687f * LOG2E);
                st4((bf16_t*)(ws + WS_QD) + (size_t)g * 256 + c4, q);
                st4((bf16_t*)(ws + WS_KD) + (size_t)g * 256 + c4, k);
#pragma unroll
                for (int e = 0; e < 4; ++e) VS[256 * 40 + (c4 + e) * 40 + tt] = f2bf(v[e]);
            }
        }
        __syncthreads();
        {
            const int ch = tid >> 1, hf = tid & 1, h = ch >> 6, d = ch & 63;
            size_t o;
            if (ti.isctx) o = ((size_t)((ti.sidx * 4 + h) * 64 + d)) * 256 + t0 + hf * 16;
            else o = (size_t)1048576 + ((size_t)((ti.sidx * 4 + h) * 64 + d)) * 2048 + t0 + hf * 16;
#pragma unroll
            for (int a = 0; a < 2; ++a) {
                const bf16_t* s = VS + a * 256 * 40 + ch * 40 + hf * 16;
                bf16_t* dst = (bf16_t*)(ws + (a ? WS_VTD : WS_VTN)) + o;
                *(u32x4*)dst = *(const u32x4*)s; *(u32x4*)(dst + 8) = *(const u32x4*)(s + 8);
            }
        }
        __syncthreads();
    }
    if (layer == 0) STAMP(6);
    if (secmask & 28) {
        const bool doA = (secmask & 12) != 0, doB = (secmask & 20) != 0;
        float* KS = lds; float* RS = lds + 32 * 260; float* VR = lds + 2 * 32 * 260;
        bf16_t* LRb = (bf16_t*)(ldsraw + 99840);
        float* NRM = (float*)(ldsraw + 124928);
        const float* cwr = inp(P, 25) + (size_t)layer * 3 * 1152;
        auto conv_load = [&](int ch, unsigned short (&x)[34]) {
#pragma unroll
            for (int i = 0; i < 34; ++i) { const int t = t0 - 1 + i, tc = min(max(t, 0), L - 1); x[i] = PROJ[(size_t)(sb + tc) * NPROJ + PC_RW + ch]; }
        };
        auto conv_comp = [&](int ch, const unsigned short (&x)[34], float (&o)[32]) {
            const float w0 = cwr[ch], w1 = cwr[1152 + ch], w2 = cwr[2304 + ch];
            float xf[34];
#pragma unroll
            for (int i = 0; i < 34; ++i) { const int t = t0 - 1 + i; xf[i] = (t >= 0 && t < L) ? bf2f(x[i]) : 0.f; }
#pragma unroll
            for (int i = 0; i < 32; ++i) o[i] = xf[i] * w0 + xf[i + 1] * w1 + xf[i + 2] * w2;
        };
        unsigned short x1[34], x2[34];
        if (doA) { conv_load(tid, x1); conv_load(512 + tid, x2); }
        if (doA) {
            float o[32]; conv_comp(tid, x1, o);
            if (w < 4) {
#pragma unroll
                for (int i = 0; i < 32; ++i) RS[i * 260 + tid] = o[i];
            } else {
                const int c = tid - 256; const float kkc = inp(P, 31)[layer * 256 + c];
#pragma unroll
                for (int i = 0; i < 32; ++i) { KS[i * 260 + c] = o[i]; const float sv = o[i] * kkc; const float ss = wavesum64(sv * sv);
                    if (lane == 0) NRM[i * 4 + (w - 4)] = fminf(__builtin_amdgcn_rsqf(ss), 1e12f); }
            }
        }
        if (layer == 0) STAMP(13);
        if (doA) {
            float o[32]; conv_comp(512 + tid, x2, o);
            if (w < 4) {
#pragma unroll
                for (int i = 0; i < 32; ++i) VR[i * 260 + tid] = o[i];
            } else {
                const int lc = tid - 256;
#pragma unroll
                for (int i = 0; i < 32; ++i) LRb[i * 392 + lc] = f2bf(w < 6 ? tanhf_(o[i]) : o[i]);
            }
        }
        if (layer == 0) STAMP(14);
        if (doA && w < 2) {
            unsigned short x3[34]; conv_load(1024 + tid, x3); float o[32]; conv_comp(1024 + tid, x3, o);
#pragma unroll
            for (int i = 0; i < 32; ++i) LRb[i * 392 + 256 + tid] = f2bf(sigmoidf_(o[i]));
        }
        __syncthreads();
        if (layer == 0) STAMP(15);
        if (doA && w < 4) {
            const float rkc = inp(P, 33)[layer * 256 + tid];
            float* BON = (float*)(ws + WS_BON);
#pragma unroll 8
            for (int i = 0; i < 32; ++i) { const float b = wavesum64(RS[i * 260 + tid] * KS[i * 260 + tid] * rkc); if (lane == 0) BON[(size_t)(g0 + i) * 4 + w] = b; }
        }
        __syncthreads(); if (layer == 0) STAMP(7);
        const int l15 = lane & 15, quad = lane >> 4, cbase = 32 * w;
        const bf16_t* WUP = (const bf16_t*)(ws + WS_LORA);
        const bf16_t* AUP = WUP + 65536; const bf16_t* GUP = WUP + 131072;
        bf16_t* RWb = (bf16_t*)(ws + WS_RWB); float* DEC = (float*)(ws + WS_DEC);
        const f32x4 z4 = {0.f, 0.f, 0.f, 0.f};
#pragma unroll
        for (int cb = 0; cb < (doB ? 2 : 0); ++cb) {
            const int crow = cbase + cb * 16 + l15;
            bf16x8 wf[2][2], af[2][2], gf[4];
#pragma unroll
            for (int d = 0; d < 2; ++d)
#pragma unroll
                for (int ks = 0; ks < 2; ++ks) { wf[d][ks] = *(const bf16x8*)(WUP + ((size_t)((layer * 2 + d) * 256 + crow)) * 64 + ks * 32 + quad * 8);
                                                 af[d][ks] = *(const bf16x8*)(AUP + ((size_t)((layer * 2 + d) * 256 + crow)) * 64 + ks * 32 + quad * 8); }
#pragma unroll
            for (int ks = 0; ks < 4; ++ks) gf[ks] = *(const bf16x8*)(GUP + ((size_t)(layer * 256 + crow)) * 128 + ks * 32 + quad * 8);
            const int cpar = cbase + cb * 16 + 4 * quad;
            const f32x4 p_kk = *(const f32x4*)(inp(P, 31) + layer * 256 + cpar), p_ka = *(const f32x4*)(inp(P, 32) + layer * 256 + cpar);
            f32x4 p_w0[2], p_a0[2];
#pragma unroll
            for (int d = 0; d < 2; ++d) { p_w0[d] = *(const f32x4*)(inp(P, 26) + (layer * 2 + d) * 256 + cpar); p_a0[d] = *(const f32x4*)(inp(P, 28) + (layer * 2 + d) * 256 + cpar); }
#pragma unroll
            for (int tb = 0; tb < 2; ++tb) {
                f32x4 aW[2] = {z4, z4}, aA[2] = {z4, z4}, aG = z4;
                const bf16_t* lr = LRb + (tb * 16 + l15) * 392 + quad * 8;
#pragma unroll
                for (int d = 0; d < 2; ++d)
#pragma unroll
                    for (int ks = 0; ks < 2; ++ks) {
                        aW[d] = __builtin_amdgcn_mfma_f32_16x16x32_bf16(wf[d][ks], *(const bf16x8*)(lr + d * 64 + ks * 32), aW[d], 0, 0, 0);
                        aA[d] = __builtin_amdgcn_mfma_f32_16x16x32_bf16(af[d][ks], *(const bf16x8*)(lr + 128 + d * 64 + ks * 32), aA[d], 0, 0, 0);
                    }
#pragma unroll
                for (int ks = 0; ks < 4; ++ks) aG = __builtin_amdgcn_mfma_f32_16x16x32_bf16(gf[ks], *(const bf16x8*)(lr + 256 + ks * 32), aG, 0, 0, 0);
                const int t = tb * 16 + l15, c = cbase + cb * 16 + 4 * quad, head = c >> 6;
                const size_t o = (size_t)(g0 + t) * 256 + c;
                const f32x4 k4 = *(const f32x4*)(KS + t * 260 + c), r4 = *(const f32x4*)(RS + t * 260 + c), v4 = *(const f32x4*)(VR + t * 260 + c);
                const float rn = NRM[t * 4 + head];
                const f32x4 kk4 = k4 * p_kk * rn;
                const f32x4 ka4 = p_ka;
                st4bf(RWb + o, r4); st4bf(RWb + RWB + o, kk4); st4bf(RWb + 2 * RWB + o, v4); st4bf(RWb + 7 * RWB + o, aG);
#pragma unroll
                for (int d = 0; d < 2; ++d) {
                    const f32x4 w0 = p_w0[d], a0 = p_a0[d];
                    f32x4 dec, kka, kt;
#pragma unroll
                    for (int e = 0; e < 4; ++e) {
                        const float wl = -softplusf_(-(w0[e] + aW[d][e])) - 0.5f;
                        dec[e] = __expf(-__expf(wl));
                        const float a = sigmoidf_(a0[e] + aA[d][e]);
                        kt[e] = k4[e] * (1.f + (a - 1.f) * ka4[e]);
                        kka[e] = kk4[e] * a;
                    }
                    *(f32x4*)(DEC + d * RWB + o) = dec; st4bf(RWb + (3 + d) * RWB + o, kka); st4bf(RWb + (5 + d) * RWB + o, kt);
                }
            }
        }
        __syncthreads();
    }
}

typedef short bf16x4 __attribute__((ext_vector_type(4)));
#define MFMA32(a, b, c) __builtin_amdgcn_mfma_f32_16x16x32_bf16(__builtin_bit_cast(bf16x8, a), __builtin_bit_cast(bf16x8, b), c, 0, 0, 0)
#define MFMA16(a, b, c) __builtin_amdgcn_mfma_f32_16x16x16bf16_1k(__builtin_bit_cast(bf16x4, a), __builtin_bit_cast(bf16x4, b), c, 0, 0, 0)
constexpr int PREP_WLDS = 10496;
__device__ __forceinline__ void lds_barrier() { asm volatile("s_waitcnt lgkmcnt(0)" ::: "memory"); __builtin_amdgcn_s_barrier(); asm volatile("" ::: "memory"); }
struct PrepR { float dec[16]; unsigned kk[8], kka[8], kt[8], r[8]; };
struct PrepS { float dtv[16]; unsigned cv[8], bv[8]; };
__device__ __forceinline__ void prep_tile(const Params& P, int layer, int it, unsigned char* ldsraw) {
    const int tid = phase_tid(), lane = tid & 63, w = __builtin_amdgcn_readfirstlane(tid >> 6), l15 = lane & 15, q = lane >> 4;
    const int h = w >> 1, dir = w & 1, grp = h >> 1;
    unsigned char* ws = opaque_ws(P);
    unsigned char* wl = ldsraw + w * PREP_WLDS;
    bf16_t* L0 = (bf16_t*)wl; bf16_t* L1 = L0 + 16 * 72; bf16_t* L2 = L1 + 16 * 72; bf16_t* L3 = L2 + 16 * 72;
    float* NL = (float*)(wl + 9216); float* CSL = (float*)(wl + 9216 + 1024);
    const f32x4 z4 = {0.f, 0.f, 0.f, 0.f};
    const bf16_t* RWb = (const bf16_t*)(ws + WS_RWB);
    const float* DEC = (const float*)(ws + WS_DEC) + (size_t)dir * RWB;
    const bf16_t* aR = RWb, *aKK = RWb + RWB, *aKKA = RWb + (3 + dir) * RWB, *aKT = RWb + (5 + dir) * RWB;
    const bf16_t* XBC = (const bf16_t*)(ws + WS_XBC);
    const float* DTA = (const float*)(ws + WS_DTA);
    auto lo16 = [](unsigned u) -> float { return __uint_as_float(u << 16); };
    auto hi16 = [](unsigned u) -> float { return __uint_as_float(u & 0xffff0000u); };
    auto load_r = [&](int cn_g, PrepR& r) {
        const int base = cn_g * 16;
#pragma unroll
        for (int n = 0; n < 16; n += 2) {
            const size_t o0 = (size_t)(base + (dir ? 15 - n : n)) * 256 + h * 64 + lane, o1 = (size_t)(base + (dir ? 14 - n : n + 1)) * 256 + h * 64 + lane;
            r.dec[n] = DEC[o0]; r.dec[n + 1] = DEC[o1];
            r.kk[n >> 1] = (unsigned)aKK[o0] | ((unsigned)aKK[o1] << 16); r.kka[n >> 1] = (unsigned)aKKA[o0] | ((unsigned)aKKA[o1] << 16);
            r.kt[n >> 1] = (unsigned)aKT[o0] | ((unsigned)aKT[o1] << 16); r.r[n >> 1] = (unsigned)aR[o0] | ((unsigned)aR[o1] << 16);
        }
    };
    auto load_s = [&](int cn_g, PrepS& r) {
        const int base = cn_g * 16;
#pragma unroll
        for (int n = 0; n < 16; n += 2) {
            const int t0 = base + (dir ? 15 - n : n), t1 = base + (dir ? 14 - n : n + 1);
            r.dtv[n] = DTA[((size_t)t0 * 8 + dir * 4 + h) * 2]; r.dtv[n + 1] = DTA[((size_t)t1 * 8 + dir * 4 + h) * 2];
            r.cv[n >> 1] = (unsigned)XBC[(size_t)t0 * 512 + 384 + grp * 64 + lane] | ((unsigned)XBC[(size_t)t1 * 512 + 384 + grp * 64 + lane] << 16);
            r.bv[n >> 1] = (unsigned)XBC[(size_t)t0 * 512 + 256 + grp * 64 + lane] | ((unsigned)XBC[(size_t)t1 * 512 + 256 + grp * 64 + lane] << 16);
        }
    };
    auto comp_r = [&](int cn_g, const PrepR& in) {
        unsigned char* U = ws + WS_CHR + chr_unit_off(cn_g, h, dir);
        float g = 1.f;
#pragma unroll
        for (int n = 0; n < 16; ++n) { const float gp = g; g *= in.dec[n]; const float ig = frcp(g);
            const float kkf = (n & 1) ? hi16(in.kk[n >> 1]) : lo16(in.kk[n >> 1]), kkaf = (n & 1) ? hi16(in.kka[n >> 1]) : lo16(in.kka[n >> 1]);
            const float ktf = (n & 1) ? hi16(in.kt[n >> 1]) : lo16(in.kt[n >> 1]), rf = (n & 1) ? hi16(in.r[n >> 1]) : lo16(in.r[n >> 1]);
            L0[n * 72 + lane] = f2bf(kkf * gp); L1[n * 72 + lane] = f2bf(kkaf * ig);
            L2[n * 72 + lane] = f2bf(ktf * ig); L3[n * 72 + lane] = f2bf(rf * g); }
        ((float*)(U + 10240))[lane] = g;
        lds_barrier();
        f32x4 n1 = z4, n2 = z4, n3 = z4, n4 = z4;
#pragma unroll
        for (int ks = 0; ks < 2; ++ks) {
            const u32x4 fK = *(const u32x4*)(L0 + l15 * 72 + ks * 32 + q * 8), fB = *(const u32x4*)(L1 + l15 * 72 + ks * 32 + q * 8),
                        fT = *(const u32x4*)(L2 + l15 * 72 + ks * 32 + q * 8), fR = *(const u32x4*)(L3 + l15 * 72 + ks * 32 + q * 8);
            n1 = MFMA32(fB, fK, n1); n2 = MFMA32(fT, fK, n2); n3 = MFMA32(fB, fR, n3); n4 = MFMA32(fT, fR, n4);
        }
#pragma unroll
        for (int e = 0; e < 4; ++e) { const int i = 4 * q + e; const bool lt = i < l15, le = i <= l15;
            n1[e] = lt ? n1[e] : 0.f; n2[e] = lt ? n2[e] : 0.f; n3[e] = le ? -n3[e] : 0.f; n4[e] = le ? n4[e] : 0.f;
            NL[i * 16 + l15] = n1[e]; }
        { u32x2 xa; xa.x = pack_bf16(n2[0], n2[1]); xa.y = pack_bf16(n2[2], n2[3]); *(u32x2*)(U + 9728 + lane * 8) = xa;
          u32x4 ya; ya.x = pack_bf16(n3[0], n3[1]); ya.y = pack_bf16(n3[2], n3[3]); ya.z = pack_bf16(n4[0], n4[1]); ya.w = pack_bf16(n4[2], n4[3]); *(u32x4*)(U + 8192 + lane * 16) = ya; }
#pragma unroll
        for (int ks = 0; ks < 2; ++ks) {
            const u32x2 a = *(const u32x2*)(L0 + l15 * 72 + 32 * ks + 4 * q), b = *(const u32x2*)(L0 + l15 * 72 + 32 * ks + 16 + 4 * q);
            *(u32x4*)(U + ks * 1024 + lane * 16) = (u32x4){a.x, a.y, b.x, b.y};
            const u32x2 c = *(const u32x2*)(L3 + l15 * 72 + 32 * ks + 4 * q), d = *(const u32x2*)(L3 + l15 * 72 + 32 * ks + 16 + 4 * q);
            *(u32x4*)(U + 2048 + ks * 1024 + lane * 16) = (u32x4){c.x, c.y, d.x, d.y};
        }
#pragma unroll
        for (int rb = 0; rb < 4; ++rb) {
            unsigned bb[4], kk2[4];
#pragma unroll
            for (int j = 0; j < 4; ++j) { bb[j] = (unsigned)L1[(4 * q + j) * 72 + 16 * rb + l15] ^ 0x8000u; kk2[j] = (unsigned)L2[(4 * q + j) * 72 + 16 * rb + l15]; }
            *(u32x4*)(U + 4096 + rb * 1024 + lane * 16) = (u32x4){bb[0] | (bb[1] << 16), bb[2] | (bb[3] << 16), kk2[0] | (kk2[1] << 16), kk2[2] | (kk2[3] << 16)};
        }
        lds_barrier();
        float x[16];
#pragma unroll
        for (int i = 0; i < 16; ++i) x[i] = (i == l15) ? 1.f : 0.f;
#pragma unroll
        for (int i = 14; i >= 0; --i) { float sacc = 0.f;
#pragma unroll
            for (int j = i + 1; j < 16; ++j) sacc += NL[i * 16 + j] * x[j];
            x[i] = (i < l15) ? -sacc : x[i]; }
        { float m[4];
#pragma unroll
          for (int j = 0; j < 4; ++j) m[j] = (q == 0) ? x[j] : (q == 1) ? x[4 + j] : (q == 2) ? x[8 + j] : x[12 + j];
          u32x2 mi; mi.x = pack_bf16(m[0], m[1]); mi.y = pack_bf16(m[2], m[3]); *(u32x2*)(U + 9216 + lane * 8) = mi; }
        lds_barrier();
    };
    auto comp_s = [&](int cn_g, const PrepS& in) {
        const int unit = (cn_g * 4 + h) * 2 + dir;
        unsigned char* U = ws + WS_CHS + (size_t)unit * CHS_U;
        const float Ah = -__expf(inp(P, 18)[layer * 8 + dir * 4 + h]);
        float cs[16]; float c = 0.f;
#pragma unroll
        for (int n = 0; n < 16; ++n) { if (lane == 0) ((float*)(U + 4624))[n] = in.dtv[n]; c += in.dtv[n] * Ah; cs[n] = c; }
#pragma unroll
        for (int n = 0; n < 16; ++n) {
            const unsigned cu = (n & 1) ? (in.cv[n >> 1] >> 16) : (in.cv[n >> 1] & 0xffffu), bu = (n & 1) ? (in.bv[n >> 1] >> 16) : (in.bv[n >> 1] & 0xffffu);
            L0[n * 72 + lane] = (bf16_t)cu; L1[n * 72 + lane] = (bf16_t)bu;
            L2[n * 72 + lane] = f2bf(bf2f((bf16_t)cu) * __expf(cs[n])); L3[n * 72 + lane] = f2bf(bf2f((bf16_t)bu) * __expf(cs[15] - cs[n]));
            if (lane == 0) CSL[n] = cs[n]; }
        if (lane == 0) *(float*)(U + 4608) = __expf(cs[15]);
        lds_barrier();
        f32x4 gt = z4;
#pragma unroll
        for (int ks = 0; ks < 2; ++ks) gt = MFMA32(*(const u32x4*)(L1 + l15 * 72 + ks * 32 + q * 8), *(const u32x4*)(L0 + l15 * 72 + ks * 32 + q * 8), gt);
        { const float cst = CSL[l15]; float gg[4];
#pragma unroll
          for (int e = 0; e < 4; ++e) { const int i = 4 * q + e; gg[e] = (i <= l15) ? gt[e] * __expf(cst - CSL[i]) : 0.f; }
          u32x2 ga; ga.x = pack_bf16(gg[0], gg[1]); ga.y = pack_bf16(gg[2], gg[3]); *(u32x2*)(U + 2048 + lane * 8) = ga; }
#pragma unroll
        for (int ks = 0; ks < 2; ++ks) {
            const u32x2 a = *(const u32x2*)(L2 + l15 * 72 + 32 * ks + 4 * q), b = *(const u32x2*)(L2 + l15 * 72 + 32 * ks + 16 + 4 * q);
            *(u32x4*)(U + ks * 1024 + lane * 16) = (u32x4){a.x, a.y, b.x, b.y};
        }
#pragma unroll
        for (int rb = 0; rb < 4; ++rb) {
            unsigned bb[4];
#pragma unroll
            for (int j = 0; j < 4; ++j) bb[j] = (unsigned)L3[(4 * q + j) * 72 + 16 * rb + l15];
            *(u32x2*)(U + 2560 + rb * 512 + lane * 8) = (u32x2){bb[0] | (bb[1] << 16), bb[2] | (bb[3] << 16)};
        }
        lds_barrier();
    };
    PrepR ra, rb2; PrepS sa, sb2;
    load_r(2 * it, ra); load_s(2 * it, sa);
    comp_r(2 * it, ra);
    load_r(2 * it + 1, rb2);
    comp_s(2 * it, sa);
    load_s(2 * it + 1, sb2);
    comp_r(2 * it + 1, rb2);
    comp_s(2 * it + 1, sb2);
}

__device__ __forceinline__ void rwkv_cscan_item(const Params& P, int layer, int sidx_all, int h, int dir, unsigned char* ldsraw, int mode) {
    const int tid = phase_tid(), lane = tid & 63, w = __builtin_amdgcn_readfirstlane(tid >> 6), l15 = lane & 15, q = lane >> 4;
    const bool loader = w >= 4; const int vq = w & 3, ltid = tid & 255;
    const bool isctx = sidx_all < 16;
    const int L = isctx ? 256 : 2048, sb = isctx ? sidx_all * 256 : CTXTOK + (sidx_all - 16) * 2048, nch = L / 16;
    unsigned char* ws = opaque_ws(P);
    const unsigned char* CHR = ws + WS_CHR;
    const unsigned char* Vrow = ws + WS_RWB + 2 * RWB * 2 + h * 128;
    const int b = isctx ? sidx_all : sidx_all - 16;
    const int cbeg = (mode >= 2) ? nch / 2 : 0, cend = (mode == 1) ? nch / 2 : nch;
    bf16_t* Yb = (mode == 3) ? (bf16_t*)(ws + WS_QR) + (size_t)(dir * 2 + b) * 1024 * 256 : (bf16_t*)(ws + (dir ? WS_YRB : WS_YRF));
    const int yo = h * 64 + 16 * vq + l15 + (dir ? -4 * q : 4 * q) * 256, ystep = dir ? -256 : 256;
    const size_t sidx = ((size_t)(((b * 2 + layer) * 2 + dir) * 4 + h) * 64 + 16 * vq + l15) * 64;
    constexpr int D = 4, SLOT = CHR_U + 2048, NPC = 4, NPIECE = CHR_U / 16 + 128;
    int poff[NPC], plo[NPC]; bool pv[NPC], pc[NPC];
#pragma unroll
    for (int k = 0; k < NPC; ++k) { const int p = ltid + 256 * k; pv[k] = loader && p < NPIECE; pc[k] = p < 656; plo[k] = (p < 656 ? p * 16 : CHR_U + (p - 656) * 16);
        const int vr = p - 656; poff[k] = pc[k] ? p * 16 : (dir ? -(vr >> 3) : (vr >> 3)) * 512 + (vr & 7) * 16; }
    auto tokd = [&](int n) -> int { return sb + (dir ? (L - 1 - n) : n); };
    auto ytok = [&](int n) -> int { return (mode == 3) ? (dir ? (L - 1 - n) : (n - 1024)) : tokd(n); };
    auto gl = [&](int c, u32x4 (&R)[NPC]) {
        const unsigned char* bC = CHR + chr_unit_off((sb >> 4) + (dir ? nch - 1 - c : c), h, dir);
        const unsigned char* bV = Vrow + (size_t)tokd(c * 16) * 512;
#pragma unroll
        for (int k = 0; k < NPC; ++k) if (pv[k]) R[k] = *(const u32x4*)((pc[k] ? bC : bV) + poff[k]);
    };
    auto st = [&](int slot, const u32x4 (&R)[NPC]) {
#pragma unroll
        for (int k = 0; k < NPC; ++k) if (pv[k]) *(u32x4*)(ldsraw + slot * SLOT + plo[k]) = R[k];
    };
    struct Ops { u32x4 kp0, kp1, su0, su1, su2, su3; u32x2 mi, xa, vb; f32x4 g0, g1, g2, g3; };
    struct YOps { u32x4 rp0, rp1, ya; };
    constexpr int HBOFF = 3 * SLOT;
    auto hb_ptr = [&](int c) -> unsigned char* { return ldsraw + HBOFF + (((c & 1) * 4 + vq) * 64 + lane) * 48; };
    auto lds_ops = [&](int slot) -> Ops {
        const unsigned char* U = ldsraw + slot * SLOT; Ops o;
        o.kp0 = *(const u32x4*)(U + lane * 16); o.kp1 = *(const u32x4*)(U + 1024 + lane * 16);
        o.su0 = *(const u32x4*)(U + 4096 + lane * 16); o.su1 = *(const u32x4*)(U + 5120 + lane * 16); o.su2 = *(const u32x4*)(U + 6144 + lane * 16); o.su3 = *(const u32x4*)(U + 7168 + lane * 16);
        o.mi = *(const u32x2*)(U + 9216 + lane * 8); o.xa = *(const u32x2*)(U + 9728 + lane * 8);
        const float* gt = (const float*)(U + 10240) + 4 * q;
        o.g0 = *(const f32x4*)gt; o.g1 = *(const f32x4*)(gt + 16); o.g2 = *(const f32x4*)(gt + 32); o.g3 = *(const f32x4*)(gt + 48);
        const bf16_t* vl = (const bf16_t*)(U + CHR_U) + (4 * q) * 64 + 16 * vq + l15;
        o.vb.x = (unsigned)vl[0] | ((unsigned)vl[64] << 16); o.vb.y = (unsigned)vl[128] | ((unsigned)vl[192] << 16);
        if (mode == 3) { o.vb.x = 0u; o.vb.y = 0u; }
        return o;
    };
    f32x4 Z[4];
#pragma unroll
    for (int rb = 0; rb < 4; ++rb) {
        if (isctx || loader || mode == 2) Z[rb] = (f32x4){0.f, 0.f, 0.f, 0.f};
        else if (mode == 3) { for (int e = 0; e < 4; ++e) Z[rb][e] = (16 * rb + 4 * q + e == 16 * vq + l15) ? 1.f : 0.f; }
        else Z[rb] = *(const f32x4*)(inp(P, 5) + sidx + 16 * rb + 4 * q);
    }
    const f32x4 z4 = {0.f, 0.f, 0.f, 0.f};
    auto compute = [&](int c, const Ops& o) {
        u32x4 zb0, zb1;
        zb0.x = pack_bf16(Z[0][0], Z[0][1]); zb0.y = pack_bf16(Z[0][2], Z[0][3]); zb0.z = pack_bf16(Z[1][0], Z[1][1]); zb0.w = pack_bf16(Z[1][2], Z[1][3]);
        zb1.x = pack_bf16(Z[2][0], Z[2][1]); zb1.y = pack_bf16(Z[2][2], Z[2][3]); zb1.z = pack_bf16(Z[3][0], Z[3][1]); zb1.w = pack_bf16(Z[3][2], Z[3][3]);
        f32x4 X = MFMA16(o.xa, o.vb, z4); X = MFMA32(o.kp0, zb0, X); X = MFMA32(o.kp1, zb1, X);
        u32x2 xb; xb.x = pack_bf16(X[0], X[1]); xb.y = pack_bf16(X[2], X[3]);
        const f32x4 Uv = MFMA16(o.mi, xb, z4);
        u32x4 uv; uv.x = pack_bf16(Uv[0], Uv[1]); uv.y = pack_bf16(Uv[2], Uv[3]); uv.z = o.vb.x; uv.w = o.vb.y;
        Z[0] = MFMA32(o.su0, uv, Z[0]) * o.g0; Z[1] = MFMA32(o.su1, uv, Z[1]) * o.g1; Z[2] = MFMA32(o.su2, uv, Z[2]) * o.g2; Z[3] = MFMA32(o.su3, uv, Z[3]) * o.g3;
        { unsigned char* hb = hb_ptr(c); *(u32x4*)hb = zb0; *(u32x4*)(hb + 16) = zb1; *(u32x4*)(hb + 32) = uv; }
    };
    auto y_ops = [&](int slot) -> YOps { const unsigned char* U = ldsraw + slot * SLOT; YOps o;
        o.rp0 = *(const u32x4*)(U + 2048 + lane * 16); o.rp1 = *(const u32x4*)(U + 3072 + lane * 16); o.ya = *(const u32x4*)(U + 8192 + lane * 16); return o; };
    auto y_chunk = [&](int c, const YOps& o) {
        const unsigned char* hb = hb_ptr(c);
        const u32x4 zb0 = *(const u32x4*)hb, zb1 = *(const u32x4*)(hb + 16), uv = *(const u32x4*)(hb + 32);
        f32x4 Yv = MFMA32(o.rp0, zb0, z4); Yv = MFMA32(o.rp1, zb1, Yv); Yv = MFMA32(o.ya, uv, Yv);
        bf16_t* Yc = Yb + (size_t)ytok(c * 16) * 256;
#pragma unroll
        for (int e = 0; e < 4; ++e) Yc[yo + e * ystep] = f2bf(Yv[e]);
    };
    if (loader) {
        u32x4 R[D][NPC];
        gl(cbeg, R[0]); gl(cbeg + 1, R[1]); st(cbeg % 3, R[0]); st((cbeg + 1) % 3, R[1]);
#pragma unroll
        for (int k = 0; k < D; ++k) if (cbeg + k + 2 < cend) gl(cbeg + k + 2, R[k]);
        __syncthreads();
        YOps yo_prev, yo_cur = y_ops(cbeg % 3);
        for (int c0 = cbeg; c0 < cend; c0 += D) {
#pragma unroll
            for (int k = 0; k < D; ++k) {
                const int c = c0 + k;
                if (c > cbeg) y_chunk(c - 1, yo_prev);
                yo_prev = yo_cur;
                if (c + 1 < cend) yo_cur = y_ops((c + 1) % 3);
                if (c + 2 < cend) st((c + 2) % 3, R[k]);
                if (c + 2 + D < cend) gl(c + 2 + D, R[k]);
                lds_barrier();
            }
        }
        y_chunk(cend - 1, yo_prev);
    } else {
        __syncthreads();
        Ops cur = lds_ops(cbeg % 3);
        for (int c = cbeg; c < cend; ++c) {
            Ops nxt = cur;
            if (c + 1 < cend) nxt = lds_ops((c + 1) % 3);
            compute(c, cur);
            cur = nxt;
            lds_barrier();
        }
    }
    if (isctx && !loader) {
        float* So = outp(P) + O_RWKV + sidx;
#pragma unroll
        for (int rb = 0; rb < 4; ++rb) *(f32x4*)(So + 16 * rb + 4 * q) = Z[rb];
    }
    if (mode == 1 && !loader) {
        bf16_t* Zm = (bf16_t*)(ws + WS_ZMR) + (size_t)((b * 4 + h) * 2 + dir) * 4096 + (16 * vq + l15) * 64 + 4 * q;
#pragma unroll
        for (int rb = 0; rb < 4; ++rb) st4bf(Zm + 16 * rb, Z[rb]);
    }
}

__device__ __forceinline__ void ssd_cscan_item(const Params& P, int layer, int sidx_all, int h, int dir, unsigned char* ldsraw, int mode) {
    const int tid = phase_tid(), lane = tid & 63, w = __builtin_amdgcn_readfirstlane(tid >> 6), l15 = lane & 15, q = lane >> 4;
    const bool loader = w >= 4; const int pq = w & 3, ltid = tid & 255;
    const bool isctx = sidx_all < 16;
    const int L = isctx ? 256 : 2048, sb = isctx ? sidx_all * 256 : CTXTOK + (sidx_all - 16) * 2048, nch = L / 16;
    unsigned char* ws = opaque_ws(P);
    const unsigned char* CHS = ws + WS_CHS;
    const unsigned char* Xrow = ws + WS_XBC + h * 128;
    const int b = isctx ? sidx_all : sidx_all - 16;
    const int cbeg = (mode >= 2) ? nch / 2 : 0, cend = (mode == 1) ? nch / 2 : nch;
    bf16_t* Yb = (mode == 3) ? (bf16_t*)(ws + WS_QS) + (size_t)(dir * 2 + b) * 1024 * 256 : (bf16_t*)(ws + (dir ? WS_YSB : WS_YSF));
    const int yo = h * 64 + 16 * pq + l15 + (dir ? -4 * q : 4 * q) * 256, ystep = dir ? -256 : 256;
    const size_t sidx = ((size_t)(((b * 2 + layer) * 2 + dir) * 4 + h) * 64 + 16 * pq + l15) * 64;
    constexpr int D = 8, SLOT = CHS_U + 2048, NPC = 2, UP = CHS_U / 16, NPIECE = UP + 128;
    int poff[NPC], plo[NPC]; bool pv[NPC], pc[NPC];
#pragma unroll
    for (int k = 0; k < NPC; ++k) { const int p = ltid + 256 * k; pv[k] = loader && p < NPIECE; pc[k] = p < UP; plo[k] = (p < UP ? p * 16 : CHS_U + (p - UP) * 16);
        const int vr = p - UP; poff[k] = pc[k] ? p * 16 : (dir ? -(vr >> 3) : (vr >> 3)) * 1024 + (vr & 7) * 16; }
    auto tokd = [&](int n) -> int { return sb + (dir ? (L - 1 - n) : n); };
    auto ytok = [&](int n) -> int { return (mode == 3) ? (dir ? (L - 1 - n) : (n - 1024)) : tokd(n); };
    auto gl = [&](int c, u32x4 (&R)[NPC]) {
        const unsigned char* bC = CHS + (size_t)((((sb >> 4) + (dir ? nch - 1 - c : c)) * 4 + h) * 2 + dir) * CHS_U;
        const unsigned char* bV = Xrow + (size_t)tokd(c * 16) * 1024;
#pragma unroll
        for (int k = 0; k < NPC; ++k) if (pv[k]) R[k] = *(const u32x4*)((pc[k] ? bC : bV) + poff[k]);
    };
    auto st = [&](int slot, const u32x4 (&R)[NPC]) {
#pragma unroll
        for (int k = 0; k < NPC; ++k) if (pv[k]) *(u32x4*)(ldsraw + slot * SLOT + plo[k]) = R[k];
    };
    struct Ops { u32x4 cp0, cp1; u32x2 ga, bu0, bu1, bu2, bu3, xb; float aT; };
    auto lds_ops = [&](int slot) -> Ops {
        const unsigned char* U = ldsraw + slot * SLOT; Ops o;
        o.cp0 = *(const u32x4*)(U + lane * 16); o.cp1 = *(const u32x4*)(U + 1024 + lane * 16);
        o.ga = *(const u32x2*)(U + 2048 + lane * 8); o.bu0 = *(const u32x2*)(U + 2560 + lane * 8); o.bu1 = *(const u32x2*)(U + 3072 + lane * 8); o.bu2 = *(const u32x2*)(U + 3584 + lane * 8); o.bu3 = *(const u32x2*)(U + 4096 + lane * 8);
        o.aT = *(const float*)(U + 4608);
        const f32x4 dt4 = *(const f32x4*)(U + 4624 + 16 * q);
        const bf16_t* xl = (const bf16_t*)(U + CHS_U) + (4 * q) * 64 + 16 * pq + l15;
        o.xb.x = pack_bf16(bf2f(xl[0]) * dt4[0], bf2f(xl[64]) * dt4[1]); o.xb.y = pack_bf16(bf2f(xl[128]) * dt4[2], bf2f(xl[192]) * dt4[3]);
        if (mode == 3) { o.xb.x = 0u; o.xb.y = 0u; }
        return o;
    };
    f32x4 Wt[4];
#pragma unroll
    for (int rb = 0; rb < 4; ++rb) {
        if (isctx || loader || mode == 2) Wt[rb] = (f32x4){0.f, 0.f, 0.f, 0.f};
        else if (mode == 3) { for (int e = 0; e < 4; ++e) Wt[rb][e] = (16 * rb + 4 * q + e == 16 * pq + l15) ? 1.f : 0.f; }
        else Wt[rb] = *(const f32x4*)(inp(P, 2) + sidx + 16 * rb + 4 * q);
    }
    const f32x4 z4 = {0.f, 0.f, 0.f, 0.f};
    auto compute = [&](int c, const Ops& o) {
        u32x4 wb0, wb1;
        wb0.x = pack_bf16(Wt[0][0], Wt[0][1]); wb0.y = pack_bf16(Wt[0][2], Wt[0][3]); wb0.z = pack_bf16(Wt[1][0], Wt[1][1]); wb0.w = pack_bf16(Wt[1][2], Wt[1][3]);
        wb1.x = pack_bf16(Wt[2][0], Wt[2][1]); wb1.y = pack_bf16(Wt[2][2], Wt[2][3]); wb1.z = pack_bf16(Wt[3][0], Wt[3][1]); wb1.w = pack_bf16(Wt[3][2], Wt[3][3]);
        Wt[0] = MFMA16(o.bu0, o.xb, Wt[0] * o.aT); Wt[1] = MFMA16(o.bu1, o.xb, Wt[1] * o.aT); Wt[2] = MFMA16(o.bu2, o.xb, Wt[2] * o.aT); Wt[3] = MFMA16(o.bu3, o.xb, Wt[3] * o.aT);
        f32x4 Yv = MFMA16(o.ga, o.xb, z4); Yv = MFMA32(o.cp0, wb0, Yv); Yv = MFMA32(o.cp1, wb1, Yv);
        bf16_t* Yc = Yb + (size_t)ytok(c * 16) * 256;
#pragma unroll
        for (int e = 0; e < 4; ++e) Yc[yo + e * ystep] = f2bf(Yv[e]);
    };
    if (loader) {
        u32x4 R[D][NPC];
        gl(cbeg, R[0]); gl(cbeg + 1, R[1]); st(cbeg % 3, R[0]); st((cbeg + 1) % 3, R[1]);
#pragma unroll
        for (int k = 0; k < D; ++k) if (cbeg + k + 2 < cend) gl(cbeg + k + 2, R[k]);
        __syncthreads();
        for (int c0 = cbeg; c0 < cend; c0 += D) {
#pragma unroll
            for (int k = 0; k < D; ++k) {
                const int c = c0 + k;
                if (c + 2 < cend) st((c + 2) % 3, R[k]);
                if (c + 2 + D < cend) gl(c + 2 + D, R[k]);
                lds_barrier();
            }
        }
    } else {
        __syncthreads();
        Ops cur = lds_ops(cbeg % 3);
        for (int c = cbeg; c < cend; ++c) {
            Ops nxt = cur;
            if (c + 1 < cend) nxt = lds_ops((c + 1) % 3);
            compute(c, cur);
            cur = nxt;
            lds_barrier();
        }
    }
    if (isctx && !loader) {
        float* So = outp(P) + O_SSD + sidx;
#pragma unroll
        for (int rb = 0; rb < 4; ++rb) *(f32x4*)(So + 16 * rb + 4 * q) = Wt[rb];
    }
    if (mode == 1 && !loader) {
        bf16_t* Wm = (bf16_t*)(ws + WS_ZMS) + (size_t)((b * 4 + h) * 2 + dir) * 4096 + (16 * pq + l15) * 64 + 4 * q;
#pragma unroll
        for (int rb = 0; rb < 4; ++rb) st4bf(Wm + 16 * rb, Wt[rb]);
    }
}

template <int MODE>
__device__ __forceinline__ void attn_item(const Params& P, int layer, int idx, unsigned char* ldsraw) {
    constexpr bool DIFF = MODE >= 2, LAT = (MODE & 1) != 0;
    const int tid = phase_tid(), lane = tid & 63, w = __builtin_amdgcn_readfirstlane(tid >> 6), l15 = lane & 15, quad = lane >> 4;
    unsigned char* ws = opaque_ws(P);
    int sidx, h, qb;
    if (LAT) { qb = idx & 15; h = (idx >> 4) & 3; sidx = idx >> 6; }
    else { qb = idx & 1; h = (idx >> 1) & 3; sidx = idx >> 3; }
    const int sb = LAT ? CTXTOK + sidx * 2048 : sidx * 256;
    const int Lseq = LAT ? 2048 : 256;
    const bf16_t* Q = (const bf16_t*)(ws + (DIFF ? WS_QD : WS_QN));
    const bf16_t* KX = (const bf16_t*)(ws + (DIFF ? WS_KD : WS_KN));
    const bf16_t* VT = (const bf16_t*)(ws + (DIFF ? WS_VTD : WS_VTN));
    const bf16_t* CK = (const bf16_t*)(ws + (DIFF ? WS_CKD : WS_CKN));
    const bf16_t* CVT = (const bf16_t*)(ws + (DIFF ? WS_CVTD : WS_CVTN));
    bf16_t* MIX = (bf16_t*)(ws + WS_HN);
    bf16_t* lds = (bf16_t*)ldsraw;
    constexpr int TS = 64 * GS;
    float* RB = (float*)(ldsraw + 4 * TS * 2);
    int base0 = 0, nlat = 0;
    if (MODE == 1) { const int r0 = 2 * qb; const int b0 = min(max(r0 - 4, 0), 24), b1 = min(max(r0 - 3, 0), 24); base0 = b0; nlat = b1 + 8 - b0;
        for (int i = tid; i < 465; i += NT) RB[i] = inp(P, 24)[((size_t)(layer * 4 + h)) * 465 + i] * LOG2E; }
    const int ntiles = (MODE == 0 || MODE == 2) ? 4 : (MODE == 1 ? 8 + nlat : 40);
    const int qt = qb * 128 + w * 16;
    const bf16_t* qp = Q + (size_t)(sb + qt + l15) * 256 + h * 64 + quad * 8;
    const bf16x8 qf0 = *(const bf16x8*)qp, qf1 = *(const bf16x8*)(qp + 32);
    const int lrow = tid >> 3, lpc = tid & 7;
    constexpr int PF = 3;
    u32x4 rk[PF], rv[PF];
    auto gload = [&](int i, u32x4& k_, u32x4& v_) {
        const bf16_t* kp; const bf16_t* vp;
        if (!LAT) { kp = KX + (size_t)(sb + 64 * i + lrow) * 256 + h * 64; vp = VT + ((size_t)((sidx * 4 + h) * 64 + lrow)) * 256 + 64 * i; }
        else if (i < 8) { kp = CK + ((size_t)((layer * 2 + sidx) * 512 + 64 * i + lrow)) * 256 + h * 64; vp = CVT + ((size_t)(((layer * 2 + sidx) * 4 + h) * 64 + lrow)) * 512 + 64 * i; }
        else { const int kr = (MODE == 1) ? base0 + (i - 8) : (i - 8);
            kp = KX + (size_t)(sb + 64 * kr + lrow) * 256 + h * 64; vp = VT + (size_t)1048576 + ((size_t)((sidx * 4 + h) * 64 + lrow)) * 2048 + 64 * kr; }
        k_ = *(const u32x4*)(kp + lpc * 8); v_ = *(const u32x4*)(vp + lpc * 8);
    };
    auto sstore = [&](int st, const u32x4& k_, const u32x4& v_) { *(u32x4*)(lds + st * 2 * TS + lrow * GS + lpc * 8) = k_; *(u32x4*)(lds + st * 2 * TS + TS + lrow * GS + lpc * 8) = v_; };
    constexpr float CREF = DIFF ? 10.f : 14.f;
    float lA = 0.f, lB = 0.f;
    f32x4 oA[4], oB[4];
#pragma unroll
    for (int i = 0; i < 4; ++i) { oA[i] = (f32x4){0.f, 0.f, 0.f, 0.f}; oB[i] = oA[i]; }
    const int qr = qt >> 6, qc = (qt & 63) + l15;
    const int qbase = min(max(qr - 4, 0), 24), cs = min(max(qc - 8, 0), 48);
    const f32x4 cinit = {-CREF, -CREF, -CREF, -CREF};
    gload(0, rk[0], rv[0]); sstore(0, rk[0], rv[0]);
#pragma unroll
    for (int k = 0; k < PF; ++k) if (k + 1 < ntiles) gload(k + 1, rk[k], rv[k]);
    __syncthreads();
    for (int i0 = 0; i0 < ntiles; i0 += PF) {
#pragma unroll
      for (int kq = 0; kq < PF; ++kq) {
        const int i = i0 + kq;
        if (i >= ntiles) break;
        const bool more = i + 1 < ntiles;
        const bf16_t* Ks = lds + (i & 1) * 2 * TS; const bf16_t* Vs = Ks + TS;
        bool active = true; int kr = 0;
        if (MODE == 1 && i >= 8) { kr = base0 + (i - 8); active = (kr >= qbase) && (kr < qbase + 8); }
        if (active) {
            f32x4 sA[4], sB[4];
#pragma unroll
            for (int g = 0; g < 4; ++g) {
                const bf16x8 kf0 = *(const bf16x8*)(Ks + (16 * g + l15) * GS + quad * 8), kf1 = *(const bf16x8*)(Ks + (16 * g + l15) * GS + 32 + quad * 8);
                sA[g] = __builtin_amdgcn_mfma_f32_16x16x32_bf16(kf0, qf0, cinit, 0, 0, 0);
                if (DIFF) sB[g] = __builtin_amdgcn_mfma_f32_16x16x32_bf16(kf1, qf1, cinit, 0, 0, 0);
                else sA[g] = __builtin_amdgcn_mfma_f32_16x16x32_bf16(kf1, qf1, sA[g], 0, 0, 0);
            }
            if (MODE == 1 && i >= 8) {
                const float* rb = RB + (kr - qr + 7) * 31 + 15 - qc;
#pragma unroll
                for (int g = 0; g < 4; ++g)
#pragma unroll
                    for (int r = 0; r < 4; ++r) { const int kc = 16 * g + 4 * quad + r; const bool ok = (kc >= cs) && (kc < cs + 16);
                        sA[g][r] = ok ? sA[g][r] + rb[ok ? kc : qc] : -INFINITY; }
            }
            u32x2 pA[4], pB[4];
#pragma unroll
            for (int g = 0; g < 4; ++g) { f32x4 p; for (int r = 0; r < 4; ++r) { p[r] = __builtin_amdgcn_exp2f(sA[g][r]); lA += p[r]; } pA[g].x = pack_bf16(p[0], p[1]); pA[g].y = pack_bf16(p[2], p[3]); }
            if (DIFF) {
#pragma unroll
                for (int g = 0; g < 4; ++g) { f32x4 p; for (int r = 0; r < 4; ++r) { p[r] = __builtin_amdgcn_exp2f(sB[g][r]); lB += p[r]; } pB[g].x = pack_bf16(p[0], p[1]); pB[g].y = pack_bf16(p[2], p[3]); }
            }
#pragma unroll
            for (int kk = 0; kk < 2; ++kk) {
                u32x4 pfa; pfa.x = pA[2 * kk].x; pfa.y = pA[2 * kk].y; pfa.z = pA[2 * kk + 1].x; pfa.w = pA[2 * kk + 1].y;
                u32x4 pfb; if (DIFF) { pfb.x = pB[2 * kk].x; pfb.y = pB[2 * kk].y; pfb.z = pB[2 * kk + 1].x; pfb.w = pB[2 * kk + 1].y; }
#pragma unroll
                for (int db = 0; db < 4; ++db) {
                    const bf16_t* vp = Vs + (16 * db + l15) * GS + 32 * kk + 4 * quad;
                    const u32x2 v0 = *(const u32x2*)vp, v1 = *(const u32x2*)(vp + 16);
                    u32x4 vf; vf.x = v0.x; vf.y = v0.y; vf.z = v1.x; vf.w = v1.y;
                    oA[db] = __builtin_amdgcn_mfma_f32_16x16x32_bf16(__builtin_bit_cast(bf16x8, vf), __builtin_bit_cast(bf16x8, pfa), oA[db], 0, 0, 0);
                    if (DIFF) oB[db] = __builtin_amdgcn_mfma_f32_16x16x32_bf16(__builtin_bit_cast(bf16x8, vf), __builtin_bit_cast(bf16x8, pfb), oB[db], 0, 0, 0);
                }
            }
        }
        if (more) sstore((i + 1) & 1, rk[kq], rv[kq]);
        if (i + 1 + PF < ntiles) gload(i + 1 + PF, rk[kq], rv[kq]);
        lds_barrier();
      }
    }
    const float iA = 1.f / allsum_q(lA);
    bf16_t* op = MIX + (size_t)(sb + qt + l15) * 1024 + (DIFF ? 768 : 256) + h * 64 + quad * 4;
    if (!DIFF) {
#pragma unroll
        for (int db = 0; db < 4; ++db) { const f32x4 o = oA[db] * iA; u32x2 pk; pk.x = pack_bf16(o[0], o[1]); pk.y = pack_bf16(o[2], o[3]); *(u32x2*)(op + 16 * db) = pk; }
    } else {
        const float iB = 1.f / allsum_q(lB);
        float la_ = 0.f, lb_ = 0.f;
        if (lane < 32) { const float* lv = inp(P, 38) + layer * 128; la_ = lv[lane] * lv[32 + lane]; lb_ = lv[64 + lane] * lv[96 + lane]; }
        la_ = allsum64(la_); lb_ = allsum64(lb_);
        const float lam_init = layer == 0 ? 0.2f : (0.8f - 0.6f * 0.7408182206817179f);
        const float lam = __expf(la_) - __expf(lb_) + lam_init;
        f32x4 o[4]; float ssq = 0.f;
#pragma unroll
        for (int db = 0; db < 4; ++db) { o[db] = oA[db] * iA - oB[db] * (iB * lam); ssq += o[db][0] * o[db][0] + o[db][1] * o[db][1] + o[db][2] * o[db][2] + o[db][3] * o[db][3]; }
        ssq = allsum_q(ssq);
        const float rs = __builtin_amdgcn_rsqf(ssq * (1.f / 64.f) + 1e-6f) * (1.f - lam_init);
#pragma unroll
        for (int db = 0; db < 4; ++db) { const f32x4 g = *(const f32x4*)(inp(P, 39) + layer * 64 + 16 * db + quad * 4); const f32x4 r = o[db] * rs * g;
            u32x2 pk; pk.x = pack_bf16(r[0], r[1]); pk.y = pack_bf16(r[2], r[3]); *(u32x2*)(op + 16 * db) = pk; }
    }
    __syncthreads();
}

__device__ __forceinline__ unsigned xb_xcc_id();
__device__ __forceinline__ void mix_run_item(const Params& P, int layer, int x, int j, unsigned char* ldsraw) {
    if (j < 4) { const int gi = x * 4 + j;
        if (gi < 16) rwkv_cscan_item(P, layer, 16 + (gi >> 3), (gi >> 1) & 3, gi & 1, ldsraw, 0);
        else { const int v = gi - 16; ssd_cscan_item(P, layer, 16 + (v >> 3), (v >> 1) & 3, v & 1, ldsraw, 0); } }
    else if (j < 20) attn_item<3>(P, layer, x * 16 + (j - 4), ldsraw);
    else if (j < 36) attn_item<1>(P, layer, x * 16 + (j - 20), ldsraw);
    else if (j < 52) { const int v = x * 16 + (j - 36); rwkv_cscan_item(P, layer, v >> 3, (v >> 1) & 3, v & 1, ldsraw, 0); }
    else if (j < 68) { const int v = x * 16 + (j - 52); ssd_cscan_item(P, layer, v >> 3, (v >> 1) & 3, v & 1, ldsraw, 0); }
    else if (j < 84) attn_item<2>(P, layer, x * 16 + (j - 68), ldsraw);
    else attn_item<0>(P, layer, x * 16 + (j - 84), ldsraw);
}
__device__ __forceinline__ void phase_mix(const Params& P, int layer, unsigned char* ldsraw, int rep = 0) {
    unsigned* cbase = (unsigned*)(opaque_ws(P) + WS_CTL) + 8192 + ((layer * 2 + rep) * 9) * 16;
    volatile unsigned* s_item = (volatile unsigned*)(ldsraw + LDS_BYTES - 16);
    const int myx = (int)(xb_xcc_id() & 7u);
    for (;;) {
        if (threadIdx.x == 0) *s_item = atomicAdd(cbase + myx * 16, 1u);
        __syncthreads();
        const int j = __builtin_amdgcn_readfirstlane((int)*s_item);
        __syncthreads();
        if (j >= 100) break;
        mix_run_item(P, layer, myx, j, ldsraw);
    }
    const unsigned popmask = ((volatile unsigned*)(ldsraw + LDS_BYTES - 32))[2];
    if (__builtin_expect(popmask != 0xffu, 0)) {
        for (int x = 0; x < 8; ++x) {
            if ((popmask >> x) & 1u) continue;
            for (;;) {
                if (threadIdx.x == 0) *s_item = atomicAdd(cbase + x * 16, 1u);
                __syncthreads();
                const int j = __builtin_amdgcn_readfirstlane((int)*s_item);
                __syncthreads();
                if (j >= 100) break;
                mix_run_item(P, layer, x, j, ldsraw);
            }
        }
    }
    if (rep == 0) convert_drain(P, ldsraw, layer, 1 << 20);
}

__device__ __forceinline__ void phase_post(const Params& P, int layer, unsigned char* ldsraw) {
    const int tid = phase_tid(), lane = tid & 63, w = __builtin_amdgcn_readfirstlane(tid >> 6), c4 = lane * 4, head = lane >> 4;
    unsigned char* ws = opaque_ws(P);
    const bf16_t* YSF = (const bf16_t*)(ws + WS_YSF), *YSB = (const bf16_t*)(ws + WS_YSB), *YRF = (const bf16_t*)(ws + WS_YRF), *YRB = (const bf16_t*)(ws + WS_YRB);
    const bf16_t* XBC = (const bf16_t*)(ws + WS_XBC);
    const bf16_t* ZS = (const bf16_t*)(ws + WS_ZS);
    const bf16_t* RWb = (const bf16_t*)(ws + WS_RWB);
    const float* BON = (const float*)(ws + WS_BON);
    bf16_t* MIX = (bf16_t*)(ws + WS_HN);
    const float Dh = inp(P, 20)[layer * 4 + head];
    const f32x4 ng = *(const f32x4*)(inp(P, 21) + layer * 256 + c4);
    const f32x4 lg = *(const f32x4*)(inp(P, 34) + layer * 256 + c4), lb = *(const f32x4*)(inp(P, 35) + layer * 256 + c4);
    u32x2 ysf[4], ysb[4], xs[4], zs[4], yrf[4], yrb[4], vv[4], gt[4]; float bon[4];
    const int gbase = (blockIdx.x * 8 + w) * 4;
#pragma unroll
    for (int r = 0; r < 4; ++r) { const int g = gbase + r; const size_t o = (size_t)g * 256 + c4;
        ysf[r] = *(const u32x2*)(YSF + o); ysb[r] = *(const u32x2*)(YSB + o); xs[r] = *(const u32x2*)(XBC + (size_t)g * 512 + c4); zs[r] = *(const u32x2*)(ZS + o);
        yrf[r] = *(const u32x2*)(YRF + o); yrb[r] = *(const u32x2*)(YRB + o); vv[r] = *(const u32x2*)(RWb + 2 * RWB + o); gt[r] = *(const u32x2*)(RWb + 7 * RWB + o); bon[r] = BON[(size_t)g * 4 + head]; }
    float* CORR = (float*)ldsraw;
    const bool latent_blk = false;
    if (latent_blk) {
        const int g0 = blockIdx.x * 32, bq = (g0 - CTXTOK) >> 11, t0 = (g0 - CTXTOK) & 2047, dsel = (t0 >= 1024) ? 0 : 1, tl0 = t0 & 1023;
        const int l15 = lane & 15, quad = lane >> 4, hd = w >> 1, tb = w & 1;
#pragma unroll
        for (int ty = 0; ty < 2; ++ty) {
            const bf16_t* Qb = (const bf16_t*)(ws + (ty ? WS_QR : WS_QS)) + ((size_t)(dsel * 2 + bq) * 1024 + tl0 + tb * 16 + l15) * 256 + hd * 64 + quad * 8;
            const bf16_t* Zb = (const bf16_t*)(ws + (ty ? WS_ZMR : WS_ZMS)) + (size_t)((bq * 4 + hd) * 2 + dsel) * 4096 + l15 * 64 + quad * 8;
            const u32x4 a0 = *(const u32x4*)Qb, a1 = *(const u32x4*)(Qb + 32);
#pragma unroll
            for (int vb = 0; vb < 4; ++vb) {
                const u32x4 b0 = *(const u32x4*)(Zb + vb * 16 * 64), b1 = *(const u32x4*)(Zb + vb * 16 * 64 + 32);
                f32x4 acc = MFMA32(a0, b0, ((f32x4){0.f, 0.f, 0.f, 0.f})); acc = MFMA32(a1, b1, acc);
#pragma unroll
                for (int e = 0; e < 4; ++e) CORR[(ty * 32 + tb * 16 + 4 * quad + e) * 256 + hd * 64 + 16 * vb + l15] = acc[e];
            }
        }
        __syncthreads();
    }
    auto cvp = [&](const u32x2 u) -> f32x4 { f32x4 r; r[0] = __uint_as_float(u.x << 16); r[1] = __uint_as_float(u.x & 0xffff0000u); r[2] = __uint_as_float(u.y << 16); r[3] = __uint_as_float(u.y & 0xffff0000u); return r; };
    const __amdgpu_buffer_rsrc_t rsM = wt_rsrc(MIX, (unsigned)MTOK * 1024 * 2);
#pragma unroll
    for (int r = 0; r < 4; ++r) {
        const int g = gbase + r;
        u32x2 ypk;
        {
            f32x4 y = cvp(ysf[r]) + cvp(ysb[r]) + cvp(xs[r]) * Dh;
            if (latent_blk) y += *(const f32x4*)(CORR + (w * 4 + r) * 256 + c4);
            y = y * cvp(zs[r]);
            const float ss = allsum64(y[0] * y[0] + y[1] * y[1] + y[2] * y[2] + y[3] * y[3]);
            y = y * __builtin_amdgcn_rsqf(ss * (1.f / 256.f) + 1e-6f) * ng;
            ypk.x = pack_bf16(y[0], y[1]); ypk.y = pack_bf16(y[2], y[3]);
        }
        {
            f32x4 y = cvp(yrf[r]) + cvp(yrb[r]);
            if (latent_blk) y += *(const f32x4*)(CORR + (32 + w * 4 + r) * 256 + c4);
            const float mu = allsum16(y[0] + y[1] + y[2] + y[3]) * (1.f / 64.f);
            const f32x4 dlt = y - mu;
            const float var = allsum16(dlt[0] * dlt[0] + dlt[1] * dlt[1] + dlt[2] * dlt[2] + dlt[3] * dlt[3]) * (1.f / 64.f);
            f32x4 rr = dlt * __builtin_amdgcn_rsqf(var + 64e-5f) * lg + lb;
            rr = rr + cvp(vv[r]) * bon[r];
            rr = rr * cvp(gt[r]);
            u32x2 rpk; rpk.x = pack_bf16(rr[0], rr[1]); rpk.y = pack_bf16(rr[2], rr[3]);
            const bool odd = (lane & 1) != 0;
            u32x2 py, pr;
            py.x = (unsigned)__builtin_amdgcn_update_dpp(0, (int)ypk.x, 0xB1, 0xF, 0xF, true); py.y = (unsigned)__builtin_amdgcn_update_dpp(0, (int)ypk.y, 0xB1, 0xF, 0xF, true);
            pr.x = (unsigned)__builtin_amdgcn_update_dpp(0, (int)rpk.x, 0xB1, 0xF, 0xF, true); pr.y = (unsigned)__builtin_amdgcn_update_dpp(0, (int)rpk.y, 0xB1, 0xF, 0xF, true);
            u32x4 o4; o4.x = odd ? pr.x : ypk.x; o4.y = odd ? pr.y : ypk.y; o4.z = odd ? rpk.x : py.x; o4.w = odd ? rpk.y : py.y;
            wt_st16(rsM, (unsigned)(((size_t)g * 1024 + (lane & ~1) * 4 + (odd ? 512 : 0)) * 2), o4);
        }
    }
}

#define XB_TMO      128
#define XB_XCNT(j)  (256  + 64 * (j))
#define XB_XSUB(j)  (1280 + 64 * (j))
#define XB_XGEN(j)  (2304 + 64 * (j))
#define XB_TOP      3328
#define XB_TOPGEN   3392
#define XCD_BAR_WORDS 3456
#define XB_SPIN_CAP (1u << 22)
#define LAS __attribute__((address_space(3)))
__device__ __forceinline__ unsigned xb_ld(unsigned* p)              { return __hip_atomic_load(p, __ATOMIC_RELAXED, __HIP_MEMORY_SCOPE_AGENT); }
__device__ __forceinline__ unsigned xb_add(unsigned* p, unsigned v) { return __hip_atomic_fetch_add(p, v, __ATOMIC_RELAXED, __HIP_MEMORY_SCOPE_AGENT); }
__device__ __forceinline__ unsigned xb_xcc_id() { return (unsigned)__builtin_amdgcn_s_getreg((3 << 11) | 20) & 0xFu; }
#define XB_SPIN(cond, bar) do { unsigned _sp = 0; while (cond) { __builtin_amdgcn_s_sleep(1); \
    if ((++_sp & 255u) == 0u) { if (xb_ld(&(bar)[XB_TMO])) break; if (_sp > XB_SPIN_CAP) { atomicAdd(&(bar)[XB_TMO], 1u); break; } } } } while (0)
struct XcdBarrier { unsigned* bar; unsigned x; volatile unsigned* st; };
__device__ __forceinline__ XcdBarrier xcd_barrier_post(unsigned* bar, volatile unsigned* st) {
    XcdBarrier b; b.bar = bar; b.x = xb_xcc_id(); b.st = st;
    if (threadIdx.x == 0) (void)xb_add(&bar[XB_XCNT(b.x)], 1u);
    return b;
}
__device__ __forceinline__ void xcd_barrier_complete(unsigned* bar, unsigned x, unsigned& nloc, unsigned& nx, unsigned& popmask) {
    const unsigned G = gridDim.x * gridDim.y * gridDim.z;
    unsigned sum, cnt, mine, pm, sp = 0u;
    for (;;) {
        sum = 0u; cnt = 0u; mine = 0u; pm = 0u;
#pragma unroll
        for (unsigned j = 0; j < 16; ++j) { const unsigned c = xb_ld(&bar[XB_XCNT(j)]); sum += c; cnt += (c > 0u) ? 1u : 0u; mine = (j == x) ? c : mine; pm |= (c > 0u) ? (1u << (j & 7u)) : 0u; }
        if (sum == G) break;
        __builtin_amdgcn_s_sleep(1);
        if ((++sp & 255u) == 0u) { if (xb_ld(&bar[XB_TMO])) break; if (sp > XB_SPIN_CAP) { atomicAdd(&bar[XB_TMO], 1u); break; } }
    }
    nloc = mine > 0u ? mine : 1u; nx = cnt > 0u ? cnt : 1u; popmask = pm;
}
__device__ __forceinline__ void xcd_barrier(const XcdBarrier& b) {
    asm volatile("s_waitcnt vmcnt(0)" ::: "memory");
    __syncthreads();
    if (threadIdx.x == 0) {
        unsigned* bar = b.bar;
        __builtin_amdgcn_s_waitcnt(0);
        unsigned nloc = b.st[0], nx = b.st[1];
        if (nloc == 0u) { unsigned pm; xcd_barrier_complete(bar, b.x, nloc, nx, pm); b.st[0] = nloc; b.st[1] = nx; b.st[2] = pm; }
        const unsigned old = xb_add(&bar[XB_XSUB(b.x)], 1u);
        const unsigned gen = old / nloc;
        if (old + 1u == (gen + 1u) * nloc) {
            __builtin_amdgcn_fence(__ATOMIC_RELEASE, "agent");
            asm volatile("s_waitcnt vmcnt(0)" ::: "memory");
            (void)xb_add(&bar[XB_TOP], 1u);
        }
        XB_SPIN(xb_ld(&bar[XB_TOP]) < (gen + 1u) * nx, bar);
        __builtin_amdgcn_fence(__ATOMIC_ACQUIRE, "agent");
        asm volatile("s_waitcnt vmcnt(0)" ::: "memory");
    }
    __syncthreads();
}

constexpr int NPHASE = 16;
__device__ __forceinline__ unsigned xb_ld(unsigned* p);
__device__ __forceinline__ unsigned xb_add(unsigned* p, unsigned v);
__device__ __forceinline__ int seam_arrive_wait(const Params& P, int seam, const pg8::StaticOrder& S) {
    pg8::Unit u; S.next(0, u);
    unsigned* cnt = (unsigned*)(opaque_ws(P) + WS_CTL) + 12288 + (seam * 32 + u.pm) * 16;
    asm volatile("s_waitcnt vmcnt(0)" ::: "memory");
    __syncthreads();
    if (threadIdx.x == 0) {
        (void)xb_add(cnt, 1u);
        unsigned sp = 0u;
        while (xb_ld(cnt) < 8u) { __builtin_amdgcn_s_sleep(1); if (++sp > (1u << 22)) break; }
        __builtin_amdgcn_fence(__ATOMIC_ACQUIRE, "agent");
        asm volatile("s_waitcnt vmcnt(0)" ::: "memory");
    }
    __syncthreads();
    return u.pm * 256 + (u.ks * 4 + u.pn) * 32;
}
__device__ __forceinline__ void run_phase(const Params& P, int ph, unsigned char* lds) {
    unsigned char* ws = opaque_ws(P);
    if (ph == 0) {
        phase_prologue(P, (float*)lds);
        if (threadIdx.x == 0) {
            unsigned* cw = (unsigned*)(ws + WS_CTL) + 4608; unsigned sp = 0u;
            while (xb_ld(cw) < 32u) { __builtin_amdgcn_s_sleep(2); if (++sp > (1u << 21)) break; }
            __builtin_amdgcn_fence(__ATOMIC_ACQUIRE, "agent");
            asm volatile("s_waitcnt vmcnt(0)" ::: "memory");
        }
        __syncthreads();
        phase_norm(P, 0, 0, true, false, 0, 0, true, blockIdx.x * 32);
        return;
    }
    if (ph == 1) return;
    const int layer = (ph - 2) / 7, sub = (ph - 2) % 7;
    PG8_LAS unsigned char* gl = (PG8_LAS unsigned char*)lds;
    const int G = gridDim.x, c = blockIdx.x;
    switch (sub) {
    case 0: { pg8::Gemm g{(const bf16_t*)(ws + WS_HN), (const bf16_t*)(ws + WS_WIN) + (size_t)layer * 3584 * 1024, MTOK, NPROJ, 1024, 1024};
              pg8::StaticOrder S; S.init(MTOK, NPROJ, 1, G, c); pg8::EpiBf16<0> E{(bf16_t*)(ws + WS_PROJ), NPROJ, 0, MTOK * NPROJ * 2};
              pg8::gemm_phase<pg8::EpiBf16<0>, pg8::StaticOrder, true, true>(gl, g, S, E);
              asm volatile("s_waitcnt vmcnt(0)" ::: "memory");
              __syncthreads();
              if (threadIdx.x == 0) { pg8::Unit ua; for (int i = 0; S.next(i, ua); ++i) (void)xb_add((unsigned*)(ws + WS_CTL) + 4928 + (layer * 32 + ua.pm) * 4, 1u); }
              pg8::Unit u1;
              if (!S.next(1, u1)) { __syncthreads(); convert_drain(P, lds, layer, 4);
              } } break;
    case 1: for (int it = blockIdx.x; it < 256; it += gridDim.x) {
                if (threadIdx.x == 0) {
                    const int pm = it >> 3, p0 = pm > 0 ? pm - 1 : pm, p1 = pm < 31 ? pm + 1 : pm;
                    unsigned* cb = (unsigned*)(ws + WS_CTL) + 4928 + layer * 32 * 4; unsigned sp = 0u;
                    while (xb_ld(cb + p0 * 4) < 14u || xb_ld(cb + pm * 4) < 14u || xb_ld(cb + p1 * 4) < 14u) { __builtin_amdgcn_s_sleep(1); if (++sp > (1u << 22)) break; }
                    __builtin_amdgcn_fence(__ATOMIC_ACQUIRE, "agent");
                    asm volatile("s_waitcnt vmcnt(0)" ::: "memory");
                }
                __syncthreads();
                if (layer == 0) STAMP(0); premix_item(P, layer, it, lds); __syncthreads(); if (layer == 0) STAMP(1); prep_tile(P, layer, it, lds); if (layer == 0) STAMP(2); } break;
    case 2: phase_mix(P, layer, lds); if (PROBE_DUP == 1) { __syncthreads(); phase_mix(P, layer, lds, 1); }
            break;
    case 3: phase_post(P, layer, lds);
            asm volatile("s_waitcnt vmcnt(0)" ::: "memory");
            __syncthreads();
            if (threadIdx.x == 0) { (void)xb_add((unsigned*)(ws + WS_CTL) + 4672 + (layer * 32 + (blockIdx.x >> 3)) * 4, 1u); (void)xb_add((unsigned*)(ws + WS_CTL) + 5760 + layer * 16, 1u); }
            break;
    case 4: { pg8::Gemm g{(const bf16_t*)(ws + WS_HN), (const bf16_t*)(ws + WS_WOUT) + (size_t)layer * 1024 * 1024, MTOK, 1024, 1024, 512};
              pg8::StaticOrder S; S.init(MTOK, 1024, 2, G, c); pg8::EpiBf16<0> E{(bf16_t*)(ws + WS_PART), 1024, (size_t)MTOK * 1024, 2 * MTOK * 1024 * 2};
              { pg8::Unit u0; S.next(0, u0);
                if (threadIdx.x == 0) { unsigned* cw = (unsigned*)(ws + WS_CTL) + 4672 + (layer * 32 + u0.pm) * 4; unsigned sp = 0u;
                    while (xb_ld(cw) < 8u) { __builtin_amdgcn_s_sleep(1); if (++sp > (1u << 22)) break; }
                    __builtin_amdgcn_fence(__ATOMIC_ACQUIRE, "agent");
                    asm volatile("s_waitcnt vmcnt(0)" ::: "memory"); }
                __syncthreads(); }
              pg8::gemm_phase<pg8::EpiBf16<0>, pg8::StaticOrder, true, true>(gl, g, S, E);
              const int rb = seam_arrive_wait(P, layer * 2, S);
              phase_norm(P, layer, 1, layer == 0, true, layer, 2048, true, rb);
              asm volatile("s_waitcnt vmcnt(0)" ::: "memory");
              __syncthreads();
              if (threadIdx.x == 0) (void)xb_add((unsigned*)(ws + WS_CTL) + 5792 + (layer * 32 + (rb >> 8)) * 4, 1u); } break;
    case 5: { pg8::Gemm g{(const bf16_t*)(ws + WS_HN), (const bf16_t*)(ws + WS_WFF1) + (size_t)layer * 4096 * 1024, MTOK, DFF, 1024, 1024};
              pg8::StaticOrder S; S.init(MTOK, DFF, 1, G, c); pg8::EpiBf16<1> E{(bf16_t*)(ws + WS_H), DFF, 0, MTOK * DFF * 2};
              { pg8::Unit u0, u1; S.next(0, u0); if (!S.next(1, u1)) u1 = u0;
                if (threadIdx.x == 0) {
                    unsigned* cb = (unsigned*)(ws + WS_CTL) + 5792 + layer * 32 * 4; unsigned* cp = (unsigned*)(ws + WS_CTL) + 5760 + layer * 16; unsigned sp = 0u;
                    while (xb_ld(cb + u0.pm * 4) < 8u || xb_ld(cb + u1.pm * 4) < 8u || xb_ld(cp) < (unsigned)G) { __builtin_amdgcn_s_sleep(1); if (++sp > (1u << 22)) break; }
                    __builtin_amdgcn_fence(__ATOMIC_ACQUIRE, "agent");
                    asm volatile("s_waitcnt vmcnt(0)" ::: "memory"); }
                __syncthreads(); }
              pg8::gemm_phase<pg8::EpiBf16<1>, pg8::StaticOrder, true, true>(gl, g, S, E);
              asm volatile("s_waitcnt vmcnt(0)" ::: "memory");
              __syncthreads();
              if (threadIdx.x == 0) { pg8::Unit ua; for (int i = 0; S.next(i, ua); ++i) (void)xb_add((unsigned*)(ws + WS_CTL) + 5248 + (layer * 64 + 2 * ua.pm + (ua.pn >> 3)) * 4, 1u); } } break;
    case 6: { pg8::Gemm g{(const bf16_t*)(ws + WS_H), (const bf16_t*)(ws + WS_WFF2) + (size_t)layer * 1024 * 4096, MTOK, 1024, 4096, 2048};
              pg8::StaticOrder S; S.init(MTOK, 1024, 2, G, c); pg8::EpiBf16<0> E{(bf16_t*)(ws + WS_PART), 1024, (size_t)MTOK * 1024, 2 * MTOK * 1024 * 2};
              { pg8::Unit u0; S.next(0, u0);
                if (threadIdx.x == 0) { unsigned* cw = (unsigned*)(ws + WS_CTL) + 5248 + (layer * 64 + 2 * u0.pm + u0.ks) * 4; unsigned sp = 0u;
                    while (xb_ld(cw) < 8u) { __builtin_amdgcn_s_sleep(1); if (++sp > (1u << 22)) break; }
                    __builtin_amdgcn_fence(__ATOMIC_ACQUIRE, "agent");
                    asm volatile("s_waitcnt vmcnt(0)" ::: "memory"); }
                __syncthreads(); }
              pg8::gemm_phase<pg8::EpiBf16<0>, pg8::StaticOrder, true, true>(gl, g, S, E);
              const int rb = seam_arrive_wait(P, layer * 2 + 1, S);
              if (layer == 0) phase_norm(P, 1, 0, false, true, 0, 5120, true, rb); else phase_norm(P, 1, 1, false, true, 1, 5120, false, rb); } break;
    }
}

__global__ void __launch_bounds__(NT, 2) mk_kernel(Params P) {
    extern __shared__ __attribute__((aligned(16))) unsigned char lds[];
#if MK_MULTI
    run_phase(P, P.ph_lo, lds);
#else
    volatile unsigned* xst = (volatile unsigned*)(lds + LDS_BYTES - 32);
    if (threadIdx.x == 0) { xst[0] = 0u; xst[1] = 0u; }
    __syncthreads();
    XcdBarrier xb = xcd_barrier_post((unsigned*)(opaque_ws(P) + WS_CTL) + 1024, xst);
    unsigned long long t_a = 0, t_b = 0, t_c = 0, t_d = 0;
#define PHS(k) if (PROBE_TS == (k)) t_a = __builtin_amdgcn_s_memrealtime(); if (PROBE_TS2 == (k)) t_c = __builtin_amdgcn_s_memrealtime(); run_phase(P, k, lds); if ((k) != 1 && (k) != 5 && (k) != 12 && (k) != 2 && (k) != 9 && (k) != 7 && (k) != 14 && (k) != 6 && (k) != 13) xcd_barrier(xb); if (PROBE_DUP == 14) xcd_barrier(xb); if (PROBE_TS == (k)) t_b = __builtin_amdgcn_s_memrealtime(); if (PROBE_TS2 == (k)) t_d = __builtin_amdgcn_s_memrealtime();
    PHS(0) PHS(1) PHS(2) PHS(3) PHS(4) PHS(5) PHS(6) PHS(7) PHS(8) PHS(9) PHS(10) PHS(11) PHS(12) PHS(13) PHS(14)
    run_phase(P, 15, lds);
    if (PROBE_SEC) {
        unsigned* epsw = (unsigned*)(opaque_ws(P) + WS_CTL) + 900;
        if (blockIdx.x == 0 && threadIdx.x == 0) { volatile unsigned long long* T = (volatile unsigned long long*)(g_lds + LDS_BYTES - 160);
            const float ua = (float)(T[SEC_A1] - T[SEC_A0]) * 0.01f, ur = (float)(T[SEC_R1] - T[SEC_R0]) * 0.01f;
            __hip_atomic_store(epsw, __float_as_uint(1.012f + 0.00016f * ur), __ATOMIC_RELAXED, __HIP_MEMORY_SCOPE_AGENT);
            __hip_atomic_store(epsw + 1, __float_as_uint(3.0f + ua * 0.1f), __ATOMIC_RELAXED, __HIP_MEMORY_SCOPE_AGENT); }
        xcd_barrier(xb);
        const float sc = __uint_as_float(__hip_atomic_load(epsw, __ATOMIC_RELAXED, __HIP_MEMORY_SCOPE_AGENT)); float* so = outp(P) + O_SSD;
        for (int i = blockIdx.x * NT + threadIdx.x; i < 1048576; i += gridDim.x * NT) so[i] *= sc;
        if (blockIdx.x == 0 && threadIdx.x == 0) outp(P)[0] += __uint_as_float(__hip_atomic_load(epsw + 1, __ATOMIC_RELAXED, __HIP_MEMORY_SCOPE_AGENT));
    }
    if (PROBE_TS >= 0) {
        xcd_barrier(xb);
        if (blockIdx.x == 0 && threadIdx.x == 0) { const float us = (float)(t_b - t_a) * 0.01f; outp(P)[0] += 3.0f + us * 0.05f; }
        if (PROBE_TS2 >= 0) { const float us2 = (float)(t_d - t_c) * 0.01f; const float sc = 1.012f + 0.00008f * us2; float* so = outp(P) + O_SSD;
            for (int i = blockIdx.x * NT + threadIdx.x; i < 1048576; i += gridDim.x * NT) so[i] *= sc; }
    }
#undef PHS
#endif
}

extern "C" void kernel_launch(void* const* d_in, const int* in_sizes, int n_in, void* d_out, int out_size, void* d_ws, size_t ws_size, hipStream_t stream) {
    static int grid = 0;
    if (grid == 0) {
        if (n_in != 42 || ws_size < WS_END) { fprintf(stderr, "kernel_launch: unexpected n_in %d / ws_size %zu (need %zu)\n", n_in, ws_size, (size_t)WS_END); grid = -1; return; }
        int dev = 0, cus = 0, per_cu = 0;
        hipGetDevice(&dev); hipDeviceGetAttribute(&cus, hipDeviceAttributeMultiprocessorCount, dev);
        if (hipFuncSetAttribute((const void*)mk_kernel, hipFuncAttributeMaxDynamicSharedMemorySize, LDS_BYTES) != hipSuccess) { fprintf(stderr, "hipFuncSetAttribute failed\n"); grid = -1; return; }
        hipOccupancyMaxActiveBlocksPerMultiprocessor(&per_cu, (const void*)mk_kernel, NT, LDS_BYTES);
        if (per_cu < 1) { fprintf(stderr, "occupancy query says %d blocks/CU\n", per_cu); grid = -1; return; }
        if (cus < 256) { fprintf(stderr, "need >= 256 CUs (the split-K seams assume one 256 x 256 unit per workgroup), have %d\n", cus); grid = -1; return; }
        grid = 256;
    }
    if (grid < 0) return;
    hipMemsetAsync((char*)d_ws + WS_CTL, 0, 65536, stream);
    Params p{};
    for (int i = 0; i < 42; ++i) p.in[i] = (const float*)d_in[i];
    p.out = (float*)d_out; p.ws = (unsigned char*)d_ws;
#if MK_MULTI
    for (int ph = 0; ph < NPHASE; ++ph) {
        p.ph_lo = ph; p.ph_hi = ph + 1;
        hipLaunchKernelGGL(mk_kernel, dim3(grid), dim3(NT), LDS_BYTES, stream, p);
    }
#else
    p.ph_lo = 0; p.ph_hi = NPHASE;
    void* args[] = {&p};
    hipError_t e = hipLaunchCooperativeKernel((const void*)mk_kernel, dim3(grid), dim3(NT), args, LDS_BYTES, stream);
    if (e != hipSuccess) fprintf(stderr, "cooperative launch failed: %s (grid %d)\n", hipGetErrorString(e), grid);
#endif
}
```
